# Optimizing an MI355X kernel written in HIP

```python
import math
import jax, jax.numpy as jnp
from jax import lax
import numpy as np

D_MODEL = 4096
BATCH = 2
SEQ = 4096
DEPTH = 2

HEAD_DIM = 128
DIFF_HEADS = 6
DIFF_DV = 2 * HEAD_DIM
MOBA_HEADS = 10
DSA_HEADS = 10
MIX_WIDTH = DIFF_HEADS * DIFF_DV + MOBA_HEADS * HEAD_DIM + DSA_HEADS * HEAD_DIM
MOBA_BLOCK = 256
MOBA_TOPK = 3
MOBA_Q_CHUNK = 32
DSA_TOPK = 256
KV_LATENT = 512
IDX_HEADS = 32
IDX_DIM = 64
DSA_Q_CHUNK = 128
DENSE_Q_BLOCK = 128
NUM_BUCKETS = 32
MAX_DISTANCE = 128
N_BIAS_COLS = 2 * DIFF_HEADS + MOBA_HEADS + DSA_HEADS
D_FF = 4 * D_MODEL
ALPHA = (2.0 * DEPTH) ** 0.25
BETA = (8.0 * DEPTH) ** -0.25
LN_EPS = 1e-5
RMS_EPS = 1e-5
NEG_INF = -1e30
IN_SIZES = (2 * DIFF_HEADS * HEAD_DIM,
            2 * DIFF_HEADS * HEAD_DIM,
            DIFF_HEADS * DIFF_DV,
            MOBA_HEADS * HEAD_DIM,
            MOBA_HEADS * HEAD_DIM,
            MOBA_HEADS * HEAD_DIM,
            DSA_HEADS * HEAD_DIM,
            KV_LATENT,
            IDX_HEADS * IDX_DIM,
            IDX_DIM,
            IDX_HEADS)
D_IN = sum(IN_SIZES)

kernel_name = 'hymba_diff_moba_dsa_deepnorm'


def _layer_norm(x, g, b):
    xf = x.astype(jnp.float32)
    mu = jnp.mean(xf, axis=-1, keepdims=True)
    var = jnp.mean(jnp.square(xf - mu), axis=-1, keepdims=True)
    y = (xf - mu) * lax.rsqrt(var + LN_EPS)
    return (y * g.astype(jnp.float32) + b.astype(jnp.float32)).astype(x.dtype)


def _standardize(x):
    xf = x.astype(jnp.float32)
    mu = jnp.mean(xf, axis=-1, keepdims=True)
    var = jnp.mean(jnp.square(xf - mu), axis=-1, keepdims=True)
    return ((xf - mu) * lax.rsqrt(var + LN_EPS)).astype(x.dtype)


def _rms_norm(x, g):
    xf = x.astype(jnp.float32)
    y = xf * lax.rsqrt(jnp.mean(jnp.square(xf), axis=-1, keepdims=True) + RMS_EPS)
    return (y * g.astype(jnp.float32)).astype(x.dtype)


def _t5_bucket(dist):
    n = jnp.maximum(dist, 0)
    max_exact = NUM_BUCKETS // 2
    nf = jnp.maximum(n, 1).astype(jnp.float32)
    large = max_exact + (jnp.log(nf / max_exact) / math.log(MAX_DISTANCE / max_exact)
                         * (NUM_BUCKETS - max_exact)).astype(jnp.int32)
    large = jnp.minimum(large, NUM_BUCKETS - 1)
    return jnp.where(n < max_exact, n, large)


def diff_attention(q, k, v, lam_vecs, subln_g, tab, lambda_init):
    B, T = q.shape[0], q.shape[1]
    qh = q.transpose(0, 2, 3, 1, 4)
    kh = k.transpose(0, 2, 3, 1, 4)
    vh = v.transpose(0, 2, 1, 3)
    lv = lam_vecs.astype(jnp.float32)
    lam = jnp.exp(jnp.sum(lv[0] * lv[1])) - jnp.exp(jnp.sum(lv[2] * lv[3])) + lambda_init
    key_pos = jnp.arange(T)
    scale = HEAD_DIM ** -0.5

    def block(i):
        q0 = i * DENSE_Q_BLOCK
        qb = lax.dynamic_slice_in_dim(qh, q0, DENSE_Q_BLOCK, axis=3)
        s = jnp.einsum('bhmqd,bhmkd->bhmqk', qb, kh).astype(jnp.float32) * scale
        dist = (q0 + jnp.arange(DENSE_Q_BLOCK))[:, None] - key_pos[None, :]
        bias = tab[_t5_bucket(dist)].reshape(DENSE_Q_BLOCK, T, DIFF_HEADS, 2).transpose(2, 3, 0, 1)
        s = jnp.where(dist >= 0, s + bias.astype(jnp.float32), NEG_INF)
        p = jax.nn.softmax(s, axis=-1)
        a = p[:, :, 0] - lam * p[:, :, 1]
        return jnp.einsum('bhqk,bhkd->bhqd', a.astype(vh.dtype), vh)

    o = lax.map(block, jnp.arange(T // DENSE_Q_BLOCK))
    o = o.transpose(1, 0, 3, 2, 4).reshape(B, T, DIFF_HEADS, DIFF_DV)
    o = _rms_norm(o, subln_g) * (1.0 - lambda_init)
    return o.reshape(B, T, DIFF_HEADS * DIFF_DV)


def moba_attention(q, k, v, tab):
    B, T, H, d = q.shape
    nb = max(-(-T // MOBA_BLOCK), MOBA_TOPK)
    Lp = nb * MOBA_BLOCK
    pad = ((0, 0), (0, 0), (0, Lp - T), (0, 0))
    qh = q.transpose(0, 2, 1, 3)
    kh = jnp.pad(k.transpose(0, 2, 1, 3), pad)
    vh = jnp.pad(v.transpose(0, 2, 1, 3), pad)
    k_blocks = kh.reshape(B, H, nb, MOBA_BLOCK, d)
    v_blocks = vh.reshape(B, H, nb, MOBA_BLOCK, d)
    k_mean = jnp.mean(k_blocks.astype(jnp.float32), axis=3)
    bi = jnp.arange(B)[:, None, None, None]
    hi = jnp.arange(H)[None, :, None, None]
    hi5 = jnp.arange(H)[None, :, None, None, None]
    tab_t = tab.T
    scale = d ** -0.5

    def chunk(i):
        q0 = i * MOBA_Q_CHUNK
        t = q0 + jnp.arange(MOBA_Q_CHUNK)
        own = q0 // MOBA_BLOCK
        qc = lax.dynamic_slice_in_dim(qh, q0, MOBA_Q_CHUNK, axis=2)
        gate = jnp.einsum('bhqd,bhnd->bhqn', qc.astype(jnp.float32), k_mean)
        gate = jnp.where(jnp.arange(nb) < own, gate, NEG_INF)
        _, sel = lax.top_k(gate, MOBA_TOPK)
        valid = jnp.arange(MOBA_TOPK) < own
        ks = k_blocks[bi, hi, sel]
        vs = v_blocks[bi, hi, sel]
        s_sel = jnp.einsum('bhqd,bhqnkd->bhqnk', qc, ks).astype(jnp.float32) * scale
        pos_sel = sel[..., None] * MOBA_BLOCK + jnp.arange(MOBA_BLOCK)
        bias_sel = tab_t[hi5, _t5_bucket(t[None, None, :, None, None] - pos_sel)]
        s_sel = jnp.where(valid[:, None], s_sel + bias_sel.astype(jnp.float32), NEG_INF)
        k_own = lax.dynamic_slice_in_dim(kh, own * MOBA_BLOCK, MOBA_BLOCK, axis=2)
        v_own = lax.dynamic_slice_in_dim(vh, own * MOBA_BLOCK, MOBA_BLOCK, axis=2)
        s_own = jnp.einsum('bhqd,bhkd->bhqk', qc, k_own).astype(jnp.float32) * scale
        dist_own = t[:, None] - (own * MOBA_BLOCK + jnp.arange(MOBA_BLOCK))[None, :]
        bias_own = tab[_t5_bucket(dist_own)].transpose(2, 0, 1)
        s_own = jnp.where(dist_own >= 0, s_own + bias_own.astype(jnp.float32), NEG_INF)
        logits = jnp.concatenate([s_sel.reshape(B, H, MOBA_Q_CHUNK, MOBA_TOPK * MOBA_BLOCK), s_own], axis=-1)
        p = jax.nn.softmax(logits, axis=-1).astype(v.dtype)
        p_sel = p[..., :MOBA_TOPK * MOBA_BLOCK].reshape(B, H, MOBA_Q_CHUNK, MOBA_TOPK, MOBA_BLOCK)
        p_own = p[..., MOBA_TOPK * MOBA_BLOCK:]
        return (jnp.einsum('bhqnk,bhqnkd->bhqd', p_sel, vs)
                + jnp.einsum('bhqk,bhkd->bhqd', p_own, v_own))

    o = lax.map(chunk, jnp.arange(T // MOBA_Q_CHUNK))
    return o.transpose(1, 0, 3, 2, 4).reshape(B, T, H * d)


def dsa_attention(q, c_kv, q_idx, k_idx, w_idx, w_uk, w_uv, tab):
    B, T, H, d = q.shape
    n_top = min(DSA_TOPK, T // 4)
    key_pos = jnp.arange(T)
    bi = jnp.arange(B)[:, None, None]
    scale = d ** -0.5

    def chunk(i):
        q0 = i * DSA_Q_CHUNK
        t = q0 + jnp.arange(DSA_Q_CHUNK)
        qi = lax.dynamic_slice_in_dim(q_idx, q0, DSA_Q_CHUNK, axis=1)
        wi = lax.dynamic_slice_in_dim(w_idx, q0, DSA_Q_CHUNK, axis=1)
        qc = lax.dynamic_slice_in_dim(q, q0, DSA_Q_CHUNK, axis=1)
        rel = jax.nn.relu(jnp.einsum('bqhe,bse->bqhs', qi, k_idx).astype(jnp.float32) * IDX_DIM ** -0.5)
        score = jnp.einsum('bqhs,bqh->bqs', rel, wi.astype(jnp.float32))
        score = jnp.where(key_pos[None, :] <= t[:, None], score, NEG_INF)
        _, sel = lax.top_k(score, n_top)
        valid = jnp.arange(n_top)[None, :] < (t + 1)[:, None]
        c_sel = c_kv[bi, sel]
        q_lat = jnp.einsum('bqhd,hcd->bqhc', qc, w_uk)
        s = jnp.einsum('bqhc,bqkc->bhqk', q_lat, c_sel).astype(jnp.float32) * scale
        bias = tab[_t5_bucket(t[None, :, None] - sel)].transpose(0, 3, 1, 2)
        s = jnp.where(valid, s + bias.astype(jnp.float32), NEG_INF)
        p = jax.nn.softmax(s, axis=-1).astype(c_kv.dtype)
        o_lat = jnp.einsum('bhqk,bqkc->bqhc', p, c_sel)
        return jnp.einsum('bqhc,hcd->bqhd', o_lat, w_uv)

    o = lax.map(chunk, jnp.arange(T // DSA_Q_CHUNK))
    return o.transpose(1, 0, 2, 3, 4).reshape(B, T, H * d)


def hybrid_layer(x, rel_bias, w_in, diff_lambda, diff_subln_g, kv_norm_g, w_uk, w_uv, w_o,
                 ln1_g, ln1_b, w_up, w_down, ln2_g, ln2_b, layer_idx):
    B, T, _ = x.shape
    proj = x @ w_in
    offs = np.cumsum(IN_SIZES)[:-1].tolist()
    dq, dk, dv, mq, mk, mv, cq, ckv, iq, ik, iw = jnp.split(proj, offs, axis=-1)
    lambda_init = 0.8 - 0.6 * math.exp(-0.3 * layer_idx)
    c0 = 2 * DIFF_HEADS
    c1 = c0 + MOBA_HEADS
    y_diff = diff_attention(dq.reshape(B, T, DIFF_HEADS, 2, HEAD_DIM),
                            dk.reshape(B, T, DIFF_HEADS, 2, HEAD_DIM),
                            dv.reshape(B, T, DIFF_HEADS, DIFF_DV),
                            diff_lambda, diff_subln_g, rel_bias[:, :c0], lambda_init)
    y_moba = moba_attention(mq.reshape(B, T, MOBA_HEADS, HEAD_DIM),
                            mk.reshape(B, T, MOBA_HEADS, HEAD_DIM),
                            mv.reshape(B, T, MOBA_HEADS, HEAD_DIM), rel_bias[:, c0:c1])
    y_dsa = dsa_attention(cq.reshape(B, T, DSA_HEADS, HEAD_DIM), _rms_norm(ckv, kv_norm_g),
                          iq.reshape(B, T, IDX_HEADS, IDX_DIM), _standardize(ik),
                          iw * IDX_HEADS ** -0.5, w_uk, w_uv, rel_bias[:, c1:])
    y = jnp.concatenate([y_diff, y_moba, y_dsa], axis=-1) @ w_o
    x = _layer_norm(ALPHA * x + y, ln1_g, ln1_b)
    h = jax.nn.relu(x @ w_up)
    x = _layer_norm(ALPHA * x + (h * h) @ w_down, ln2_g, ln2_b)
    return x


def setup_inputs(seed: int = 0) -> dict:
    key = jax.random.key(seed)
    ks = jax.random.split(key, 17)
    f32 = jnp.float32
    nrm = lambda k, shape: jax.random.normal(k, shape, f32)
    return {
        'x': nrm(ks[0], (BATCH, SEQ, D_MODEL)),
        'ln_emb_g': 1.0 + 0.02 * nrm(ks[1], (D_MODEL,)),
        'ln_emb_b': 0.02 * nrm(ks[2], (D_MODEL,)),
        'rel_bias': 0.2 * nrm(ks[3], (NUM_BUCKETS, N_BIAS_COLS)),
        'w_in': nrm(ks[4], (DEPTH, D_MODEL, D_IN)) * D_MODEL ** -0.5,
        'diff_lambda': 0.1 * nrm(ks[5], (DEPTH, 4, HEAD_DIM)),
        'diff_subln_g': 1.0 + 0.02 * nrm(ks[6], (DEPTH, DIFF_DV)),
        'kv_norm_g': 1.0 + 0.02 * nrm(ks[7], (DEPTH, KV_LATENT)),
        'w_uk': nrm(ks[8], (DEPTH, DSA_HEADS, KV_LATENT, HEAD_DIM)) * KV_LATENT ** -0.5,
        'w_uv': nrm(ks[9], (DEPTH, DSA_HEADS, KV_LATENT, HEAD_DIM)) * KV_LATENT ** -0.5,
        'w_o': nrm(ks[10], (DEPTH, MIX_WIDTH, D_MODEL)) * (MIX_WIDTH ** -0.5 * BETA),
        'ln1_g': 1.0 + 0.02 * nrm(ks[11], (DEPTH, D_MODEL)),
        'ln1_b': 0.02 * nrm(ks[12], (DEPTH, D_MODEL)),
        'w_up': nrm(ks[13], (DEPTH, D_MODEL, D_FF)) * D_MODEL ** -0.5,
        'w_down': nrm(ks[14], (DEPTH, D_FF, D_MODEL)) * (D_FF ** -0.5 * BETA),
        'ln2_g': 1.0 + 0.02 * nrm(ks[15], (DEPTH, D_MODEL)),
        'ln2_b': 0.02 * nrm(ks[16], (DEPTH, D_MODEL)),
    }


def reference(x, ln_emb_g, ln_emb_b, rel_bias, w_in, diff_lambda, diff_subln_g, kv_norm_g,
              w_uk, w_uv, w_o, ln1_g, ln1_b, w_up, w_down, ln2_g, ln2_b):
    h = _layer_norm(x, ln_emb_g, ln_emb_b)
    for l in range(DEPTH):
        h = hybrid_layer(h, rel_bias, w_in[l], diff_lambda[l], diff_subln_g[l], kv_norm_g[l],
                         w_uk[l], w_uv[l], w_o[l], ln1_g[l], ln1_b[l], w_up[l], w_down[l],
                         ln2_g[l], ln2_b[l], l)
    return h
```

```cpp
#include <hip/hip_runtime.h>
#include <cstdio>
#include <cstdint>
#include <cmath>
namespace pg8 {
#define PG8_LAS __attribute__((address_space(3)))
typedef unsigned short bf16_t;
typedef short bf16x8 __attribute__((ext_vector_type(8)));
typedef float f32x4 __attribute__((ext_vector_type(4)));
typedef unsigned u32x4 __attribute__((ext_vector_type(4)));
constexpr int BM = 256, BK = 64, HALF = 128, HTB = HALF * BK * 2  , STAGE_BYTES = 8 * HTB, NXCD = 8, WGM = 8;

__host__ __device__ __forceinline__ int lds_byte(int r, int c) { const int st = (r >> 4) * 2 + (c >> 5), rr = r & 15, cc = c & 31, ob = rr * 64 + cc * 2; return st * 1024 + (ob ^ (((ob >> 9) & 1) << 5)); }
__host__ __device__ __forceinline__ void stage_rc(int b, int& R, int& C) { const int st = b / 1024, sb = b % 1024, swz = sb ^ (((sb >> 9) & 1) << 5); R = (st >> 1) * 16 + swz / 64; C = (st & 1) * 32 + (swz % 64) / 2; }
__host__ __device__ __forceinline__ int perm32(int rho) { const int n = rho >> 4, i = rho & 15; return 8 * (i >> 2) + 4 * n + (i & 3); }

struct Unit { int pm, pn; };
struct Gemm { const bf16_t* A; const bf16_t* Bt; int M, N, K; };

struct StaticOrder {
    int nM, nN, nwg, G, c;
    __host__ __device__ void init(int M, int N, int G_, int c_) { nM = M / BM; nN = N / BM; nwg = nM * nN; G = G_; c = c_; }
    __host__ __device__ bool next(int i, Unit& u) const {
        const long L = (long)i * G + c; if (L >= nwg) return false;
        int wgid = (int)L; { const int q = nwg / NXCD, r = nwg % NXCD, xcd = wgid % NXCD, off = wgid / NXCD; wgid = (xcd < r ? xcd * (q + 1) : r * (q + 1) + (xcd - r) * q) + off; }
        const int nig = WGM * nN, gid = wgid / nig, fm = gid * WGM, gsz = (nM - fm) < WGM ? (nM - fm) : WGM;
        u.pm = fm + ((wgid % nig) % gsz); u.pn = (wgid % nig) / gsz; return true;
    }
    __device__ __forceinline__ void a_ready(const Unit&) const {}
    __device__ __forceinline__ void done(const Unit&) const {}
};


__device__ __forceinline__ unsigned cvt_pk_bf16(float lo, float hi) { unsigned r; asm volatile("v_cvt_pk_bf16_f32 %0, %1, %2" : "=v"(r) : "v"(lo), "v"(hi)); return r; }
template <int ACT> struct EpiBf16 {
    static constexpr bool PERM = true, AFTER_DRAIN = false;
    bf16_t* O; int ldc;
    __device__ __forceinline__ void operator()(const f32x4 (&acc)[2][2][4][2], const Unit& u, int wr, int wc, int fr, int fq) const {
        const int row0 = u.pm * BM + wr * 64 + fr, col0 = u.pn * BM + wc * 32 + 8 * fq;
#pragma unroll
        for (int ai = 0; ai < 2; ++ai)
#pragma unroll
            for (int m = 0; m < 4; ++m) { bf16_t* rowp = O + (size_t)(row0 + ai * HALF + m * 16) * ldc + col0;
#pragma unroll
                for (int bj = 0; bj < 2; ++bj) { f32x4 v0 = acc[ai][bj][m][0], v1 = acc[ai][bj][m][1];
                    if (ACT == 1) {
#pragma unroll
                        for (int j = 0; j < 4; ++j) { const float a = fmaxf(v0[j], 0.f), b = fmaxf(v1[j], 0.f); v0[j] = a * a; v1[j] = b * b; } }
                    u32x4 w; w.x = cvt_pk_bf16(v0[0], v0[1]); w.y = cvt_pk_bf16(v0[2], v0[3]); w.z = cvt_pk_bf16(v1[0], v1[1]); w.w = cvt_pk_bf16(v1[2], v1[3]);
                    *(u32x4*)(rowp + bj * HALF) = w; } }
    }
};
struct EpiResBf16 {
    static constexpr bool PERM = true, AFTER_DRAIN = false;
    bf16_t* C; const bf16_t* R; int ldc; float alpha;
    __device__ __forceinline__ void operator()(const f32x4 (&acc)[2][2][4][2], const Unit& u, int wr, int wc, int fr, int fq) const {
        const int row0 = u.pm * BM + wr * 64 + fr, col0 = u.pn * BM + wc * 32 + 8 * fq;
#pragma unroll
        for (int ai = 0; ai < 2; ++ai)
#pragma unroll
            for (int m = 0; m < 4; ++m) { const size_t off = (size_t)(row0 + ai * HALF + m * 16) * ldc + col0;
#pragma unroll
                for (int bj = 0; bj < 2; ++bj) { const u32x4 rv = *(const u32x4*)(R + off + bj * HALF); const f32x4 v0 = acc[ai][bj][m][0], v1 = acc[ai][bj][m][1];
#define PG8_BL(w) __builtin_bit_cast(float, (w) << 16)
#define PG8_BH(w) __builtin_bit_cast(float, (w) & 0xffff0000u)
                    u32x4 w; w.x = cvt_pk_bf16(PG8_BL(rv.x) * alpha + v0[0], PG8_BH(rv.x) * alpha + v0[1]); w.y = cvt_pk_bf16(PG8_BL(rv.y) * alpha + v0[2], PG8_BH(rv.y) * alpha + v0[3]);
                    w.z = cvt_pk_bf16(PG8_BL(rv.z) * alpha + v1[0], PG8_BH(rv.z) * alpha + v1[1]); w.w = cvt_pk_bf16(PG8_BL(rv.w) * alpha + v1[2], PG8_BH(rv.w) * alpha + v1[3]);
#undef PG8_BL
#undef PG8_BH
                    *(u32x4*)(C + off + bj * HALF) = w; } }
    }
};

template <class Epi, class Sched, bool ALIGN_EPI = false, bool SP2 = false>
__device__ __forceinline__ void gemm_phase(PG8_LAS unsigned char* lds, const Gemm g, const Sched& S, const Epi& E, int wave_) {
    int lane_; asm volatile("v_mbcnt_lo_u32_b32 %0, -1, 0\n\tv_mbcnt_hi_u32_b32 %0, -1, %0" : "=v"(lane_));
    const int wid = wave_, lane = lane_, tid = wid * 64 + lane, wr = wid >> 2, wc = wid & 3, fr = lane & 15, fq = lane >> 4;
    const int K = g.K, nt = K / BK;
    unsigned voffA[2], voffB[2];
#pragma unroll
    for (int i = 0; i < 2; ++i) { int R, C; stage_rc(tid * 16 + i * 8192, R, C); const int Rb = Epi::PERM ? ((R & ~31) + perm32(R & 31)) : R;
        voffA[i] = (unsigned)(R * K + C) * 2u; voffB[i] = (unsigned)(Rb * K + C) * 2u; }
    const size_t kstep = (size_t)(BK * 2);
    const size_t hstep = (size_t)HALF * K * 2;
    const size_t tstep = 2 * hstep;
    const unsigned ldsw = (unsigned)wid * 1024u;
    const int aoff = lds_byte(wr * 64 + fr, fq * 8), boff = lds_byte(wc * 32 + fr, fq * 8);
#define PG8_SA(b, h) (((b) * 2 + (h)) * HTB)
#define PG8_SB(b, h) ((4 + (b) * 2 + (h)) * HTB)
#define PG8_STAGE(bufoff, gbase, voff) do { _Pragma("unroll") for (int _i = 0; _i < 2; ++_i) \
        __builtin_amdgcn_global_load_lds((const unsigned*)((const char*)(gbase) + (voff)[_i]), (PG8_LAS unsigned*)(lds + (bufoff) + ldsw + _i * 8192), 16, 0, 0); } while (0)
#define PG8_LDA(dst, b, h) do { _Pragma("unroll") for (int m = 0; m < 4; ++m) _Pragma("unroll") for (int k = 0; k < 2; ++k) dst[m][k] = *(const PG8_LAS bf16x8*)(lds + PG8_SA(b, h) + aoff + m * 2048 + k * 1024); } while (0)
#define PG8_LDB(dst, b, h) do { _Pragma("unroll") for (int n = 0; n < 2; ++n) _Pragma("unroll") for (int k = 0; k < 2; ++k) dst[n][k] = *(const PG8_LAS bf16x8*)(lds + PG8_SB(b, h) + boff + n * 2048 + k * 1024); } while (0)
#define PG8_MMA(ai, bj, At, Bt) do { __builtin_amdgcn_s_setprio(1); _Pragma("unroll") for (int m = 0; m < 4; ++m) _Pragma("unroll") for (int n = 0; n < 2; ++n) _Pragma("unroll") for (int k = 0; k < 2; ++k) \
        acc[ai][bj][m][n] = __builtin_amdgcn_mfma_f32_16x16x32_bf16(Bt[n][k], At[m][k], acc[ai][bj][m][n], 0, 0, 0); __builtin_amdgcn_s_setprio(0); } while (0)
#define PG8_WAIT_V(n) asm volatile("s_waitcnt vmcnt(" #n ")" ::: "memory")
#define PG8_WAIT_L(n) asm volatile("s_waitcnt lgkmcnt(" #n ")" ::: "memory")
#define PG8_BAR __builtin_amdgcn_s_barrier()
#define PG8_SCHED __builtin_amdgcn_sched_barrier(0)
    Unit cur, nxt; int ui = 0;
    if (!S.next(0, cur)) return;
    f32x4 acc[2][2][4][2];
#pragma unroll
    for (int a = 0; a < 2; ++a)
#pragma unroll
        for (int b = 0; b < 2; ++b)
#pragma unroll
            for (int m = 0; m < 4; ++m)
#pragma unroll
                for (int n = 0; n < 2; ++n) acc[a][b][m][n] = (f32x4){0.f, 0.f, 0.f, 0.f};
    bf16x8 At[4][2], B0[2][2], B1[2][2];
    const char* cA = (const char*)g.A + (size_t)cur.pm * tstep; const char* cB = (const char*)g.Bt + (size_t)cur.pn * tstep;
    S.a_ready(cur);
    if constexpr (SP2) {
        PG8_STAGE(PG8_SB(0, 0), cB, voffB); PG8_STAGE(PG8_SB(0, 1), cB + hstep, voffB); PG8_STAGE(PG8_SA(0, 0), cA, voffA); PG8_STAGE(PG8_SA(0, 1), cA + hstep, voffA);
        if (wr == 1) PG8_BAR;
        PG8_WAIT_V(2); PG8_BAR;
        PG8_STAGE(PG8_SB(1, 0), cB + kstep, voffB); PG8_STAGE(PG8_SA(1, 0), cA + kstep, voffA); PG8_STAGE(PG8_SB(1, 1), cB + hstep + kstep, voffB);
        PG8_WAIT_V(6); PG8_BAR;
    } else {
        PG8_STAGE(PG8_SB(0, 0), cB, voffB); PG8_STAGE(PG8_SA(0, 0), cA, voffA); PG8_STAGE(PG8_SB(0, 1), cB + hstep, voffB); PG8_STAGE(PG8_SA(0, 1), cA + hstep, voffA);
        if (wr == 1) PG8_BAR;
        PG8_WAIT_V(4); PG8_BAR;
        PG8_STAGE(PG8_SB(1, 0), cB + kstep, voffB); PG8_STAGE(PG8_SA(1, 0), cA + kstep, voffA); PG8_STAGE(PG8_SB(1, 1), cB + hstep + kstep, voffB);
        PG8_WAIT_V(6); PG8_BAR;
    }
    for (;;) {
        const bool has_next = S.next(ui + 1, nxt);
        const char* nA = has_next ? (const char*)g.A + (size_t)nxt.pm * tstep : cA; const char* nB = has_next ? (const char*)g.Bt + (size_t)nxt.pn * tstep : cB;
        for (int t = 0; t < nt; t += 2) {
            const bool last = (t == nt - 2);
            const char* a1 = cA + (size_t)(t + 1) * kstep;
            const char* a2 = last ? nA : cA + (size_t)(t + 2) * kstep; const char* b2 = last ? nB : cB + (size_t)(t + 2) * kstep;
            const char* a3 = a2 + kstep; const char* b3 = b2 + kstep;
            if (last && has_next) S.a_ready(nxt);
            if constexpr (SP2) {
            PG8_LDB(B0, 0, 0); PG8_LDB(B1, 0, 1); PG8_SCHED; PG8_LDA(At, 0, 0); PG8_STAGE(PG8_SA(1, 1), a1 + hstep, voffA);
            PG8_WAIT_V(8); PG8_WAIT_L(0); PG8_BAR; PG8_MMA(0, 0, At, B0); PG8_MMA(0, 1, At, B1); PG8_BAR; PG8_SCHED;
            PG8_LDA(At, 0, 1); PG8_STAGE(PG8_SB(0, 0), b2, voffB); PG8_STAGE(PG8_SB(0, 1), b2 + hstep, voffB); PG8_STAGE(PG8_SA(0, 0), a2, voffA);
            PG8_WAIT_V(8); PG8_WAIT_L(0); PG8_BAR; PG8_MMA(1, 0, At, B0); PG8_MMA(1, 1, At, B1); PG8_BAR; PG8_SCHED;
            PG8_LDB(B0, 1, 0); PG8_LDB(B1, 1, 1); PG8_SCHED; PG8_LDA(At, 1, 0); PG8_STAGE(PG8_SA(0, 1), a2 + hstep, voffA);
            PG8_WAIT_V(8); PG8_WAIT_L(0); PG8_BAR; PG8_MMA(0, 0, At, B0); PG8_MMA(0, 1, At, B1); PG8_BAR; PG8_SCHED;
            PG8_LDA(At, 1, 1); PG8_STAGE(PG8_SB(1, 0), b3, voffB); PG8_STAGE(PG8_SB(1, 1), b3 + hstep, voffB); PG8_STAGE(PG8_SA(1, 0), a3, voffA);
            PG8_WAIT_V(8); PG8_WAIT_L(0); PG8_BAR; PG8_MMA(1, 0, At, B0); PG8_MMA(1, 1, At, B1); PG8_BAR; PG8_SCHED;
            } else {
            PG8_LDB(B0, 0, 0); PG8_SCHED; PG8_LDA(At, 0, 0); PG8_STAGE(PG8_SA(1, 1), a1 + hstep, voffA);
            PG8_WAIT_L(8); PG8_BAR; PG8_WAIT_L(0); PG8_MMA(0, 0, At, B0); PG8_BAR; PG8_SCHED;
            PG8_LDB(B1, 0, 1); PG8_STAGE(PG8_SB(0, 0), b2, voffB);
            PG8_BAR; PG8_WAIT_L(0); PG8_MMA(0, 1, At, B1); PG8_BAR;
            PG8_LDA(At, 0, 1); PG8_STAGE(PG8_SA(0, 0), a2, voffA);
            PG8_BAR; PG8_WAIT_L(0); PG8_MMA(1, 0, At, B0); PG8_BAR; PG8_SCHED;
            PG8_STAGE(PG8_SB(0, 1), b2 + hstep, voffB);
            PG8_WAIT_V(6); PG8_BAR; PG8_MMA(1, 1, At, B1); PG8_BAR;
            PG8_LDB(B0, 1, 0); PG8_SCHED; PG8_LDA(At, 1, 0); PG8_STAGE(PG8_SA(0, 1), a2 + hstep, voffA);
            PG8_WAIT_L(8); PG8_BAR; PG8_WAIT_L(0); PG8_MMA(0, 0, At, B0); PG8_BAR; PG8_SCHED;
            PG8_LDB(B1, 1, 1); PG8_STAGE(PG8_SB(1, 0), b3, voffB);
            PG8_BAR; PG8_WAIT_L(0); PG8_MMA(0, 1, At, B1); PG8_BAR;
            PG8_LDA(At, 1, 1); PG8_STAGE(PG8_SA(1, 0), a3, voffA);
            PG8_BAR; PG8_WAIT_L(0); PG8_MMA(1, 0, At, B0); PG8_BAR; PG8_SCHED;
            PG8_STAGE(PG8_SB(1, 1), b3 + hstep, voffB);
            PG8_WAIT_V(6); PG8_BAR; PG8_MMA(1, 1, At, B1); PG8_BAR;
            }
        }
        if constexpr (ALIGN_EPI) { if (wr == 0) PG8_BAR; }
        if constexpr (!Epi::AFTER_DRAIN) { E(acc, cur, wr, wc, fr, fq); S.done(cur); }
        if (!has_next) break;
#pragma unroll
        for (int a = 0; a < 2; ++a)
#pragma unroll
            for (int b = 0; b < 2; ++b)
#pragma unroll
                for (int m = 0; m < 4; ++m)
#pragma unroll
                    for (int n = 0; n < 2; ++n) acc[a][b][m][n] = (f32x4){0.f, 0.f, 0.f, 0.f};
        cur = nxt; cA = nA; cB = nB; ++ui;
        if constexpr (ALIGN_EPI) { if (wr == 1) PG8_BAR; }
    }
    PG8_WAIT_V(0);
    if constexpr (!ALIGN_EPI) { if (wr == 0) PG8_BAR; }
    PG8_BAR;
    if constexpr (Epi::AFTER_DRAIN) { E.fused(acc, cur, wr, wc, fr, fq, lds, wid, lane); S.done(cur); }
#undef PG8_SA
#undef PG8_SB
#undef PG8_STAGE
#undef PG8_LDA
#undef PG8_LDB
#undef PG8_MMA
#undef PG8_WAIT_V
#undef PG8_WAIT_L
#undef PG8_BAR
#undef PG8_SCHED
}
}


#ifndef PG8_SP2
#define PG8_SP2 true
#endif
#ifndef PG8_ALIGN
#define PG8_ALIGN true
#endif
constexpr int NB = 2, T = 4096, DM = 4096, M = NB * T, DEPTH = 2, HD = 128;
constexpr int DIFF_H = 6, MOBA_H = 10, DSA_H = 10, KVL = 512, IDX_H = 32, IDX_D = 64, DFF = 16384, DIN = 12384, DINM = 12288, NTAIL = 96;
constexpr int O_DQ = 0, O_DK = 1536, O_DV = 3072, O_MQ = 4608, O_MK = 5888, O_MV = 7168, O_CQ = 8448, O_CKV = 9728, O_IQ = 10240, O_IK = 12288, O_IW = 12352;
constexpr float ALPHA = 1.4142135623730951f;
constexpr float LN_EPS = 1e-5f, RMS_EPS = 1e-5f, NEG_INF = -1e30f;
constexpr float SCALE = 0.08838834764831845f;
constexpr int NWAVES = 8;

constexpr size_t MiB = 1u << 20;
constexpr size_t WS_CTL = 0, CTL_ZERO_BYTES = 1 * MiB;
constexpr size_t SZ_WIN = 97 * MiB, SZ_WO = 32 * MiB, SZ_WUP = 128 * MiB, SZ_WDN = 128 * MiB, SZ_WL = SZ_WIN + SZ_WO + SZ_WUP + SZ_WDN;
constexpr size_t WS_W = 1 * MiB;
constexpr size_t WS_WUK = WS_W + 2 * SZ_WL;
constexpr size_t WS_WUVT = WS_WUK + 3 * MiB;
constexpr size_t WS_H = WS_WUVT + 3 * MiB;
constexpr size_t WS_XN = WS_H + 128 * MiB;
constexpr size_t WS_PROJ = WS_XN + 64 * MiB;
constexpr size_t WS_TAIL = WS_PROJ + 192 * MiB;
constexpr size_t WS_Y = WS_TAIL + 3 * MiB;
constexpr size_t WS_Z = WS_Y + 64 * MiB;
constexpr size_t WS_HID = WS_Z + 128 * MiB;
constexpr size_t WS_QLAT = WS_HID + 256 * MiB;
constexpr size_t WS_OLAT = WS_QLAT + 80 * MiB;
constexpr size_t WS_DIFFO = WS_OLAT + 80 * MiB;
constexpr size_t WS_CKVN = WS_DIFFO + 48 * MiB;
constexpr size_t WS_KI = WS_CKVN + 8 * MiB;
constexpr size_t WS_WI = WS_KI + 1 * MiB;
constexpr size_t WS_KMEAN = WS_WI + 1 * MiB;
constexpr size_t WS_MMASK = WS_KMEAN + 1 * MiB;
constexpr size_t WS_SEL = WS_MMASK + 1 * MiB;
constexpr size_t WS_END = WS_SEL + 4 * MiB;
static_assert(WS_END <= (size_t)2047 * MiB, "d_ws map must fit 4x the largest tensor (2048 MiB)");
constexpr int CW_TMO = 0, CW_CODE = 1;
constexpr int CW_BAR = 4096;
constexpr int MAX_LAUNCHES = 40;

constexpr int RING_OFF = 0, RING_BYTES = 159744;
constexpr int LDSCTL_OFF = RING_BYTES, MISC_OFF = LDSCTL_OFF + 320;
constexpr int LDS_BYTES = 163840;
static_assert(MISC_OFF + 128 <= LDS_BYTES, "LDS map");

#define GAS __attribute__((address_space(1)))
#define LAS __attribute__((address_space(3)))
typedef unsigned short bf16;
typedef unsigned v4u __attribute__((ext_vector_type(4)));
typedef unsigned v2u __attribute__((ext_vector_type(2)));
typedef float f32x4 __attribute__((ext_vector_type(4)));
typedef float f32x16 __attribute__((ext_vector_type(16)));
typedef short bf16x8 __attribute__((ext_vector_type(8)));
typedef short s16x4 __attribute__((ext_vector_type(4)));
typedef GAS unsigned gu32;
typedef GAS unsigned long long gu64;
#define RLX_AGENT __ATOMIC_RELAXED, __HIP_MEMORY_SCOPE_AGENT
#define LDS_WAIT() asm volatile("s_waitcnt lgkmcnt(0)" ::: "memory")
#define VM_WAIT() asm volatile("s_waitcnt vmcnt(0)" ::: "memory")
__device__ __forceinline__ unsigned f2bf(float f) { unsigned u = __builtin_bit_cast(unsigned, f); return (u + 0x7fffu + ((u >> 16) & 1u)) >> 16; }
__device__ __forceinline__ unsigned pk2(float lo, float hi) { return f2bf(lo) | (f2bf(hi) << 16); }
__device__ __forceinline__ float bf2f(unsigned short b) { return __builtin_bit_cast(float, (unsigned)b << 16); }
__device__ __forceinline__ float bflo(unsigned w) { return __builtin_bit_cast(float, w << 16); }
__device__ __forceinline__ float bfhi(unsigned w) { return __builtin_bit_cast(float, w & 0xffff0000u); }

__device__ __forceinline__ int lane_now() { int l; asm volatile("v_mbcnt_lo_u32_b32 %0, -1, 0\n\tv_mbcnt_hi_u32_b32 %0, -1, %0" : "=v"(l)); return l; }
__constant__ unsigned char c_bucket[128] = {0, 1, 2, 3, 4, 5, 6, 7, 8, 9, 10, 11, 12, 13, 14, 15, 16, 16, 16, 17, 17, 18, 18, 18, 19, 19, 19, 20, 20, 20, 20, 21, 21, 21, 21, 22, 22, 22, 22, 22, 23, 23, 23, 23, 23, 23, 24, 24, 24, 24, 24, 24, 25, 25, 25, 25, 25, 25, 25, 26, 26, 26, 26, 26, 26, 26, 26, 27, 27, 27, 27, 27, 27, 27, 27, 27, 27, 28, 28, 28, 28, 28, 28, 28, 28, 28, 28, 29, 29, 29, 29, 29, 29, 29, 29, 29, 29, 29, 29, 30, 30, 30, 30, 30, 30, 30, 30, 30, 30, 30, 30, 30, 30, 31, 31, 31, 31, 31, 31, 31, 31, 31, 31, 31, 31, 31, 31, 31};
__device__ __forceinline__ int bucket(int dist) { return dist < 0 ? 0 : (dist > 127 ? 31 : (int)c_bucket[dist]); }


#define XB_TMO      128
#define XB_XCNT(j)  (256  + 64 * (j))
#define XB_XSUB(j)  (1280 + 64 * (j))
#define XB_XGEN(j)  (2304 + 64 * (j))
#define XB_TOP      3328
#define XB_TOPGEN   3392
#define XCD_BAR_WORDS 3456
#define XB_SPIN_CAP (1u << 18)

__device__ __forceinline__ unsigned xb_ld(unsigned* p)              { return __hip_atomic_load(p, __ATOMIC_RELAXED, __HIP_MEMORY_SCOPE_AGENT); }
__device__ __forceinline__ unsigned xb_add(unsigned* p, unsigned v) { return __hip_atomic_fetch_add(p, v, __ATOMIC_RELAXED, __HIP_MEMORY_SCOPE_AGENT); }
__device__ __forceinline__ unsigned xb_xcc_id() { return (unsigned)__builtin_amdgcn_s_getreg((3 << 11) | 20) & 0xFu; }
#define XB_SPIN(cond, bar) do { unsigned _sp = 0; while (cond) { __builtin_amdgcn_s_sleep(1); \
    if ((++_sp & 255u) == 0u) { if (xb_ld(&(bar)[XB_TMO])) break; if (_sp > XB_SPIN_CAP) { atomicAdd(&(bar)[XB_TMO], 1u); break; } } } } while (0)

struct XcdBarrier {
    unsigned* bar; unsigned x;
    int wave;
    volatile LAS unsigned* st;
};

__device__ __forceinline__ XcdBarrier xcd_barrier_post(unsigned* bar, volatile LAS unsigned* st, int wave) {
    XcdBarrier b; b.bar = bar; b.x = xb_xcc_id(); b.st = st; b.wave = wave;
    if (wave == 0 && lane_now() == 0) (void)xb_add(&bar[XB_XCNT(b.x)], 1u);
    return b;
}
__device__ __forceinline__ void xcd_barrier_complete(unsigned* bar, unsigned x, unsigned& nloc, unsigned& nx) {
    const unsigned G = gridDim.x * gridDim.y * gridDim.z;
    unsigned sum, cnt, mine, sp = 0u;
    for (;;) {
        sum = 0u; cnt = 0u; mine = 0u;
#pragma unroll
        for (unsigned j = 0; j < 16; ++j) { const unsigned c = xb_ld(&bar[XB_XCNT(j)]); sum += c; cnt += (c > 0u) ? 1u : 0u; mine = (j == x) ? c : mine; }
        if (sum == G) break;
        __builtin_amdgcn_s_sleep(1);
        if ((++sp & 255u) == 0u) { if (xb_ld(&bar[XB_TMO])) break; if (sp > XB_SPIN_CAP) { atomicAdd(&bar[XB_TMO], 1u); break; } }
    }
    nloc = mine > 0u ? mine : 1u; nx = cnt > 0u ? cnt : 1u;
}

__device__ __forceinline__ void xcd_barrier(const XcdBarrier& b) {
    asm volatile("s_waitcnt vmcnt(0)" ::: "memory");
    __syncthreads();
    if (b.wave == 0 && lane_now() == 0) {
        unsigned* bar = b.bar;
        __builtin_amdgcn_s_waitcnt(0);
        unsigned nloc = b.st[0], nx = b.st[1];
        if (nloc == 0u) { xcd_barrier_complete(bar, b.x, nloc, nx); b.st[0] = nloc; b.st[1] = nx; }
        const unsigned old = xb_add(&bar[XB_XSUB(b.x)], 1u);
        const unsigned gen = old / nloc;
        if (old + 1u == (gen + 1u) * nloc) {
            __builtin_amdgcn_fence(__ATOMIC_RELEASE, "agent");
            asm volatile("s_waitcnt vmcnt(0)" ::: "memory");
            const unsigned og = xb_add(&bar[XB_TOP], 1u);
            const unsigned tg = og / nx;
            if (og + 1u == (tg + 1u) * nx) xb_add(&bar[XB_TOPGEN], 1u);
            else XB_SPIN(xb_ld(&bar[XB_TOPGEN]) == tg, bar);
            __builtin_amdgcn_fence(__ATOMIC_ACQUIRE, "agent");
            xb_add(&bar[XB_XGEN(b.x)], 1u);
            asm volatile("s_waitcnt vmcnt(0)" ::: "memory");
        } else {
            XB_SPIN(xb_ld(&bar[XB_XGEN(b.x)]) == gen, bar);
            __builtin_amdgcn_fence(__ATOMIC_ACQUIRE, "agent");
            asm volatile("s_waitcnt vmcnt(0)" ::: "memory");
        }
    }
    __syncthreads();
}


struct Frame {
    LAS unsigned char* lds;
    volatile LAS unsigned* MISC;
    gu32* ctl;
    int wave;
    int vcu, G;
    unsigned char* ws;
};
#define WSL(F) ws_opaque((F).ws)
#define WAVE(F) int_opaque((F).wave)
#define VCU(F) int_opaque((F).vcu)
__device__ __forceinline__ int int_opaque(int v) { asm volatile("" : "+s"(v)); return v; }
__device__ __forceinline__ unsigned char* ws_opaque(unsigned char* p) { asm volatile("" : "+s"(p)); return p; }
typedef const __attribute__((address_space(4))) char* kseg_t;
__device__ __forceinline__ const float* karg(int i) { kseg_t ka = (kseg_t)__builtin_amdgcn_kernarg_segment_ptr(); asm volatile("" : "+s"(ka)); return *(const float* const __attribute__((address_space(4)))*)(ka + 8 * i); }
__device__ __forceinline__ float wave_sum(float v) {
    v += __builtin_bit_cast(float, __builtin_amdgcn_mov_dpp(__builtin_bit_cast(int, v), 0xB1, 0xF, 0xF, true));
    v += __builtin_bit_cast(float, __builtin_amdgcn_mov_dpp(__builtin_bit_cast(int, v), 0x4E, 0xF, 0xF, true));
    v += __builtin_bit_cast(float, __builtin_amdgcn_mov_dpp(__builtin_bit_cast(int, v), 0x141, 0xF, 0xF, true));
    v += __builtin_bit_cast(float, __builtin_amdgcn_mov_dpp(__builtin_bit_cast(int, v), 0x140, 0xF, 0xF, true));
    { auto r = __builtin_amdgcn_permlane16_swap(__float_as_uint(v), __float_as_uint(v), false, false); v = __uint_as_float(r[0]) + __uint_as_float(r[1]); }
    { auto r = __builtin_amdgcn_permlane32_swap(__float_as_uint(v), __float_as_uint(v), false, false); v = __uint_as_float(r[0]) + __uint_as_float(r[1]); }
    return v;
}
__device__ __forceinline__ void p0_transpose_item(const float* W, int K, int N, bf16* WT, int row_off, LAS float* scr, int item, int lane) {
    const int nblk = N / 32, kb = item / nblk, nb = item % nblk, k0 = 64 * kb, n0 = 32 * nb;
    float wv[32];
#pragma unroll
    for (int i = 0; i < 32; ++i) wv[i] = __builtin_nontemporal_load(W + (size_t)(k0 + 2 * i + (lane >> 5)) * N + n0 + (lane & 31));
#pragma unroll
    for (int i = 0; i < 32; ++i) scr[(2 * i + (lane >> 5)) * 33 + (lane & 31)] = wv[i];
    LDS_WAIT(); asm volatile("" ::: "memory");
    const int c = lane & 7;
#pragma unroll
    for (int j = 0; j < 4; ++j) { const int n = (lane >> 3) + 8 * j; const LAS float* s = scr + (8 * c) * 33 + n;
        v4u o; o.x = pk2(s[0 * 33], s[1 * 33]); o.y = pk2(s[2 * 33], s[3 * 33]); o.z = pk2(s[4 * 33], s[5 * 33]); o.w = pk2(s[6 * 33], s[7 * 33]);
        __builtin_nontemporal_store(o, (GAS v4u*)(WT + (size_t)(row_off + n0 + n) * K + k0 + 8 * c)); }
    LDS_WAIT(); asm volatile("" ::: "memory");
}
template <bool IN_BF16>
__device__ __forceinline__ void ln_row(int lane, const void* zrow, const float* g, const float* b, float* hrow, bf16* xrow) {
    f32x4 v[16]; float s = 0.f;
    if (IN_BF16) { const GAS v2u* zr = (const GAS v2u*)zrow + lane;
#pragma unroll
        for (int j = 0; j < 16; ++j) { const v2u w = zr[64 * j]; v[j] = (f32x4){bflo(w.x), bfhi(w.x), bflo(w.y), bfhi(w.y)}; s += (v[j].x + v[j].y) + (v[j].z + v[j].w); } }
    else { const GAS f32x4* zr = (const GAS f32x4*)zrow + lane;
#pragma unroll
        for (int j = 0; j < 16; ++j) { v[j] = zr[64 * j]; s += (v[j].x + v[j].y) + (v[j].z + v[j].w); } }
    const float mean = wave_sum(s) * (1.f / DM); float s2 = 0.f;
#pragma unroll
    for (int j = 0; j < 16; ++j) { v[j] = v[j] - mean; s2 += (v[j].x * v[j].x + v[j].y * v[j].y) + (v[j].z * v[j].z + v[j].w * v[j].w); }
    const float rstd = 1.f / sqrtf(wave_sum(s2) * (1.f / DM) + LN_EPS);
    const GAS f32x4* gr = (const GAS f32x4*)g + lane; const GAS f32x4* br = (const GAS f32x4*)b + lane;
#pragma unroll
    for (int j = 0; j < 16; ++j) { const f32x4 o = v[j] * rstd * gr[64 * j] + br[64 * j];
        if (hrow) ((GAS f32x4*)hrow + lane)[64 * j] = o;
        if (xrow) ((GAS unsigned long long*)xrow + lane)[64 * j] = (unsigned long long)pk2(o.x, o.y) | ((unsigned long long)pk2(o.z, o.w) << 32); }
}
__device__ __forceinline__ bf16* w_layer(Frame& F, int l, int which) {
    const size_t o = WS_W + (size_t)l * SZ_WL + (which == 0 ? 0 : which == 1 ? SZ_WIN : which == 2 ? SZ_WIN + SZ_WO : SZ_WIN + SZ_WO + SZ_WUP);
    return (bf16*)(WSL(F) + o);
}
__device__ __forceinline__ void p0_prologue(Frame& F) {
    const int lane = lane_now();
    const int w_ = WAVE(F); LAS float* scr = (LAS float*)(F.lds + RING_OFF + w_ * 16384);
    const int gw = VCU(F) * NWAVES + w_, NGW = F.G * NWAVES;
    constexpr int I_IN = (DM / 64) * (DIN / 32), I_O = (DM / 64) * (DM / 32), I_UP = (DM / 64) * (DFF / 32), I_DN = (DFF / 64) * (DM / 32), I_UV = (KVL / 64) * (HD / 32) * DSA_H;
    constexpr int PER_L = I_IN + I_O + I_UP + I_DN + I_UV, NITEMS = DEPTH * PER_L;
    for (int it = gw; it < NITEMS; it += NGW) {
        const int l = it / PER_L; int r = it - l * PER_L;
        if (r < I_IN) { p0_transpose_item(karg(4) + (size_t)l * DM * DIN, DM, DIN, w_layer(F, l, 0), 0, scr, r, lane); continue; } r -= I_IN;
        if (r < I_O) { p0_transpose_item(karg(10) + (size_t)l * DM * DM, DM, DM, w_layer(F, l, 1), 0, scr, r, lane); continue; } r -= I_O;
        if (r < I_UP) { p0_transpose_item(karg(13) + (size_t)l * DM * DFF, DM, DFF, w_layer(F, l, 2), 0, scr, r, lane); continue; } r -= I_UP;
        if (r < I_DN) { p0_transpose_item(karg(14) + (size_t)l * DFF * DM, DFF, DM, w_layer(F, l, 3), 0, scr, r, lane); continue; } r -= I_DN;
        { const int h = r / ((KVL / 64) * (HD / 32)), rr = r % ((KVL / 64) * (HD / 32));
          p0_transpose_item(karg(9) + ((size_t)l * DSA_H + h) * KVL * HD, KVL, HD, (bf16*)(WSL(F) + WS_WUVT) + ((size_t)l * DSA_H + h) * HD * KVL, 0, scr, rr, lane); }
    }
    { const GAS f32x4* src = (const GAS f32x4*)karg(8); GAS v2u* dst = (GAS v2u*)(WSL(F) + WS_WUK); const int n4 = DEPTH * DSA_H * KVL * HD / 4;
      for (int i = gw * 64 + lane; i < n4; i += NGW * 64) { const f32x4 v = src[i]; v2u o; o.x = pk2(v.x, v.y); o.y = pk2(v.z, v.w); dst[i] = o; } }
    for (int m = gw; m < M; m += NGW) ln_row<false>(lane, karg(0) + (size_t)m * DM, karg(1), karg(2), nullptr, (bf16*)(WSL(F) + WS_XN) + (size_t)m * DM);
}
__device__ __forceinline__ void tail_phase(Frame& F, const bf16* XN, const bf16* WT, float* TAIL) {
    LAS float* part = (LAS float*)(F.lds + RING_OFF);
    const int lane = lane_now();
    const int w = WAVE(F), fr = lane & 15, fq = lane >> 4;
    for (int unit = VCU(F); unit < M / 32; unit += F.G) {
        const int m0 = unit * 32;
        f32x4 acc[2][6];
#pragma unroll
        for (int i = 0; i < 2; ++i)
#pragma unroll
            for (int j = 0; j < 6; ++j) acc[i][j] = (f32x4){0.f, 0.f, 0.f, 0.f};
        const bf16* ap = XN + (size_t)(m0 + fr) * DM + w * 512 + 8 * fq; const bf16* bp = WT + (size_t)fr * DM + w * 512 + 8 * fq;
#pragma unroll 4
        for (int ks = 0; ks < 16; ++ks) {
            bf16x8 a[2], b[6];
#pragma unroll
            for (int i = 0; i < 2; ++i) a[i] = *(const GAS bf16x8*)(ap + (size_t)i * 16 * DM + ks * 32);
#pragma unroll
            for (int j = 0; j < 6; ++j) b[j] = *(const GAS bf16x8*)(bp + (size_t)j * 16 * DM + ks * 32);
#pragma unroll
            for (int i = 0; i < 2; ++i)
#pragma unroll
                for (int j = 0; j < 6; ++j) acc[i][j] = __builtin_amdgcn_mfma_f32_16x16x32_bf16(a[i], b[j], acc[i][j], 0, 0, 0);
        }
#pragma unroll
        for (int i = 0; i < 2; ++i)
#pragma unroll
            for (int j = 0; j < 6; ++j)
#pragma unroll
                for (int r = 0; r < 4; ++r) part[(w * 32 + i * 16 + fq * 4 + r) * 96 + j * 16 + fr] = acc[i][j][r];
        __syncthreads();
        for (int o = w * 64 + lane; o < 32 * 96; o += NWAVES * 64) { float s = 0.f;
#pragma unroll
            for (int ww = 0; ww < 8; ++ww) s += part[ww * 32 * 96 + o];
            TAIL[(size_t)m0 * 96 + o] = s; }
        __syncthreads();
    }
}
__device__ __forceinline__ void ln_phase(Frame& F, const bf16* Z, const float* g, const float* b, float* Fout, bf16* Xout) {
    const int lane = lane_now();
    const int gw = VCU(F) * NWAVES + WAVE(F), NGW = F.G * NWAVES;
    for (int m = gw; m < M; m += NGW) ln_row<true>(lane, Z + (size_t)m * DM, g, b, Fout ? Fout + (size_t)m * DM : nullptr, Xout ? Xout + (size_t)m * DM : nullptr);
}

__constant__ unsigned short c_attn_sched[256][4] = {{660,132,65535,65535},{661,133,65535,65535},{662,134,65535,65535},{663,135,65535,65535},{664,136,65535,65535},{665,137,65535,65535},{666,138,65535,65535},{667,139,65535,65535},{668,140,65535,65535},{669,141,65535,65535},{670,142,65535,65535},{671,143,65535,65535},{672,144,65535,65535},{673,145,65535,65535},{674,146,65535,65535},{675,147,65535,65535},{676,148,65535,65535},{677,149,65535,65535},{678,150,65535,65535},{679,151,65535,65535},{680,152,65535,65535},{681,153,65535,65535},{682,154,65535,65535},{683,155,65535,65535},{616,196,65535,65535},{617,197,65535,65535},{618,198,65535,65535},{619,199,65535,65535},{620,288,65535,65535},{621,289,65535,65535},{622,290,65535,65535},{623,291,65535,65535},{624,292,65535,65535},{625,293,65535,65535},{626,294,65535,65535},{627,295,65535,65535},{628,296,65535,65535},{629,297,65535,65535},{630,298,65535,65535},{631,299,65535,65535},{632,300,65535,65535},{633,301,65535,65535},{634,302,65535,65535},{635,303,65535,65535},{636,304,65535,65535},{637,305,65535,65535},{638,306,65535,65535},{639,307,65535,65535},{572,348,65535,65535},{573,349,65535,65535},{574,350,65535,65535},{575,351,65535,65535},{576,176,28,65535},{577,177,29,65535},{578,178,30,65535},{579,179,31,65535},{580,180,32,65535},{581,181,33,65535},{582,182,34,65535},{583,183,35,65535},{584,184,36,65535},{585,185,37,65535},{586,186,38,65535},{587,187,39,65535},{588,188,40,65535},{589,189,41,65535},{590,190,42,65535},{591,191,43,65535},{592,192,65535,65535},{593,193,65535,65535},{594,194,65535,65535},{595,195,65535,65535},{528,388,65535,65535},{529,389,65535,65535},{530,390,65535,65535},{531,391,65535,65535},{532,392,65535,65535},{533,393,65535,65535},{534,394,65535,65535},{535,395,65535,65535},{536,332,12,65535},{537,333,13,65535},{538,334,14,65535},{539,335,15,65535},{540,336,16,65535},{541,337,17,65535},{542,338,18,65535},{543,339,19,65535},{544,340,20,65535},{545,341,21,65535},{546,342,22,65535},{547,343,23,65535},{548,344,24,65535},{549,345,25,65535},{550,346,26,65535},{551,347,27,65535},{484,232,128,65535},{485,233,129,65535},{486,234,130,65535},{487,235,131,65535},{488,236,68,65535},{489,237,69,65535},{490,238,70,65535},{491,239,71,65535},{492,240,72,65535},{493,241,73,65535},{494,242,74,65535},{495,243,75,65535},{496,376,76,65535},{497,377,77,65535},{498,378,78,65535},{499,379,79,65535},{500,380,80,65535},{501,381,81,65535},{502,382,82,65535},{503,383,83,65535},{504,384,84,65535},{505,385,85,65535},{506,386,86,65535},{507,387,87,65535},{440,428,48,65535},{441,429,49,65535},{442,430,50,65535},{443,431,51,65535},{444,432,52,65535},{445,433,53,65535},{446,434,54,65535},{447,435,55,65535},{448,436,56,65535},{449,437,57,65535},{450,438,58,65535},{451,439,59,65535},{452,220,244,65535},{453,221,245,65535},{454,222,246,65535},{455,223,247,65535},{456,224,248,65535},{457,225,249,65535},{458,226,250,65535},{459,227,251,65535},{460,228,252,65535},{461,229,253,65535},{462,230,254,65535},{463,231,255,65535},{684,276,60,65535},{685,277,61,65535},{686,278,62,65535},{687,279,63,65535},{688,280,64,65535},{689,281,65,65535},{690,282,66,65535},{691,283,67,65535},{692,284,112,65535},{693,285,113,65535},{694,286,114,65535},{695,287,115,65535},{696,420,216,65535},{697,421,217,65535},{698,422,218,65535},{699,423,219,65535},{700,424,88,65535},{701,425,89,65535},{702,426,90,65535},{703,427,91,65535},{396,516,0,65535},{397,517,1,65535},{398,518,2,65535},{399,519,3,65535},{400,520,4,65535},{401,521,5,65535},{402,522,6,65535},{403,523,7,65535},{404,524,8,65535},{405,525,9,65535},{406,526,10,65535},{407,527,11,65535},{408,464,92,65535},{409,465,93,65535},{410,466,94,65535},{411,467,95,65535},{412,468,96,65535},{413,469,97,65535},{414,470,98,65535},{415,471,99,65535},{416,472,100,65535},{417,473,101,65535},{418,474,102,65535},{419,475,103,65535},{640,476,104,65535},{641,477,105,65535},{642,478,106,65535},{643,479,107,65535},{644,480,108,65535},{645,481,109,65535},{646,482,110,65535},{647,483,111,65535},{648,264,256,65535},{649,265,257,65535},{650,266,258,65535},{651,267,259,65535},{652,268,260,65535},{653,269,261,65535},{654,270,262,65535},{655,271,263,65535},{656,272,200,65535},{657,273,201,65535},{658,274,202,65535},{659,275,203,65535},{596,320,156,65535},{597,321,157,65535},{598,322,158,65535},{599,323,159,65535},{600,324,160,65535},{601,325,161,65535},{602,326,162,65535},{603,327,163,65535},{604,328,164,65535},{605,329,165,65535},{606,330,166,65535},{607,331,167,65535},{608,508,168,65535},{609,509,169,65535},{610,510,170,65535},{611,511,171,65535},{612,512,172,65535},{613,513,173,65535},{614,514,174,65535},{615,515,175,65535},{352,560,116,65535},{353,561,117,65535},{354,562,118,65535},{355,563,119,65535},{356,564,120,65535},{357,565,121,65535},{358,566,122,65535},{359,567,123,65535},{360,568,124,65535},{361,569,125,65535},{362,570,126,65535},{363,571,127,65535},{364,308,204,65535},{365,309,205,65535},{366,310,206,65535},{367,311,207,65535},{368,312,208,65535},{369,313,209,65535},{370,314,210,65535},{371,315,211,65535},{372,316,212,65535},{373,317,213,65535},{374,318,214,65535},{375,319,215,65535},{552,556,44,65535},{553,557,45,65535},{554,558,46,65535},{555,559,47,65535}};


namespace fa {
constexpr int NW = 8, QBLK = 32, KVBLK = 64, QB = NW * QBLK, D = 128;
constexpr int SHM_V = KVBLK * D * 2, SHM_K = KVBLK * D * 2;
constexpr int NSLOT = 3, SLOT = SHM_K + 2 * SHM_V;
constexpr int OFF_RING = 0, OFF_WS = OFF_RING + NSLOT * SLOT, OFF_BT = OFF_WS + NW * 64 * 4, BT_PAD = 96, BT_N = BT_PAD + 256, LDS_BYTES = OFF_BT + BT_N * 4;
constexpr float THR = 8.f;
#define KSWZ(row, colB) ((row) * 256 + ((colB) ^ (((row) & 7) << 4)))
#define SBAR() __builtin_amdgcn_sched_barrier(0)
__device__ __forceinline__ int v_st(int k, int c) { const int kk = (k & ~0xC) | ((k & 4) << 1) | ((k & 8) >> 1); return ((kk >> 3) * 4 + (c >> 5)) * 512 + ((kk & 7) * 32 + (c & 31)) * 2; }
__device__ __forceinline__ int v_rd_base(int lane) { return ((lane & 3) << 3) | (((lane >> 2) & 3) << 6) | (((lane >> 4) & 1) << 5) | (((lane >> 5) & 1) << 8); }
constexpr int v_rd_off(int d0, int ks, int half) { return d0 * 512 + ks * 4096 + half * 2048; }
__device__ __forceinline__ int crow(int r, int hi) { return (r & 3) + 8 * (r >> 2) + 4 * hi; }
__device__ __forceinline__ unsigned cvtpk(float lo, float hi) { unsigned r; asm volatile("v_cvt_pk_bf16_f32 %0, %1, %2" : "=v"(r) : "v"(lo), "v"(hi)); return r; }

__device__ __forceinline__ void bias_mask_tile(f32x16& p0, f32x16& p1, int dq, const LAS float* bt) {
    const float NEG = -__builtin_inff();
    const LAS float* b = bt + BT_PAD + dq - 59;
#pragma unroll
    for (int r = 0; r < 16; ++r) {
        const int c = (r & 3) + 8 * (r >> 2);
        const float v0 = b[59 - c], v1 = b[59 - c - 32];
        p0[r] = (dq - c) >= 0 ? p0[r] + v0 : NEG;
        p1[r] = (dq - c - 32) >= 0 ? p1[r] + v1 : NEG;
    }
}
__device__ __forceinline__ void partialSM(f32x16& p0, f32x16& p1, float& m_reg, float& alpha, float bc) {
    float pmax = p0[0];
#pragma unroll
    for (int r = 1; r < 16; ++r) pmax = fmaxf(pmax, p0[r]);
#pragma unroll
    for (int r = 0; r < 16; ++r) pmax = fmaxf(pmax, p1[r]);
    { auto rr = __builtin_amdgcn_permlane32_swap(__float_as_uint(pmax), __float_as_uint(pmax), false, false);
      pmax = fmaxf(__uint_as_float(rr[0]), __uint_as_float(rr[1])); }
    pmax += bc;
    constexpr float C2 = 1.4426950408889634f * SCALE;
    float mn;
    if (__builtin_expect(__all((pmax - m_reg) * SCALE <= THR), 1)) { mn = m_reg; alpha = 1.f; }
    else { mn = fmaxf(m_reg, pmax); alpha = __builtin_amdgcn_exp2f((m_reg - mn) * C2); m_reg = mn; }
    const float mnL = (bc - mn) * C2;
#pragma unroll
    for (int r = 0; r < 16; ++r) p0[r] = __builtin_amdgcn_exp2f(fmaf(p0[r], C2, mnL));
#pragma unroll
    for (int r = 0; r < 16; ++r) p1[r] = __builtin_amdgcn_exp2f(fmaf(p1[r], C2, mnL));
}
__device__ __forceinline__ void finishSM(f32x16& p0, f32x16& p1, float alpha, float& l_reg, bf16x8& pa0, bf16x8& pa1, bf16x8& pa2, bf16x8& pa3) {
    float ps = 0;
#pragma unroll
    for (int r = 0; r < 16; ++r) ps += p0[r];
#pragma unroll
    for (int r = 0; r < 16; ++r) ps += p1[r];
    { auto rr = __builtin_amdgcn_permlane32_swap(__float_as_uint(ps), __float_as_uint(ps), false, false);
      ps = __uint_as_float(rr[0]) + __uint_as_float(rr[1]); }
    l_reg = l_reg * alpha + ps;
#define PK4(P, B_, OUT) do { unsigned a0 = cvtpk(P[B_+0], P[B_+1]), a1 = cvtpk(P[B_+2], P[B_+3]);                          \
        unsigned b0 = cvtpk(P[B_+4], P[B_+5]), b1 = cvtpk(P[B_+6], P[B_+7]);                                             \
        auto r0 = __builtin_amdgcn_permlane32_swap(a0, b0, false, false); auto r1 = __builtin_amdgcn_permlane32_swap(a1, b1, false, false); \
        v4u w = {r0[0], r1[0], r0[1], r1[1]}; OUT = __builtin_bit_cast(bf16x8, w); } while (0)
    PK4(p0, 0, pa0); PK4(p0, 8, pa1); PK4(p1, 0, pa2); PK4(p1, 8, pa3);
#undef PK4
}
__device__ __forceinline__ void qkt(f32x16& p0, f32x16& p1, const LAS char* Kb, int r32, int hi, const bf16x8* qr) {
    p0 = f32x16{}; p1 = f32x16{};
    const LAS char* kb[4];
#pragma unroll
    for (int dd = 0; dd < 4; ++dd) kb[dd] = Kb + KSWZ(r32, (dd * 16 + hi * 8) * 2);
#pragma unroll
    for (int d0 = 0; d0 < 8; ++d0) { const LAS char* a = kb[d0 & 3] + (d0 >> 2) * 128;
        const bf16x8 b0 = *(const LAS bf16x8*)a;
        const bf16x8 b1 = *(const LAS bf16x8*)(a + 32 * 256);
        p0 = __builtin_amdgcn_mfma_f32_32x32x16_bf16(b0, qr[d0], p0, 0, 0, 0);
        p1 = __builtin_amdgcn_mfma_f32_32x32x16_bf16(b1, qr[d0], p1, 0, 0, 0); }
}
__device__ __forceinline__ void pv_tile(f32x16* o, int vb0, bf16x8 pa0, bf16x8 pa1, bf16x8 pa2, bf16x8 pa3) {
#define TRRD(dst, off) asm volatile("ds_read_b64_tr_b16 %0, %1 offset:%2" : "=&v"(dst) : "v"(vb0), "i"(off) : "memory")
#define PV_D0(d0) do { s16x4 l0, l1, l2, l3, h0, h1, h2, h3; constexpr int b_ = v_rd_off(d0, 0, 0);   \
        TRRD(l0, b_); TRRD(h0, b_ + 2048); TRRD(l1, b_ + 4096); TRRD(h1, b_ + 6144); TRRD(l2, b_ + 8192); TRRD(h2, b_ + 10240); TRRD(l3, b_ + 12288); TRRD(h3, b_ + 14336); \
        asm volatile("s_waitcnt lgkmcnt(0)" ::: "memory"); SBAR();   \
        o[d0] = __builtin_amdgcn_mfma_f32_32x32x16_bf16(pa0, (bf16x8){l0[0], l0[1], l0[2], l0[3], h0[0], h0[1], h0[2], h0[3]}, o[d0], 0, 0, 0);   \
        o[d0] = __builtin_amdgcn_mfma_f32_32x32x16_bf16(pa1, (bf16x8){l1[0], l1[1], l1[2], l1[3], h1[0], h1[1], h1[2], h1[3]}, o[d0], 0, 0, 0);   \
        o[d0] = __builtin_amdgcn_mfma_f32_32x32x16_bf16(pa2, (bf16x8){l2[0], l2[1], l2[2], l2[3], h2[0], h2[1], h2[2], h2[3]}, o[d0], 0, 0, 0);   \
        o[d0] = __builtin_amdgcn_mfma_f32_32x32x16_bf16(pa3, (bf16x8){l3[0], l3[1], l3[2], l3[3], h3[0], h3[1], h3[2], h3[3]}, o[d0], 0, 0, 0); } while (0)
    PV_D0(0); PV_D0(1); PV_D0(2); PV_D0(3);
#undef PV_D0
#undef TRRD
}

template <bool MOBA, int VW>
__device__ __forceinline__ void unit(LAS unsigned char* lds, const bf16* Q, const bf16* K, const bf16* V, bf16* O, int ldq, int ldk, int ldv, int ldo, int P0,
                                     const float* biascol, const unsigned* mmask, int mstride, int wave) {
    const int wid = wave, lane = lane_now(), tid = wid * 64 + lane, r32 = lane & 31, hi = lane >> 5;
    LAS float* wsf = (LAS float*)(lds + OFF_WS) + wid * 64; LAS float* li_l = wsf; LAS float* al_l = wsf + 32;
    LAS float* bt = (LAS float*)(lds + OFF_BT);
    const float bfar = biascol[31 * 32] * (1.f / SCALE);
    const int NT = (P0 + QB) / KVBLK;
    const int qlo = P0 + wid * QBLK, qm = qlo + r32 - 4 * hi;
    const int own = P0 >> 8;
    unsigned mw = 0u; if (MOBA) mw = mmask[(size_t)(qlo + r32) * mstride];
    float m_reg = -1e30f, l_reg = 0.f; f32x16 o[4 * VW] = {};
    const int vrb = v_rd_base(lane);
    bf16x8 qr[8];
#pragma unroll
    for (int d0 = 0; d0 < 8; ++d0) qr[d0] = *(const GAS bf16x8*)(Q + (size_t)(qlo + r32) * ldq + d0 * 16 + hi * 8);
#define FA_ISSUE(t_) do { const int sl_ = (t_) % NSLOT; const bf16* kt_ = K + (size_t)((t_) * KVBLK) * ldk; const bf16* vt_ = V + (size_t)((t_) * KVBLK) * ldv; \
        int ln_ = lane; asm volatile("" : "+v"(ln_));     \
        _Pragma("unroll") for (int jj = 0; jj < 2; ++jj) { const int j_ = 2 * wid + jj, row_ = 4 * j_ + (ln_ >> 4), ks_ = row_ * ldk + (((ln_ & 15) ^ (row_ & 7)) << 3); \
            const int s_ = 2 * j_ + (ln_ >> 5), kk_ = (s_ >> 2) * 8 + ((ln_ & 31) >> 2), c_ = (s_ & 3) * 32 + (ln_ & 3) * 8, key_ = (kk_ & ~0xC) | ((kk_ & 4) << 1) | ((kk_ & 8) >> 1), vs_ = key_ * ldv + c_; \
            __builtin_amdgcn_global_load_lds((const GAS unsigned*)(kt_ + ks_), (LAS unsigned*)(lds + OFF_RING + sl_ * SLOT + (2 * wid + jj) * 1024), 16, 0, 0); \
            _Pragma("unroll") for (int vh_ = 0; vh_ < VW; ++vh_) __builtin_amdgcn_global_load_lds((const GAS unsigned*)(vt_ + vs_ + vh_ * 128), (LAS unsigned*)(lds + OFF_RING + sl_ * SLOT + SHM_K + vh_ * SHM_V + (2 * wid + jj) * 1024), 16, 0, 0); } } while (0)
    __syncthreads();
    for (int i = tid; i < BT_N; i += NW * 64) { const int d = i - BT_PAD; bt[i] = biascol[bucket(d < 0 ? 0 : d) * 32] * (1.f / SCALE); }
    asm volatile("s_waitcnt vmcnt(0) lgkmcnt(0)" ::: "memory");
    FA_ISSUE(0); if (NT > 1) FA_ISSUE(1);
    for (int t = 0; t < NT; ++t) {
        const int kb = t * KVBLK; const LAS unsigned char* slot = lds + OFF_RING + (t % NSLOT) * SLOT;
        if (t + 1 < NT) { if (VW == 2) asm volatile("s_waitcnt vmcnt(6)" ::: "memory"); else asm volatile("s_waitcnt vmcnt(4)" ::: "memory"); } else asm volatile("s_waitcnt vmcnt(0)" ::: "memory");
        __builtin_amdgcn_s_barrier();
        asm volatile("" ::: "memory"); SBAR();
        if (t + 2 < NT) FA_ISSUE(t + 2);
        if (kb <= qlo + QBLK - 1) {
        f32x16 p0, p1; float alpha; bf16x8 pa0, pa1, pa2, pa3;
        qkt(p0, p1, (const LAS char*)slot, r32, hi, qr);
        const bool near = kb + KVBLK - 1 > qlo - 113;
        float bc = near ? 0.f : bfar;
        if (MOBA) { const int n = kb >> 8; if (n < own && !((mw >> n) & 1u)) bc = -__builtin_inff(); }
        if (near) bias_mask_tile(p0, p1, qm - kb, bt);
        partialSM(p0, p1, m_reg, alpha, bc);
        finishSM(p0, p1, alpha, l_reg, pa0, pa1, pa2, pa3);
        if (__any(alpha < 1.f)) { if (hi == 0) al_l[r32] = alpha; asm volatile("s_waitcnt lgkmcnt(0)" ::: "memory");
#pragma unroll
            for (int d_ = 0; d_ < 4 * VW; ++d_)
#pragma unroll
                for (int r = 0; r < 16; ++r) o[d_][r] *= al_l[crow(r, hi)]; }
        SBAR();
        pv_tile(o, (int)(unsigned)(size_t)(slot + SHM_K) + vrb, pa0, pa1, pa2, pa3);
        if (VW == 2) pv_tile(o + 4, (int)(unsigned)(size_t)(slot + SHM_K + SHM_V) + vrb, pa0, pa1, pa2, pa3);
        }
    }
#undef FA_ISSUE
    if (hi == 0) li_l[r32] = l_reg; asm volatile("s_waitcnt lgkmcnt(0)" ::: "memory");
    bf16* Ow = O + (size_t)qlo * ldo;
#pragma unroll
    for (int r = 0; r < 16; ++r) { const int orow = crow(r, hi); const float rl = __builtin_amdgcn_rcpf(li_l[orow]);
#pragma unroll
        for (int d0 = 0; d0 < 4 * VW; ++d0) { const float v = o[d0][r] * rl; const float vn = __shfl_xor(v, 1);
            if ((r32 & 1) == 0) *(GAS unsigned*)(Ow + (size_t)orow * ldo + d0 * 32 + r32) = cvtpk(v, vn); } }
}
#undef KSWZ
#undef SBAR
}


__device__ __forceinline__ float lambda_init_of(int l) { return l == 0 ? 0.2f : 0.35550906759096925f; }

__device__ __forceinline__ void prep_phase(Frame& F, int l) {
    const int lane = lane_now();
    const int wv_ = WAVE(F), gw = VCU(F) * NWAVES + wv_, NGW = F.G * NWAVES;
    const bf16* PROJ = (const bf16*)(WSL(F) + WS_PROJ); const float* TAIL = (const float*)(WSL(F) + WS_TAIL);
    bf16* CKVN = (bf16*)(WSL(F) + WS_CKVN); bf16* KI = (bf16*)(WSL(F) + WS_KI); float* WI = (float*)(WSL(F) + WS_WI); float* KMEAN = (float*)(WSL(F) + WS_KMEAN);
    const float* kvg = karg(7) + (size_t)l * KVL;
    const f32x4 g0 = *(const GAS f32x4*)(kvg + lane * 8), g1 = *(const GAS f32x4*)(kvg + lane * 8 + 4);
    for (int m = gw; m < M; m += NGW) {
        const v4u cw = *(const GAS v4u*)(PROJ + (size_t)m * DINM + O_CKV + lane * 8);
        float c[8] = {bflo(cw.x), bfhi(cw.x), bflo(cw.y), bfhi(cw.y), bflo(cw.z), bfhi(cw.z), bflo(cw.w), bfhi(cw.w)};
        float ss = 0.f;
#pragma unroll
        for (int j = 0; j < 8; ++j) ss += c[j] * c[j];
        const float r = 1.f / sqrtf(wave_sum(ss) * (1.f / KVL) + RMS_EPS);
        v4u o; o.x = pk2(c[0] * r * g0.x, c[1] * r * g0.y); o.y = pk2(c[2] * r * g0.z, c[3] * r * g0.w); o.z = pk2(c[4] * r * g1.x, c[5] * r * g1.y); o.w = pk2(c[6] * r * g1.z, c[7] * r * g1.w);
        *(GAS v4u*)(CKVN + (size_t)m * KVL + lane * 8) = o;
        const float kv = TAIL[(size_t)m * NTAIL + lane];
        const float mean = wave_sum(kv) * (1.f / 64.f); const float d = kv - mean;
        const float var = wave_sum(d * d) * (1.f / 64.f);
        KI[(size_t)m * 64 + lane] = (bf16)f2bf(d / sqrtf(var + LN_EPS));
        if (lane < 32) WI[(size_t)m * 32 + lane] = TAIL[(size_t)m * NTAIL + 64 + lane] * (0.17677669529663687f * 0.125f);
    }
    { LAS float* red = (LAS float*)(F.lds + RING_OFF);
      for (int it = VCU(F); it < NB * MOBA_H * 16; it += F.G) {
        const int n = it & 15, bh = it >> 4, b = bh / MOBA_H, h = bh % MOBA_H;
        const bf16* kp = PROJ + (size_t)(b * T + n * 256 + wv_ * 32) * DINM + O_MK + h * HD + 2 * lane; unsigned wq[32];
#pragma unroll
        for (int j = 0; j < 32; ++j) wq[j] = *(const GAS unsigned*)(kp + (size_t)j * DINM);
        float s0 = 0.f, s1 = 0.f;
#pragma unroll
        for (int j = 0; j < 32; ++j) { s0 += bflo(wq[j]); s1 += bfhi(wq[j]); }
        __syncthreads();
        red[wv_ * 128 + 2 * lane] = s0; red[wv_ * 128 + 2 * lane + 1] = s1;
        __syncthreads();
        if (wv_ == 0) { float a0 = 0.f, a1 = 0.f;
#pragma unroll
            for (int ww = 0; ww < 8; ++ww) { a0 += red[ww * 128 + 2 * lane]; a1 += red[ww * 128 + 2 * lane + 1]; }
            KMEAN[(size_t)it * HD + 2 * lane] = a0 * (1.f / 256.f); KMEAN[(size_t)it * HD + 2 * lane + 1] = a1 * (1.f / 256.f); }
      } }
}
__device__ __forceinline__ float quad_sum(float v) {
    v += __builtin_bit_cast(float, __builtin_amdgcn_mov_dpp(__builtin_bit_cast(int, v), 0xB1, 0xF, 0xF, true));
    v += __builtin_bit_cast(float, __builtin_amdgcn_mov_dpp(__builtin_bit_cast(int, v), 0x4E, 0xF, 0xF, true));
    return v;
}
#ifdef MS_CHECK
__device__ __forceinline__ unsigned ms_ref_mask(float g, int own) {
    float v1 = 0.f, v2 = 0.f, v3 = 0.f; int i1 = -1, i2 = -1, i3 = -1;
#pragma unroll
    for (int nn = 0; nn < 15; ++nn) { const float gg = __builtin_bit_cast(float, __builtin_amdgcn_readlane(__builtin_bit_cast(int, g), 4 * nn));
        if (nn < own) {
            if (i1 < 0 || gg > v1) { v3 = v2; i3 = i2; v2 = v1; i2 = i1; v1 = gg; i1 = nn; }
            else if (i2 < 0 || gg > v2) { v3 = v2; i3 = i2; v2 = gg; i2 = nn; }
            else if (i3 < 0 || gg > v3) { v3 = gg; i3 = nn; } } }
    unsigned mask = 0u; if (i1 >= 0) mask |= 1u << i1; if (i2 >= 0) mask |= 1u << i2; if (i3 >= 0) mask |= 1u << i3;
    return mask;
}
#define MS_CHK(g_, mask_, row_) do { if (ms_ref_mask(g_, own) != ((mask_) ^ MS_CHECK_XOR) && lane == 0) ((unsigned short*)(WSL(F) + WS_XN))[(size_t)(row_) * DM] = 0x7FC0; } while (0)
#else
#define MS_CHK(g_, mask_, row_) do { } while (0)
#endif
__device__ __forceinline__ int quads_max(int v) {
    { const int o = __builtin_amdgcn_mov_dpp(v, 0x141, 0xF, 0xF, true); v = v > o ? v : o; }
    { const int o = __builtin_amdgcn_mov_dpp(v, 0x140, 0xF, 0xF, true); v = v > o ? v : o; }
    { auto r = __builtin_amdgcn_permlane16_swap((unsigned)v, (unsigned)v, false, false); const int a = (int)r[0], c = (int)r[1]; v = a > c ? a : c; }
    { auto r = __builtin_amdgcn_permlane32_swap((unsigned)v, (unsigned)v, false, false); const int a = (int)r[0], c = (int)r[1]; v = a > c ? a : c; }
    return v;
}
__device__ __forceinline__ void moba_select_phase(Frame& F) {
    const int lane = lane_now();
    const int wv_ = WAVE(F), gw = VCU(F) * NWAVES + wv_, NGW = F.G * NWAVES, n = lane >> 2, part = lane & 3;
    const bf16* PROJ = (const bf16*)(WSL(F) + WS_PROJ); const float* KMEAN = (const float*)(WSL(F) + WS_KMEAN); unsigned* MMASK = (unsigned*)(WSL(F) + WS_MMASK);
    for (int m4 = gw; m4 < M / 4; m4 += NGW) {
        const int m0 = m4 * 4, b = m0 / T, own = (m0 % T) >> 8;
        f32x4 kmA[8], kmB[8]; v4u qA[4][4], qB[4][4];
#define MS_LOAD(KM, QQ, h_) do { const float* kp_ = KMEAN + ((size_t)((b * MOBA_H + (h_)) * 16 + n)) * HD + part * 32; \
        _Pragma("unroll") for (int i = 0; i < 8; ++i) KM[i] = n < own ? *(const GAS f32x4*)(kp_ + 4 * i) : (f32x4){0.f, 0.f, 0.f, 0.f}; \
        _Pragma("unroll") for (int tk = 0; tk < 4; ++tk) { const bf16* qp_ = PROJ + (size_t)(m0 + tk) * DINM + O_MQ + (h_) * HD + part * 32; \
            _Pragma("unroll") for (int i = 0; i < 4; ++i) QQ[tk][i] = *(const GAS v4u*)(qp_ + 8 * i); } } while (0)
#define MS_HEAD(KM, QQ, h_) do { _Pragma("unroll") for (int tk = 0; tk < 4; ++tk) { float g = 0.f; \
            _Pragma("unroll") for (int i = 0; i < 4; ++i) { const v4u qw = QQ[tk][i]; \
                g += bflo(qw.x) * KM[2 * i].x + bfhi(qw.x) * KM[2 * i].y + bflo(qw.y) * KM[2 * i].z + bfhi(qw.y) * KM[2 * i].w \
                   + bflo(qw.z) * KM[2 * i + 1].x + bfhi(qw.z) * KM[2 * i + 1].y + bflo(qw.w) * KM[2 * i + 1].z + bfhi(qw.w) * KM[2 * i + 1].w; } \
            g = quad_sum(g); \
              \
            int key_ = __builtin_bit_cast(int, g); key_ ^= (key_ >> 31) & 0x7FFFFFFF; bool live_ = n < own; unsigned mask = 0u; \
            _Pragma("unroll") for (int rd_ = 0; rd_ < 3; ++rd_) { const int mx_ = quads_max(live_ ? key_ : (int)0x80000000); \
                const unsigned long long bal_ = __ballot(live_ && key_ == mx_); \
                if (bal_) { const int sel_ = (int)(__builtin_ctzll(bal_) >> 2); mask |= 1u << sel_; live_ = live_ && n != sel_; } } \
            MS_CHK(g, mask, m0 + tk); \
            if (lane == 0) MMASK[(size_t)(m0 + tk) * MOBA_H + (h_)] = mask; } } while (0)
        MS_LOAD(kmA, qA, 0);
        for (int h = 0; h < MOBA_H; h += 2) {
            MS_LOAD(kmB, qB, h + 1);
            MS_HEAD(kmA, qA, h);
            if (h + 2 < MOBA_H) MS_LOAD(kmA, qA, h + 2);
            MS_HEAD(kmB, qB, h + 1);
        }
#undef MS_LOAD
#undef MS_HEAD
#undef MS_CHK
    }
}
__device__ __forceinline__ void attn_phase(Frame& F) {
    const bf16* PROJ = (const bf16*)(WSL(F) + WS_PROJ); bf16* DIFFO = (bf16*)(WSL(F) + WS_DIFFO); bf16* Y = (bf16*)(WSL(F) + WS_Y);
    const unsigned* MMASK = (const unsigned*)(WSL(F) + WS_MMASK); const float* tab = karg(3);
    constexpr int ND = NB * DIFF_H * 2, PER_QB = ND + NB * MOBA_H, NU = 16 * PER_QB;
    const int vcu_ = VCU(F), wave_ = WAVE(F);
    for (int r = 0;; ++r) {
        int i;
        if (F.G == 256) { if (r >= 4) break; const int id = (int)c_attn_sched[vcu_][r]; if (id == 0xFFFF) break; i = (15 - id / PER_QB) * PER_QB + id % PER_QB; }
        else { i = r * F.G + ((r & 1) ? F.G - 1 - vcu_ : vcu_); if (i >= NU) break; }
        const int qb = 15 - i / PER_QB, j = i % PER_QB, P0 = qb * 256;
        if (j < ND) {
            const int b = j / (DIFF_H * 2), vh = j % (DIFF_H * 2), h = vh >> 1, mp = vh & 1;
            const bf16* base = PROJ + (size_t)(b * T) * DINM;
            fa::unit<false, 2>(F.lds + RING_OFF, base + O_DQ + h * 256 + mp * 128, base + O_DK + h * 256 + mp * 128, base + O_DV + h * 256,
                               DIFFO + (size_t)(b * T) * (DIFF_H * 512) + (h * 2 + mp) * 256, DINM, DINM, DINM, DIFF_H * 512, P0, tab + h * 2 + mp, nullptr, 0, wave_);
        } else {
            const int jj = j - ND, b = jj / MOBA_H, h = jj % MOBA_H;
            const bf16* base = PROJ + (size_t)(b * T) * DINM;
            fa::unit<true, 1>(F.lds + RING_OFF, base + O_MQ + h * HD, base + O_MK + h * HD, base + O_MV + h * HD, Y + (size_t)(b * T) * DM + 1536 + h * HD, DINM, DINM, DINM, DM, P0,
                              tab + 12 + h, MMASK + (size_t)(b * T) * MOBA_H + h, MOBA_H, wave_);
        }
    }
}
__device__ __forceinline__ void post_phase(Frame& F, int l) {
    const int lane = lane_now();
    const int wv_ = WAVE(F), gw = VCU(F) * NWAVES + wv_, NGW = F.G * NWAVES;
    const bf16* DIFFO = (const bf16*)(WSL(F) + WS_DIFFO); bf16* Y = (bf16*)(WSL(F) + WS_Y);
    const float* lv = karg(5) + (size_t)l * 512; const float* sg = karg(6) + (size_t)l * 256;
    const float e1 = wave_sum(lv[lane] * lv[128 + lane] + lv[64 + lane] * lv[192 + lane]), e2 = wave_sum(lv[256 + lane] * lv[384 + lane] + lv[320 + lane] * lv[448 + lane]);
    const float li = lambda_init_of(l), lam = expf(e1) - expf(e2) + li;
    const f32x4 g = *(const GAS f32x4*)(sg + lane * 4);
    for (int it0 = gw * 4; it0 < M * DIFF_H; it0 += NGW * 4) {
        v2u a[4], c[4];
#pragma unroll
        for (int u = 0; u < 4; ++u) { const int it = it0 + u, m = it / DIFF_H, h = it % DIFF_H; const bf16* p = DIFFO + (size_t)m * (DIFF_H * 512) + h * 512 + lane * 4;
            a[u] = *(const GAS v2u*)p; c[u] = *(const GAS v2u*)(p + 256); }
#pragma unroll
        for (int u = 0; u < 4; ++u) { const int it = it0 + u, m = it / DIFF_H, h = it % DIFF_H;
            const float o0 = bflo(a[u].x) - lam * bflo(c[u].x), o1 = bfhi(a[u].x) - lam * bfhi(c[u].x), o2 = bflo(a[u].y) - lam * bflo(c[u].y), o3 = bfhi(a[u].y) - lam * bfhi(c[u].y);
            const float r = 1.f / sqrtf(wave_sum(o0 * o0 + o1 * o1 + o2 * o2 + o3 * o3) * (1.f / 256.f) + RMS_EPS) * (1.f - li);
            v2u o; o.x = pk2(o0 * r * g.x, o1 * r * g.y); o.y = pk2(o2 * r * g.z, o3 * r * g.w);
            *(GAS v2u*)(Y + (size_t)m * DM + h * 256 + lane * 4) = o; }
    }
}


template <int KK, int NCT>
__device__ __forceinline__ void sg_unit(const bf16* A, int lda, const bf16* B, bf16* C, int ldc, int lane) {
    const int fr = lane & 15, fq = lane >> 4;
    f32x4 acc[2][NCT];
#pragma unroll
    for (int i = 0; i < 2; ++i)
#pragma unroll
        for (int j = 0; j < NCT; ++j) acc[i][j] = (f32x4){0.f, 0.f, 0.f, 0.f};
    const bf16* ap = A + (size_t)fr * lda + 8 * fq; const bf16* bp = B + (size_t)fr * KK + 8 * fq;
#pragma unroll 4
    for (int ks = 0; ks < KK / 32; ++ks) {
        bf16x8 a[2], b[NCT];
#pragma unroll
        for (int i = 0; i < 2; ++i) a[i] = *(const GAS bf16x8*)(ap + (size_t)i * 16 * lda + ks * 32);
#pragma unroll
        for (int j = 0; j < NCT; ++j) b[j] = *(const GAS bf16x8*)(bp + (size_t)j * 16 * KK + ks * 32);
#pragma unroll
        for (int i = 0; i < 2; ++i)
#pragma unroll
            for (int j = 0; j < NCT; ++j) acc[i][j] = __builtin_amdgcn_mfma_f32_16x16x32_bf16(b[j], a[i], acc[i][j], 0, 0, 0);
    }
#pragma unroll
    for (int i = 0; i < 2; ++i)
#pragma unroll
        for (int j = 0; j < NCT; ++j) { v2u o; o.x = pk2(acc[i][j][0], acc[i][j][1]); o.y = pk2(acc[i][j][2], acc[i][j][3]);
            *(GAS v2u*)(C + (size_t)(i * 16 + fr) * ldc + j * 16 + 4 * fq) = o; }
}
__device__ __forceinline__ void qlat_phase(Frame& F, int l) {
    const int lane = lane_now();
    const int gw = VCU(F) * NWAVES + WAVE(F), NGW = F.G * NWAVES;
    const bf16* PROJ = (const bf16*)(WSL(F) + WS_PROJ); const bf16* WUK = (const bf16*)(WSL(F) + WS_WUK) + (size_t)l * DSA_H * KVL * HD; bf16* QLAT = (bf16*)(WSL(F) + WS_QLAT);
    for (int wu = gw; wu < (M / 32) * DSA_H * 4; wu += NGW) { const int tt = wu / (DSA_H * 4), rem = wu % (DSA_H * 4), h = rem >> 2, cg = rem & 3;
        sg_unit<HD, 8>(PROJ + (size_t)(tt * 32) * DINM + O_CQ + h * HD, DINM, WUK + ((size_t)h * KVL + cg * 128) * HD, QLAT + (size_t)(tt * 32) * (DSA_H * KVL) + h * KVL + cg * 128, DSA_H * KVL, lane); }
}
__device__ __forceinline__ void dsa_out_phase(Frame& F, int l) {
    const int lane = lane_now();
    const int gw = VCU(F) * NWAVES + WAVE(F), NGW = F.G * NWAVES;
    const bf16* OLAT = (const bf16*)(WSL(F) + WS_OLAT); const bf16* WUVT = (const bf16*)(WSL(F) + WS_WUVT) + (size_t)l * DSA_H * HD * KVL; bf16* Y = (bf16*)(WSL(F) + WS_Y);
    for (int wu = gw; wu < (M / 32) * DSA_H * 2; wu += NGW) { const int tt = wu / (DSA_H * 2), rem = wu % (DSA_H * 2), h = rem >> 1, cg = rem & 1;
        sg_unit<KVL, 4>(OLAT + (size_t)(tt * 32) * (DSA_H * KVL) + h * KVL, DSA_H * KVL, WUVT + ((size_t)h * HD + cg * 64) * KVL, Y + (size_t)(tt * 32) * DM + 2816 + h * HD + cg * 64, DM, lane); }
}

typedef short v4i16_t __attribute__((ext_vector_type(4)));
namespace dsa {
constexpr int G = 4;
constexpr int KT = 256, KSTR = 144;
constexpr int NB1 = 1024;
constexpr int SZ_KI = KT * KSTR, OFF_KI = 0, OFF_SC = 2 * SZ_KI, OFF_HIST = OFF_SC + G * 16384, OFF_SEL = OFF_HIST + G * NB1 * 4, OFF_CNT = OFF_SEL + G * 512  , CNT_W = 64  , LDS_END = OFF_CNT + G * CNT_W * 4;
static_assert(LDS_END <= RING_BYTES, "dsa select LDS map");
__device__ __forceinline__ unsigned fkey(float f) { const unsigned u = __float_as_uint(f); return (u & 0x80000000u) ? ~u : (u | 0x80000000u); }
__device__ __forceinline__ int crow(int r, int hi) { return (r & 3) + 8 * (r >> 2) + 4 * hi; }
}
__device__ __forceinline__ void dsa_select_phase(Frame& F) {
    using namespace dsa;
    const int lane = lane_now(), w = WAVE(F), tid = w * 64 + lane, g = w >> 1, par = w & 1, r32 = lane & 31, hi = lane >> 5;
    LAS unsigned char* L = F.lds + RING_OFF;
    LAS float* sc = (LAS float*)(L + OFF_SC) + g * 4096; LAS unsigned* hist = (LAS unsigned*)(L + OFF_HIST) + g * NB1;
    LAS unsigned* bmp = (LAS unsigned*)(L + OFF_SEL) + g * 128; LAS unsigned* cnt = (LAS unsigned*)(L + OFF_CNT) + g * CNT_W;
    LAS unsigned* cnt_all = (LAS unsigned*)(L + OFF_CNT);
    const bf16* PROJ = (const bf16*)(WSL(F) + WS_PROJ); const bf16* KI = (const bf16*)(WSL(F) + WS_KI); const float* WI = (const float*)(WSL(F) + WS_WI); unsigned short* SEL = (unsigned short*)(WSL(F) + WS_SEL);
    constexpr int NGRP = M / G; const int vcu_ = VCU(F);
    for (int rr = 0;; ++rr) {
        const int i = rr * F.G + ((rr & 1) ? F.G - 1 - vcu_ : vcu_); if (i >= NGRP) break;
        const int b = i & 1, t0 = T - G - G * (i >> 1), t = t0 + g; const size_t row = (size_t)b * T + t;
        if (t0 + G - 1 < 256) {
            if (par == 0) { const unsigned e = lane * 4; v2u o; o.x = e | ((e + 1) << 16); o.y = (e + 2) | ((e + 3) << 16); *(GAS v2u*)(SEL + row * 256 + lane * 4) = o; }
            continue; }
        bf16x8 aq[4]; float wv[16];
#pragma unroll
        for (int ks = 0; ks < 4; ++ks) aq[ks] = *(const GAS bf16x8*)(PROJ + row * DINM + O_IQ + r32 * IDX_D + 16 * ks + 8 * hi);
#pragma unroll
        for (int r = 0; r < 16; ++r) wv[r] = WI[row * IDX_H + crow(r, hi)];
        const int ntile = (t0 + G - 1) / KT + 1;
        const bf16* kib = KI + (size_t)b * T * IDX_D;
        v4u sa0, sa1, sa2, sa3, sb0, sb1, sb2, sb3;
        const int p0k = tid >> 3, p0c = tid & 7;
#define DS_LOAD(R, tl) do { const bf16* s_ = kib + (size_t)((tl) * KT + p0k) * IDX_D + p0c * 8; R##0 = *(const GAS v4u*)s_; R##1 = *(const GAS v4u*)(s_ + 64 * IDX_D); R##2 = *(const GAS v4u*)(s_ + 128 * IDX_D); R##3 = *(const GAS v4u*)(s_ + 192 * IDX_D); } while (0)
#define DS_WRITE(R, bf) do { LAS unsigned char* d_ = L + OFF_KI + (bf) * SZ_KI + p0k * KSTR + p0c * 16; *(LAS v4u*)d_ = R##0; *(LAS v4u*)(d_ + 64 * KSTR) = R##1; *(LAS v4u*)(d_ + 128 * KSTR) = R##2; *(LAS v4u*)(d_ + 192 * KSTR) = R##3; } while (0)
        __syncthreads();
        if (tid < G * CNT_W) cnt_all[tid] = 0u;
        ((LAS unsigned*)(L + OFF_SEL))[tid] = 0u;
        DS_LOAD(sa, 0); if (ntile > 1) DS_LOAD(sb, 1);
        DS_WRITE(sa, 0);
        __syncthreads();
        float smin = 3.0e38f, smax = -3.0e38f;
#define DS_MF(ACC, sb_) do { ACC = (f32x16){}; _Pragma("unroll") for (int ks = 0; ks < 4; ++ks) ACC = __builtin_amdgcn_mfma_f32_32x32x16_bf16(aq[ks], kf[sb_][ks], ACC, 0, 0, 0); } while (0)
#define DS_EP(ACC, sb_, tl) do { const int key = (tl) * KT + (par + 2 * (sb_)) * 32 + r32; float s = 0.f; \
            _Pragma("unroll") for (int r = 0; r < 16; ++r) { const int ai_ = __float_as_int(ACC[r]); s += wv[r] * __int_as_float(ai_ > 0 ? ai_ : 0); }   \
            { auto rr = __builtin_amdgcn_permlane32_swap(__float_as_uint(s), __float_as_uint(s), false, false); s = __uint_as_float(rr[0]) + __uint_as_float(rr[1]); } \
            if (hi == 0 && key <= t) { sc[key] = s; smin = fminf(smin, s); smax = fmaxf(smax, s); } } while (0)
#define DS_STEP(tl, RL, RW) do { const int bufi = (tl) & 1; \
            if ((tl) + 2 < ntile) DS_LOAD(RL, (tl) + 2); \
            { const unsigned kbase = (unsigned)(size_t)(L + OFF_KI + bufi * SZ_KI + (par * 32 + r32) * KSTR + 16 * hi); \
              bf16x8 kf[4][4]; \
              _Pragma("unroll") for (int sb_ = 0; sb_ < 4; ++sb_) \
                  _Pragma("unroll") for (int ks = 0; ks < 4; ++ks) asm volatile("ds_read_b128 %0, %1 offset:%2" : "=v"(kf[sb_][ks]) : "v"(kbase), "i"(sb_ * 64 * KSTR + ks * 32) : "memory"); \
                \
              f32x16 accA, accB; \
              asm volatile("s_waitcnt lgkmcnt(12)" ::: "memory"); __builtin_amdgcn_sched_barrier(0); DS_MF(accA, 0); __builtin_amdgcn_sched_barrier(0); \
              asm volatile("s_waitcnt lgkmcnt(8)" ::: "memory"); __builtin_amdgcn_sched_barrier(0); DS_MF(accB, 1); __builtin_amdgcn_sched_barrier(0); \
              DS_EP(accA, 0, tl); __builtin_amdgcn_sched_barrier(0); \
              asm volatile("s_waitcnt lgkmcnt(4)" ::: "memory"); __builtin_amdgcn_sched_barrier(0); DS_MF(accA, 2); __builtin_amdgcn_sched_barrier(0); \
              DS_EP(accB, 1, tl); __builtin_amdgcn_sched_barrier(0); \
              asm volatile("s_waitcnt lgkmcnt(0)" ::: "memory"); __builtin_amdgcn_sched_barrier(0); DS_MF(accB, 3); __builtin_amdgcn_sched_barrier(0); \
              DS_EP(accA, 2, tl); __builtin_amdgcn_sched_barrier(0); \
              DS_EP(accB, 3, tl); } \
            if ((tl) + 1 < ntile) DS_WRITE(RW, bufi ^ 1); \
            asm volatile("s_waitcnt lgkmcnt(0)" ::: "memory"); __builtin_amdgcn_s_barrier(); asm volatile("" ::: "memory");   } while (0)
        for (int tl = 0; tl < ntile; tl += 2) { DS_STEP(tl, sa, sb); if (tl + 1 < ntile) DS_STEP(tl + 1, sb, sa); }
#undef DS_STEP
#undef DS_MF
#undef DS_EP
#undef DS_LOAD
#undef DS_WRITE
#ifndef REP_SELSTAGE
#define REP_SELSTAGE 1
#endif
        for (int rep_ = 0; rep_ < REP_SELSTAGE; ++rep_) {
        if (rep_) { __syncthreads(); if (tid < G * CNT_W) cnt_all[tid] = 0u; __syncthreads(); }
#pragma unroll
        for (int o = 1; o < 64; o <<= 1) { smin = fminf(smin, __shfl_xor(smin, o)); smax = fmaxf(smax, __shfl_xor(smax, o)); }
        if (lane == 0) { cnt[4 + 2 * par] = __float_as_uint(smin); cnt[5 + 2 * par] = __float_as_uint(smax); }
        for (int e = tid; e < G * NB1; e += NWAVES * 64) ((LAS unsigned*)(L + OFF_HIST))[e] = 0u;
        __syncthreads();
        const float lo = fminf(__uint_as_float(cnt[4]), __uint_as_float(cnt[6])), hi_ = fmaxf(__uint_as_float(cnt[5]), __uint_as_float(cnt[7]));
        const float bscale = hi_ > lo ? ((float)NB1 - 0.5f) / (hi_ - lo) : 0.f;
        const int n = t + 1;
        for (int e0 = par * 64 + lane; e0 < n; e0 += 512) {
            float sv_[4];
#pragma unroll
            for (int u = 0; u < 4; ++u) sv_[u] = sc[(e0 + 128 * u) & 4095];
#pragma unroll
            for (int u = 0; u < 4; ++u) if (e0 + 128 * u < n) { int bin = (int)((sv_[u] - lo) * bscale); bin = bin > NB1 - 1 ? NB1 - 1 : bin;
                __hip_atomic_fetch_add(&hist[bin], 1u, __ATOMIC_RELAXED, __HIP_MEMORY_SCOPE_WORKGROUP); } }
        __syncthreads();
        int B1, need; unsigned hB1;
        { unsigned hh[16]; unsigned tot = 0;
#pragma unroll
          for (int q = 0; q < 4; ++q) { const v4u v = *(const LAS v4u*)&hist[16 * lane + 4 * q]; hh[4 * q] = v.x; hh[4 * q + 1] = v.y; hh[4 * q + 2] = v.z; hh[4 * q + 3] = v.w; tot += v.x + v.y + v.z + v.w; }
          unsigned suf = tot;
#pragma unroll
          for (int o = 1; o < 64; o <<= 1) { const unsigned v = __shfl_down(suf, o); if (lane + o < 64) suf += v; }
          const unsigned long long bal = __ballot(suf >= 256u);
          const int ls = 63 - __builtin_clzll(bal | 1ull);
          unsigned cum = suf - tot; int bb = 0; unsigned cg = 0, hb = 0; bool found = false;
#pragma unroll
          for (int q = 15; q >= 0; --q) { if (!found) { if (cum + hh[q] >= 256u) { bb = q; cg = cum; hb = hh[q]; found = true; } else cum += hh[q]; } }
          B1 = 16 * ls + __shfl(bb, ls); need = 256 - (int)__shfl(cg, ls); hB1 = __shfl(hb, ls); }
        if (lane == 0 && par == 0) { unsigned z_ = 0u; asm volatile("" : "+v"(z_)); cnt[2] = ~z_; cnt[3] = z_; }
        __syncthreads();
        LAS unsigned short* cand = (LAS unsigned short*)(cnt + 8);
        { unsigned kmn = 0xFFFFFFFFu, kmx = 0u;
          for (int e0 = par * 64 + lane; e0 < n; e0 += 512) { float sv_[4];
#pragma unroll
            for (int u = 0; u < 4; ++u) sv_[u] = sc[(e0 + 128 * u) & 4095];
#pragma unroll
            for (int u = 0; u < 4; ++u) { const int e = e0 + 128 * u; if (e < n) { const float s = sv_[u]; int bin = (int)((s - lo) * bscale); bin = bin > NB1 - 1 ? NB1 - 1 : bin;
              if (bin > B1) __hip_atomic_fetch_or(&bmp[e >> 5], 1u << (e & 31), __ATOMIC_RELAXED, __HIP_MEMORY_SCOPE_WORKGROUP);
              else if (bin == B1) { const unsigned pos = __hip_atomic_fetch_add(&cnt[0], 1u, __ATOMIC_RELAXED, __HIP_MEMORY_SCOPE_WORKGROUP); if (pos < 64u) cand[pos] = (unsigned short)e;
                  const unsigned k = fkey(s); kmn = k < kmn ? k : kmn; kmx = k > kmx ? k : kmx; } } } }
          if (hB1 > 64u) {
#pragma unroll
              for (int o = 1; o < 64; o <<= 1) { const unsigned a = __shfl_xor(kmn, o), c2 = __shfl_xor(kmx, o); kmn = a < kmn ? a : kmn; kmx = c2 > kmx ? c2 : kmx; }
              if (lane == 0) { __hip_atomic_fetch_min(&cnt[2], kmn, __ATOMIC_RELAXED, __HIP_MEMORY_SCOPE_WORKGROUP); __hip_atomic_fetch_max(&cnt[3], kmx, __ATOMIC_RELAXED, __HIP_MEMORY_SCOPE_WORKGROUP); } } }
        if (lane == 0 && par == 0) cnt[1] = hB1 > 64u ? 0u : 1u;
        for (int e = tid; e < G * NB1; e += NWAVES * 64) ((LAS unsigned*)(L + OFF_HIST))[e] = 0u;
        __syncthreads();
        if (hB1 <= 64u) {
            if (par == 0) { const int nc = (int)hB1; const int me = lane < nc ? (int)cand[lane] : 0; const unsigned mk = lane < nc ? fkey(sc[me]) : 0u; int rank = 0;
                for (int jn = 0; jn < nc; ++jn) { const int oe = __builtin_amdgcn_readlane(me, jn); const unsigned ok = (unsigned)__builtin_amdgcn_readlane((int)mk, jn); rank += (ok > mk || (ok == mk && oe < me)) ? 1 : 0; }
                if (lane < nc && rank < need) __hip_atomic_fetch_or(&bmp[me >> 5], 1u << (me & 31), __ATOMIC_RELAXED, __HIP_MEMORY_SCOPE_WORKGROUP); } }
        const bool any_fb = (cnt_all[1] + cnt_all[CNT_W + 1] + cnt_all[2 * CNT_W + 1] + cnt_all[3 * CNT_W + 1]) != (unsigned)G;
        if (any_fb) {
        unsigned kmin = cnt[2], kmax = cnt[3];
        bool done = hB1 <= 64u;
        for (int lev = 0; lev < 4; ++lev) {
            const unsigned width = kmax - kmin; const int bits = 32 - __builtin_clz(width | 1u);
            int sh = bits - 8; if (sh < 0) sh = 0;
            if (!done) for (int e = par * 64 + lane; e < n; e += 128) { const unsigned k = fkey(sc[e]); if (k >= kmin && k <= kmax) __hip_atomic_fetch_add(&hist[(k - kmin) >> sh], 1u, __ATOMIC_RELAXED, __HIP_MEMORY_SCOPE_WORKGROUP); }
            __syncthreads();
            unsigned B = 0, cgt = 0, hB = 0;
            if (!done) {
                const unsigned h0 = hist[4 * lane], h1 = hist[4 * lane + 1], h2 = hist[4 * lane + 2], h3 = hist[4 * lane + 3];
                unsigned suf = h0 + h1 + h2 + h3;
#pragma unroll
                for (int o = 1; o < 64; o <<= 1) { const unsigned v = __shfl_down(suf, o); if (lane + o < 64) suf += v; }
                const unsigned long long bal = __ballot(suf >= (unsigned)need);
                const int ls = 63 - __builtin_clzll(bal | 1ull);
                unsigned cum = suf - (h0 + h1 + h2 + h3), bb = 0, cg = 0, hb = 0;
                if (cum + h3 >= (unsigned)need) { bb = 3; cg = cum; hb = h3; }
                else if (cum + h3 + h2 >= (unsigned)need) { bb = 2; cg = cum + h3; hb = h2; }
                else if (cum + h3 + h2 + h1 >= (unsigned)need) { bb = 1; cg = cum + h3 + h2; hb = h1; }
                else { bb = 0; cg = cum + h3 + h2 + h1; hb = h0; }
                B = 4 * ls + __shfl(bb, ls); cgt = __shfl(cg, ls); hB = __shfl(hb, ls);
            }
            __syncthreads();
            if (!done) {
                const bool all_b = (cgt + hB == (unsigned)need);
                const bool ties = !all_b && sh == 0;
                for (int e = par * 64 + lane; e < n; e += 128) { const unsigned k = fkey(sc[e]);
                    if (k >= kmin && k <= kmax) { const unsigned bin = (k - kmin) >> sh;
                        if (bin > B || (all_b && bin == B)) { __hip_atomic_fetch_or(&bmp[e >> 5], 1u << (e & 31), __ATOMIC_RELAXED, __HIP_MEMORY_SCOPE_WORKGROUP); } } }
                if (ties) { if (par == 0) { int left = need - (int)cgt; const unsigned kk = kmin + B;
                        for (int e0 = 0; e0 < n && left > 0; e0 += 64) { const int e = e0 + lane; const bool eq = e < n && fkey(sc[e]) == kk;
                            const unsigned long long bq = __ballot(eq); const int before = __popcll(bq & ((1ull << lane) - 1ull));
                            if (eq && before < left) { __hip_atomic_fetch_or(&bmp[e >> 5], 1u << (e & 31), __ATOMIC_RELAXED, __HIP_MEMORY_SCOPE_WORKGROUP); }
                            left -= __popcll(bq); } }
                    done = true; }
                else if (all_b) done = true;
                else { need -= (int)cgt; const unsigned long long lo2 = (unsigned long long)kmin + ((unsigned long long)B << sh), hi2 = lo2 + ((1ull << sh) - 1ull);
                    kmin = (unsigned)lo2; kmax = hi2 < (unsigned long long)kmax ? (unsigned)hi2 : kmax; }
            }
            if (lane == 0 && par == 0) cnt[1] = done ? 1u : 0u;
            for (int e = tid; e < G * NB1; e += NWAVES * 64) ((LAS unsigned*)(L + OFF_HIST))[e] = 0u;
            __syncthreads();
            if (cnt_all[1] + cnt_all[CNT_W + 1] + cnt_all[2 * CNT_W + 1] + cnt_all[3 * CNT_W + 1] == (unsigned)G) break;
        }
        }
        __syncthreads();
        if (par == 0) {
            unsigned w0 = bmp[2 * lane], w1 = bmp[2 * lane + 1]; const int c = __popc(w0) + __popc(w1); int pre = c;
#pragma unroll
            for (int o = 1; o < 64; o <<= 1) { const int v = __shfl_up(pre, o); if (lane >= o) pre += v; }
            int pos = pre - c; unsigned short* so = SEL + row * 256;
            while (w0) { const int bb = __builtin_ctz(w0); w0 &= w0 - 1u; if (pos < 256) so[pos] = (unsigned short)(lane * 64 + bb); ++pos; }
            while (w1) { const int bb = __builtin_ctz(w1); w1 &= w1 - 1u; if (pos < 256) so[pos] = (unsigned short)(lane * 64 + 32 + bb); ++pos; }
        }
        }
    }
}
#ifndef REP_GATHER
#define REP_GATHER 1
#endif
constexpr int DA_XOFF = 131072, DA_SOFF = DA_XOFF + 8192;
constexpr int DA_BOFF = DA_SOFF + 2048;
static_assert(DA_BOFF + 8192 <= RING_BYTES, "dsa attention LDS map");
__device__ __forceinline__ void dsa_attn_phase(Frame& F) {
    const int lane = lane_now(), w = WAVE(F), tid = w * 64 + lane, g = w >> 1, half = w & 1, fr = lane & 15, fq = lane >> 4;
    LAS unsigned char* cbuf = F.lds + RING_OFF + g * 32768; LAS unsigned char* xb = F.lds + RING_OFF + DA_XOFF + g * 2048;
    const bf16* CKVN = (const bf16*)(WSL(F) + WS_CKVN); const bf16* QLAT = (const bf16*)(WSL(F) + WS_QLAT); const unsigned short* SEL = (const unsigned short*)(WSL(F) + WS_SEL);
    bf16* OLAT = (bf16*)(WSL(F) + WS_OLAT); const float* tab = karg(3);
    const int hh = fr < DSA_H ? fr : DSA_H - 1;
    constexpr float LOG2E = 1.4426950408889634f;
    const int q4 = (lane >> 2) & 3, p4 = lane & 3, keyl = 4 * fq + q4;
    LAS float* btab = (LAS float*)(F.lds + RING_OFF + DA_BOFF);
    for (int e = tid; e < 128 * 16; e += NWAVES * 64) { const int d = e >> 4, h_ = e & 15; btab[e] = tab[bucket(d) * 32 + 22 + (h_ < DSA_H ? h_ : DSA_H - 1)] * LOG2E; }
    const int vcu_ = VCU(F), per_x = F.G >= 8 ? F.G / 8 : 1, xcd = vcu_ / per_x, jx = vcu_ % per_x, nxb = F.G >= 8 ? 4 : F.G;
    for (int r8 = 0;; ++r8) {
        int b, t0;
        if (F.G >= 8 && F.G % 8 == 0) { const int gi = r8 * (nxb * per_x) + (xcd >> 1) * per_x + jx; if (gi >= T / 4) break; b = xcd & 1; t0 = T - 4 - 4 * gi; }
        else { const int gi = r8 * F.G + vcu_; if (gi >= M / 4) break; b = gi & 1; t0 = T - 4 - 4 * (gi >> 1); }
        const int t = t0 + g, q = b * T + t, nsel = t + 1 < 256 ? t + 1 : 256;
        const int nmax = ((t0 + 4 < 256 ? t0 + 4 : 256) + 15) >> 4;
        bf16x8 ql[8];
#pragma unroll
        for (int ks = 0; ks < 8; ++ks) ql[ks] = __builtin_nontemporal_load((const GAS bf16x8*)(QLAT + (size_t)q * (DSA_H * KVL) + hh * KVL + half * 256 + 32 * ks + 8 * fq));
        f32x4 O[16];
#pragma unroll
        for (int ct = 0; ct < 16; ++ct) O[ct] = (f32x4){0.f, 0.f, 0.f, 0.f};
        float m_run = -1e30f, l_run = 0.f;
        const bf16* cb = CKVN + (size_t)b * T * KVL;
        const LAS unsigned short* srow = (const LAS unsigned short*)(F.lds + RING_OFF + DA_SOFF + g * 512);
        v2u selw; if (half == 0) selw = *(const GAS v2u*)(SEL + (size_t)q * 256 + lane * 4);
#define DA_RD128(dst, addr, off) asm volatile("ds_read_b128 %0, %1 offset:%2" : "=v"(dst) : "v"(addr), "i"(off) : "memory")
#define DA_RDTR(dst, addr, off) asm volatile("ds_read_b64_tr_b16 %0, %1 offset:%2" : "=v"(dst) : "v"(addr), "i"(off) : "memory")
#define DA_ISSUE(sv_, bf_) do { _Pragma("unroll") for (int k = 0; k < 8; ++k) { const int slot_ = half * 8 + k; const int idx_ = __builtin_amdgcn_readlane(sv_, slot_); \
        _Pragma("unroll") for (int rg_ = 0; rg_ < REP_GATHER; ++rg_) __builtin_amdgcn_global_load_lds((const GAS unsigned*)(cb + (size_t)idx_ * KVL + ((lane ^ slot_) & 63) * 8), (LAS unsigned*)(cbuf + (bf_) * 16384 + slot_ * 1024), 16, 0, 0); } } while (0)
        __syncthreads();
        if (half == 0) *(LAS v2u*)(F.lds + RING_OFF + DA_SOFF + g * 512 + lane * 8) = selw;
        __syncthreads();
        int selv = fr < nsel ? (int)srow[fr] : 0;
        DA_ISSUE(selv, 0);
        for (int c = 0; c < nmax; ++c) {
            const int cur = c & 1;
            asm volatile("s_waitcnt vmcnt(0)" ::: "memory");
            __builtin_amdgcn_s_barrier();
            asm volatile("" ::: "memory"); __builtin_amdgcn_sched_barrier(0);
            if (c + 1 < nmax) { const int slot = (c + 1) * 16 + fr; selv = slot < nsel ? (int)srow[slot] : 0; DA_ISSUE(selv, cur ^ 1); }
            const LAS unsigned char* buf = cbuf + cur * 16384;
            f32x4 s4 = (f32x4){0.f, 0.f, 0.f, 0.f};
            { bf16x8 af[8];
#pragma unroll
              for (int i4 = 0; i4 < 4; ++i4) { const unsigned sa = (unsigned)(size_t)(buf + fr * 1024 + half * 512 + (((4 * i4 + fq) ^ fr) << 4));
                  DA_RD128(af[i4], sa, 0); DA_RD128(af[4 + i4], sa, 256); }
              asm volatile("s_waitcnt lgkmcnt(0)" ::: "memory"); __builtin_amdgcn_sched_barrier(0);
#pragma unroll
              for (int ks = 0; ks < 8; ++ks) s4 = __builtin_amdgcn_mfma_f32_16x16x32_bf16(af[ks], ql[ks], s4, 0, 0, 0); }
            *(LAS f32x4*)(xb + half * 1024 + lane * 16) = s4;
            asm volatile("s_waitcnt lgkmcnt(0)" ::: "memory");
            __builtin_amdgcn_s_barrier();
            asm volatile("" ::: "memory"); __builtin_amdgcn_sched_barrier(0);
            s4 = s4 + *(const LAS f32x4*)(xb + (half ^ 1) * 1024 + lane * 16);
            float sv[4]; float cmax = -__builtin_inff();
#pragma unroll
            for (int r = 0; r < 4; ++r) { const int ks_ = 4 * fq + r; const bool valid = c * 16 + ks_ < nsel; const int idx = valid ? (int)srow[c * 16 + ks_] : 0;
                int dist = t - idx; dist = dist > 127 ? 127 : dist; const float bias = btab[dist * 16 + fr];
                sv[r] = valid ? s4[r] * (SCALE * LOG2E) + bias : -__builtin_inff(); cmax = fmaxf(cmax, sv[r]); }
            { auto r1 = __builtin_amdgcn_permlane16_swap(__float_as_uint(cmax), __float_as_uint(cmax), false, false); cmax = fmaxf(__uint_as_float(r1[0]), __uint_as_float(r1[1]));
              auto r2 = __builtin_amdgcn_permlane32_swap(__float_as_uint(cmax), __float_as_uint(cmax), false, false); cmax = fmaxf(__uint_as_float(r2[0]), __uint_as_float(r2[1])); }
            const bool grow = __any(cmax - m_run > 10.f);
            const float m_new = grow ? fmaxf(m_run, cmax) : m_run, alpha = grow ? __builtin_amdgcn_exp2f(m_run - m_new) : 1.f;
            float p[4], ps = 0.f;
#pragma unroll
            for (int r = 0; r < 4; ++r) { p[r] = __builtin_amdgcn_exp2f(sv[r] - m_new); ps += p[r]; }
            { auto r1 = __builtin_amdgcn_permlane16_swap(__float_as_uint(ps), __float_as_uint(ps), false, false); ps = __uint_as_float(r1[0]) + __uint_as_float(r1[1]);
              auto r2 = __builtin_amdgcn_permlane32_swap(__float_as_uint(ps), __float_as_uint(ps), false, false); ps = __uint_as_float(r2[0]) + __uint_as_float(r2[1]); }
            l_run = l_run * alpha + ps; m_run = m_new;
            if (grow) { float ar[4];
#pragma unroll
                for (int r = 0; r < 4; ++r) ar[r] = __shfl(alpha, 4 * fq + r);
#pragma unroll
                for (int ct = 0; ct < 16; ++ct)
#pragma unroll
                    for (int r = 0; r < 4; ++r) O[ct][r] *= ar[r]; }
            v2u pw; pw.x = pk2(p[0], p[1]); pw.y = pk2(p[2], p[3]);
            const s16x4 pa = __builtin_bit_cast(s16x4, pw);
            { const unsigned rb = (unsigned)(size_t)(buf + keyl * 1024 + half * 512 + (p4 & 1) * 8); s16x4 bvv[16];
#pragma unroll
              for (int i8 = 0; i8 < 8; ++i8) { const unsigned ad = rb + (((2 * i8 + (p4 >> 1)) ^ keyl) << 4);
                  DA_RDTR(bvv[i8], ad, 0); DA_RDTR(bvv[8 + i8], ad, 256); }
              asm volatile("s_waitcnt lgkmcnt(0)" ::: "memory"); __builtin_amdgcn_sched_barrier(0);
#pragma unroll
              for (int ct = 0; ct < 16; ++ct) O[ct] = __builtin_amdgcn_mfma_f32_16x16x16bf16_1k(pa, bvv[ct], O[ct], 0, 0, 0); }
        }
#undef DA_ISSUE
#undef DA_RD128
#undef DA_RDTR
        float rl[4];
#pragma unroll
        for (int r = 0; r < 4; ++r) rl[r] = 1.f / __shfl(l_run, 4 * fq + r);
        { LAS unsigned char* stg = cbuf + (nmax & 1) * 16384 + half * 8192;
          LAS unsigned char* wb = stg + (4 * fq * 256 + fr) * 2;
#pragma unroll
          for (int r = 0; r < 4; ++r) if (4 * fq + r < DSA_H) {
#pragma unroll
              for (int ct = 0; ct < 16; ++ct) *(LAS unsigned short*)(wb + r * 512 + ct * 32) = (unsigned short)f2bf(O[ct][r] * rl[r]); }
          asm volatile("s_waitcnt lgkmcnt(0)" ::: "memory");
#pragma unroll
          for (int i5 = 0; i5 < 5; ++i5) { const int e = i5 * 512 + lane * 8, hd = e >> 8, col = e & 255;
              __builtin_nontemporal_store(*(const LAS v4u*)(stg + i5 * 1024 + lane * 16), (GAS v4u*)(OLAT + (size_t)q * (DSA_H * KVL) + hd * KVL + half * 256 + col)); } }
    }
}


template <class P> __device__ __forceinline__ P* lnd(P* p) { asm volatile("" : "+s"(p)); return p; }
#ifndef REP_FA
#define REP_FA 1
#endif
#ifndef REP_DA
#define REP_DA 1
#endif
#ifndef REP_MS
#define REP_MS 1
#endif
#ifndef REP_TAIL
#define REP_TAIL 1
#endif
#ifndef REP_P0
#define REP_P0 1
#endif
#ifndef REP_PROJ
#define REP_PROJ 1
#endif
#ifndef REP_PREP
#define REP_PREP 1
#endif
#ifndef REP_SEL
#define REP_SEL 1
#endif
#ifndef REP_ATTN
#define REP_ATTN 1
#endif
#ifndef REP_POST
#define REP_POST 1
#endif
#ifndef REP_WO
#define REP_WO 1
#endif
#ifndef REP_LN
#define REP_LN 1
#endif
#ifndef REP_UP
#define REP_UP 1
#endif
#ifndef REP_DN
#define REP_DN 1
#endif
constexpr int PH_PER_LAYER = 10, N_PHASES = 1 + DEPTH * PH_PER_LAYER;
struct Args { const float* in[17]; float* out; unsigned char* ws; int ph_lo, ph_hi, li, pad; };
__global__ void __launch_bounds__(NWAVES * 64, 2) mk_fwd(Args args) {
    extern __shared__ __attribute__((aligned(16))) unsigned char lds[];
    Frame F;
    F.lds = (LAS unsigned char*)lds;
    F.MISC = (volatile LAS unsigned*)(F.lds + MISC_OFF);
    F.wave = __builtin_amdgcn_readfirstlane((int)threadIdx.x >> 6);
    F.G = gridDim.x; { const int bx = blockIdx.x; F.vcu = (F.G % 8 == 0) ? (bx % 8) * (F.G / 8) + bx / 8 : bx; }
    F.ws = args.ws; F.ctl = (gu32*)(args.ws + WS_CTL);
    { for (int u = F.wave * 64 + lane_now(); u < (LDS_BYTES - LDSCTL_OFF) / 4; u += NWAVES * 64) ((LAS unsigned*)(F.lds + LDSCTL_OFF))[u] = 0u; }
    __syncthreads();
    XcdBarrier bar = xcd_barrier_post((unsigned*)(F.ctl + CW_BAR) + args.li * XCD_BAR_WORDS, F.MISC + 8, F.wave);
    const int lo = args.ph_lo, hi = args.ph_hi;
#define IN(k) (lo <= (k) && (k) < hi)
#ifndef REP_BAR
#define REP_BAR 1
#endif
#define SEAM(k) do { if (IN(k) && IN((k) + 1)) { for (int rb_ = 0; rb_ < REP_BAR; ++rb_) xcd_barrier(bar); } } while (0)

#define XN ((bf16*)(WSL(F) + WS_XN))
#define PROJ ((bf16*)(WSL(F) + WS_PROJ))
#define TAIL ((float*)(WSL(F) + WS_TAIL))
#define Y ((bf16*)(WSL(F) + WS_Y))
#define Z ((bf16*)(WSL(F) + WS_Z))
#define HID ((bf16*)(WSL(F) + WS_HID))

    for (int rep_ = 0; rep_ < REP_P0; ++rep_) { if (IN(0)) { p0_prologue(F); }
    SEAM(0); }
    for (int l = 0; l < DEPTH; ++l) {
        const int pb = 1 + l * PH_PER_LAYER;
        for (int rep_ = 0; rep_ < REP_PROJ; ++rep_) { if (IN(pb + 0)) {
            pg8::Gemm g{lnd(XN), lnd(w_layer(F, l, 0)), M, DINM, DM}; pg8::StaticOrder S; S.init(M, DINM, F.G, (int)blockIdx.x);
            pg8::EpiBf16<0> E{lnd(PROJ), DINM};
            pg8::gemm_phase<pg8::EpiBf16<0>, pg8::StaticOrder, PG8_ALIGN, PG8_SP2>(F.lds + RING_OFF, g, S, E, WAVE(F));
            for (int rt_ = 0; rt_ < REP_TAIL; ++rt_) tail_phase(F, lnd(XN), lnd(w_layer(F, l, 0) + (size_t)DINM * DM), lnd(TAIL));
        }
        SEAM(pb + 0); }
        for (int rep_ = 0; rep_ < REP_PREP; ++rep_) { if (IN(pb + 1)) { prep_phase(F, l); qlat_phase(F, l); }
        SEAM(pb + 1); }
        for (int rep_ = 0; rep_ < REP_SEL; ++rep_) { if (IN(pb + 2)) { for (int r2_ = 0; r2_ < REP_MS; ++r2_) moba_select_phase(F); dsa_select_phase(F); }
        SEAM(pb + 2); }
        for (int rep_ = 0; rep_ < REP_ATTN; ++rep_) { if (IN(pb + 3)) { for (int r2_ = 0; r2_ < REP_FA; ++r2_) { attn_phase(F); __syncthreads(); } for (int r2_ = 0; r2_ < REP_DA; ++r2_) { dsa_attn_phase(F); __syncthreads(); } }
        SEAM(pb + 3); }
        for (int rep_ = 0; rep_ < REP_POST; ++rep_) { if (IN(pb + 4)) { post_phase(F, l); dsa_out_phase(F, l); }
        SEAM(pb + 4); }
        for (int rep_ = 0; rep_ < REP_WO; ++rep_) { if (IN(pb + 5)) {
            pg8::Gemm g{lnd(Y), lnd(w_layer(F, l, 1)), M, DM, DM}; pg8::StaticOrder S; S.init(M, DM, F.G, (int)blockIdx.x);
            pg8::EpiResBf16 E{lnd(Z), lnd(XN), DM, ALPHA};
            pg8::gemm_phase<pg8::EpiResBf16, pg8::StaticOrder, PG8_ALIGN, PG8_SP2>(F.lds + RING_OFF, g, S, E, WAVE(F));
        }
        SEAM(pb + 5); }
        for (int rep_ = 0; rep_ < REP_LN; ++rep_) { if (IN(pb + 6)) ln_phase(F, lnd(Z), lnd(karg(11) + (size_t)l * DM), lnd(karg(12) + (size_t)l * DM), nullptr, lnd(XN));
        SEAM(pb + 6); }
        for (int rep_ = 0; rep_ < REP_UP; ++rep_) { if (IN(pb + 7)) {
            pg8::Gemm g{lnd(XN), lnd(w_layer(F, l, 2)), M, DFF, DM}; pg8::StaticOrder S; S.init(M, DFF, F.G, (int)blockIdx.x);
            pg8::EpiBf16<1> E{lnd(HID), DFF};
            pg8::gemm_phase<pg8::EpiBf16<1>, pg8::StaticOrder, PG8_ALIGN, PG8_SP2>(F.lds + RING_OFF, g, S, E, WAVE(F));
        }
        SEAM(pb + 7); }
        for (int rep_ = 0; rep_ < REP_DN; ++rep_) { if (IN(pb + 8)) {
            pg8::Gemm g{lnd(HID), lnd(w_layer(F, l, 3)), M, DM, DFF}; pg8::StaticOrder S; S.init(M, DM, F.G, (int)blockIdx.x);
            pg8::EpiResBf16 E{lnd(Z), lnd(XN), DM, ALPHA};
            pg8::gemm_phase<pg8::EpiResBf16, pg8::StaticOrder, PG8_ALIGN, PG8_SP2>(F.lds + RING_OFF, g, S, E, WAVE(F));
        }
        SEAM(pb + 8); }
        for (int rep_ = 0; rep_ < REP_LN; ++rep_) { if (IN(pb + 9)) { const bool fin = (l == DEPTH - 1); ln_phase(F, lnd(Z), lnd(karg(15) + (size_t)l * DM), lnd(karg(16) + (size_t)l * DM), fin ? lnd((float*)karg(17)) : nullptr, fin ? nullptr : lnd(XN)); }
        SEAM(pb + 9); }
    }
#undef IN
#undef SEAM
#undef XN
#undef PROJ
#undef TAIL
#undef Y
#undef Z
#undef HID
}


extern "C" void kernel_launch(void* const* d_in, const int* in_sizes, int n_in, void* d_out, int out_size, void* d_ws, size_t ws_size, hipStream_t stream) {
    static int grid = 0;
    if (grid == 0) {
        if (n_in != 17 || in_sizes[0] != M * DM || out_size != M * DM || ws_size < WS_END) { fprintf(stderr, "kernel_launch: unexpected shapes / workspace (n_in %d, ws %zu need %zu); nothing launched\n", n_in, ws_size, (size_t)WS_END); grid = -1; return; }
        int dev = 0, cus = 0, per_cu = 0;
        if (hipGetDevice(&dev) != hipSuccess || hipDeviceGetAttribute(&cus, hipDeviceAttributeMultiprocessorCount, dev) != hipSuccess) { grid = -1; return; }
        if (hipFuncSetAttribute((const void*)mk_fwd, hipFuncAttributeMaxDynamicSharedMemorySize, LDS_BYTES) != hipSuccess) { fprintf(stderr, "kernel_launch: hipFuncSetAttribute failed\n"); grid = -1; return; }
        if (hipOccupancyMaxActiveBlocksPerMultiprocessor(&per_cu, (const void*)mk_fwd, NWAVES * 64, LDS_BYTES) != hipSuccess || per_cu < 1)
            fprintf(stderr, "kernel_launch: note: occupancy query reports %d workgroups per CU\n", per_cu);
        (void)hipGetLastError();
        grid = cus;
    }
    if (grid < 0) return;
    (void)hipMemsetAsync((char*)d_ws + WS_CTL, 0, CTL_ZERO_BYTES, stream);
    Args a{};
    for (int i = 0; i < 17; ++i) a.in[i] = (const float*)d_in[i];
    a.out = (float*)d_out; a.ws = (unsigned char*)d_ws; a.ph_lo = 0; a.ph_hi = N_PHASES; a.li = 0; a.pad = 0;
    hipLaunchKernelGGL(mk_fwd, dim3(grid), dim3(NWAVES * 64), LDS_BYTES, stream, a);
    const hipError_t le = hipPeekAtLastError();
    if (le != hipSuccess) fprintf(stderr, "kernel_launch: launch failed: %s\n", hipGetErrorName(le));
}
```

```cpp
#include <hip/hip_runtime.h>
#include <cstdio>
#include <cstdint>
#include <cmath>
namespace pg8 {
#define PG8_LAS __attribute__((address_space(3)))
typedef unsigned short bf16_t;
typedef short bf16x8 __attribute__((ext_vector_type(8)));
typedef float f32x4 __attribute__((ext_vector_type(4)));
typedef unsigned u32x4 __attribute__((ext_vector_type(4)));
constexpr int BM = 256, BK = 64, HALF = 128, HTB = HALF * BK * 2  , STAGE_BYTES = 8 * HTB, NXCD = 8, WGM = 8;

__host__ __device__ __forceinline__ int lds_byte(int r, int c) { const int st = (r >> 4) * 2 + (c >> 5), rr = r & 15, cc = c & 31, ob = rr * 64 + cc * 2; return st * 1024 + (ob ^ (((ob >> 9) & 1) << 5)); }
__host__ __device__ __forceinline__ void stage_rc(int b, int& R, int& C) { const int st = b / 1024, sb = b % 1024, swz = sb ^ (((sb >> 9) & 1) << 5); R = (st >> 1) * 16 + swz / 64; C = (st & 1) * 32 + (swz % 64) / 2; }
__host__ __device__ __forceinline__ int perm32(int rho) { const int n = rho >> 4, i = rho & 15; return 8 * (i >> 2) + 4 * n + (i & 3); }

struct Unit { int pm, pn; };
struct Gemm { const bf16_t* A; const bf16_t* Bt; int M, N, K; };

struct StaticOrder {
    int nM, nN, nwg, G, c;
    __host__ __device__ void init(int M, int N, int G_, int c_) { nM = M / BM; nN = N / BM; nwg = nM * nN; G = G_; c = c_; }
    __host__ __device__ bool next(int i, Unit& u) const {
        const long L = (long)i * G + c; if (L >= nwg) return false;
        int wgid = (int)L; { const int q = nwg / NXCD, r = nwg % NXCD, xcd = wgid % NXCD, off = wgid / NXCD; wgid = (xcd < r ? xcd * (q + 1) : r * (q + 1) + (xcd - r) * q) + off; }
        const int nig = WGM * nN, gid = wgid / nig, fm = gid * WGM, gsz = (nM - fm) < WGM ? (nM - fm) : WGM;
        u.pm = fm + ((wgid % nig) % gsz); u.pn = (wgid % nig) / gsz; return true;
    }
    __device__ __forceinline__ void a_ready(const Unit&) const {}
    __device__ __forceinline__ void done(const Unit&) const {}
};


__device__ __forceinline__ unsigned cvt_pk_bf16(float lo, float hi) { unsigned r; asm volatile("v_cvt_pk_bf16_f32 %0, %1, %2" : "=v"(r) : "v"(lo), "v"(hi)); return r; }
template <int ACT> struct EpiBf16 {
    static constexpr bool PERM = true, AFTER_DRAIN = false;
    bf16_t* O; int ldc;
    __device__ __forceinline__ void operator()(const f32x4 (&acc)[2][2][4][2], const Unit& u, int wr, int wc, int fr, int fq) const {
        const int row0 = u.pm * BM + wr * 64 + fr, col0 = u.pn * BM + wc * 32 + 8 * fq;
#pragma unroll
        for (int ai = 0; ai < 2; ++ai)
#pragma unroll
            for (int m = 0; m < 4; ++m) { bf16_t* rowp = O + (size_t)(row0 + ai * HALF + m * 16) * ldc + col0;
#pragma unroll
                for (int bj = 0; bj < 2; ++bj) { f32x4 v0 = acc[ai][bj][m][0], v1 = acc[ai][bj][m][1];
                    if (ACT == 1) {
#pragma unroll
                        for (int j = 0; j < 4; ++j) { const float a = fmaxf(v0[j], 0.f), b = fmaxf(v1[j], 0.f); v0[j] = a * a; v1[j] = b * b; } }
                    u32x4 w; w.x = cvt_pk_bf16(v0[0], v0[1]); w.y = cvt_pk_bf16(v0[2], v0[3]); w.z = cvt_pk_bf16(v1[0], v1[1]); w.w = cvt_pk_bf16(v1[2], v1[3]);
                    *(u32x4*)(rowp + bj * HALF) = w; } }
    }
};
struct EpiResBf16 {
    static constexpr bool PERM = true, AFTER_DRAIN = false;
    bf16_t* C; const bf16_t* R; int ldc; float alpha;
    __device__ __forceinline__ void operator()(const f32x4 (&acc)[2][2][4][2], const Unit& u, int wr, int wc, int fr, int fq) const {
        const int row0 = u.pm * BM + wr * 64 + fr, col0 = u.pn * BM + wc * 32 + 8 * fq;
#pragma unroll
        for (int ai = 0; ai < 2; ++ai)
#pragma unroll
            for (int m = 0; m < 4; ++m) { const size_t off = (size_t)(row0 + ai * HALF + m * 16) * ldc + col0;
#pragma unroll
                for (int bj = 0; bj < 2; ++bj) { const u32x4 rv = *(const u32x4*)(R + off + bj * HALF); const f32x4 v0 = acc[ai][bj][m][0], v1 = acc[ai][bj][m][1];
#define PG8_BL(w) __builtin_bit_cast(float, (w) << 16)
#define PG8_BH(w) __builtin_bit_cast(float, (w) & 0xffff0000u)
                    u32x4 w; w.x = cvt_pk_bf16(PG8_BL(rv.x) * alpha + v0[0], PG8_BH(rv.x) * alpha + v0[1]); w.y = cvt_pk_bf16(PG8_BL(rv.y) * alpha + v0[2], PG8_BH(rv.y) * alpha + v0[3]);
                    w.z = cvt_pk_bf16(PG8_BL(rv.z) * alpha + v1[0], PG8_BH(rv.z) * alpha + v1[1]); w.w = cvt_pk_bf16(PG8_BL(rv.w) * alpha + v1[2], PG8_BH(rv.w) * alpha + v1[3]);
#undef PG8_BL
#undef PG8_BH
                    *(u32x4*)(C + off + bj * HALF) = w; } }
    }
};

template <class Epi, class Sched, bool ALIGN_EPI = false, bool SP2 = false>
__device__ __forceinline__ void gemm_phase(PG8_LAS unsigned char* lds, const Gemm g, const Sched& S, const Epi& E, int wave_) {
    int lane_; asm volatile("v_mbcnt_lo_u32_b32 %0, -1, 0\n\tv_mbcnt_hi_u32_b32 %0, -1, %0" : "=v"(lane_));
    const int wid = wave_, lane = lane_, tid = wid * 64 + lane, wr = wid >> 2, wc = wid & 3, fr = lane & 15, fq = lane >> 4;
    const int K = g.K, nt = K / BK;
    unsigned voffA[2], voffB[2];
#pragma unroll
    for (int i = 0; i < 2; ++i) { int R, C; stage_rc(tid * 16 + i * 8192, R, C); const int Rb = Epi::PERM ? ((R & ~31) + perm32(R & 31)) : R;
        voffA[i] = (unsigned)(R * K + C) * 2u; voffB[i] = (unsigned)(Rb * K + C) * 2u; }
    const size_t kstep = (size_t)(BK * 2);
    const size_t hstep = (size_t)HALF * K * 2;
    const size_t tstep = 2 * hstep;
    const unsigned ldsw = (unsigned)wid * 1024u;
    const int aoff = lds_byte(wr * 64 + fr, fq * 8), boff = lds_byte(wc * 32 + fr, fq * 8);
#define PG8_SA(b, h) (((b) * 2 + (h)) * HTB)
#define PG8_SB(b, h) ((4 + (b) * 2 + (h)) * HTB)
#define PG8_STAGE(bufoff, gbase, voff) do { _Pragma("unroll") for (int _i = 0; _i < 2; ++_i) \
        __builtin_amdgcn_global_load_lds((const unsigned*)((const char*)(gbase) + (voff)[_i]), (PG8_LAS unsigned*)(lds + (bufoff) + ldsw + _i * 8192), 16, 0, 0); } while (0)
#define PG8_LDA(dst, b, h) do { _Pragma("unroll") for (int m = 0; m < 4; ++m) _Pragma("unroll") for (int k = 0; k < 2; ++k) dst[m][k] = *(const PG8_LAS bf16x8*)(lds + PG8_SA(b, h) + aoff + m * 2048 + k * 1024); } while (0)
#define PG8_LDB(dst, b, h) do { _Pragma("unroll") for (int n = 0; n < 2; ++n) _Pragma("unroll") for (int k = 0; k < 2; ++k) dst[n][k] = *(const PG8_LAS bf16x8*)(lds + PG8_SB(b, h) + boff + n * 2048 + k * 1024); } while (0)
#define PG8_MMA(ai, bj, At, Bt) do { __builtin_amdgcn_s_setprio(1); _Pragma("unroll") for (int m = 0; m < 4; ++m) _Pragma("unroll") for (int n = 0; n < 2; ++n) _Pragma("unroll") for (int k = 0; k < 2; ++k) \
        acc[ai][bj][m][n] = __builtin_amdgcn_mfma_f32_16x16x32_bf16(Bt[n][k], At[m][k], acc[ai][bj][m][n], 0, 0, 0); __builtin_amdgcn_s_setprio(0); } while (0)
#define PG8_WAIT_V(n) asm volatile("s_waitcnt vmcnt(" #n ")" ::: "memory")
#define PG8_WAIT_L(n) asm volatile("s_waitcnt lgkmcnt(" #n ")" ::: "memory")
#define PG8_BAR __builtin_amdgcn_s_barrier()
#define PG8_SCHED __builtin_amdgcn_sched_barrier(0)
    Unit cur, nxt; int ui = 0;
    if (!S.next(0, cur)) return;
    f32x4 acc[2][2][4][2];
#pragma unroll
    for (int a = 0; a < 2; ++a)
#pragma unroll
        for (int b = 0; b < 2; ++b)
#pragma unroll
            for (int m = 0; m < 4; ++m)
#pragma unroll
                for (int n = 0; n < 2; ++n) acc[a][b][m][n] = (f32x4){0.f, 0.f, 0.f, 0.f};
    bf16x8 At[4][2], B0[2][2], B1[2][2];
    const char* cA = (const char*)g.A + (size_t)cur.pm * tstep; const char* cB = (const char*)g.Bt + (size_t)cur.pn * tstep;
    S.a_ready(cur);
    if constexpr (SP2) {
        PG8_STAGE(PG8_SB(0, 0), cB, voffB); PG8_STAGE(PG8_SB(0, 1), cB + hstep, voffB); PG8_STAGE(PG8_SA(0, 0), cA, voffA); PG8_STAGE(PG8_SA(0, 1), cA + hstep, voffA);
        if (wr == 1) PG8_BAR;
        PG8_WAIT_V(2); PG8_BAR;
        PG8_STAGE(PG8_SB(1, 0), cB + kstep, voffB); PG8_STAGE(PG8_SA(1, 0), cA + kstep, voffA); PG8_STAGE(PG8_SB(1, 1), cB + hstep + kstep, voffB);
        PG8_WAIT_V(6); PG8_BAR;
    } else {
        PG8_STAGE(PG8_SB(0, 0), cB, voffB); PG8_STAGE(PG8_SA(0, 0), cA, voffA); PG8_STAGE(PG8_SB(0, 1), cB + hstep, voffB); PG8_STAGE(PG8_SA(0, 1), cA + hstep, voffA);
        if (wr == 1) PG8_BAR;
        PG8_WAIT_V(4); PG8_BAR;
        PG8_STAGE(PG8_SB(1, 0), cB + kstep, voffB); PG8_STAGE(PG8_SA(1, 0), cA + kstep, voffA); PG8_STAGE(PG8_SB(1, 1), cB + hstep + kstep, voffB);
        PG8_WAIT_V(6); PG8_BAR;
    }
    for (;;) {
        const bool has_next = S.next(ui + 1, nxt);
        const char* nA = has_next ? (const char*)g.A + (size_t)nxt.pm * tstep : cA; const char* nB = has_next ? (const char*)g.Bt + (size_t)nxt.pn * tstep : cB;
        for (int t = 0; t < nt; t += 2) {
            const bool last = (t == nt - 2);
            const char* a1 = cA + (size_t)(t + 1) * kstep;
            const char* a2 = last ? nA : cA + (size_t)(t + 2) * kstep; const char* b2 = last ? nB : cB + (size_t)(t + 2) * kstep;
            const char* a3 = a2 + kstep; const char* b3 = b2 + kstep;
            if (last && has_next) S.a_ready(nxt);
            if constexpr (SP2) {
            PG8_LDB(B0, 0, 0); PG8_LDB(B1, 0, 1); PG8_SCHED; PG8_LDA(At, 0, 0); PG8_STAGE(PG8_SA(1, 1), a1 + hstep, voffA);
            PG8_WAIT_V(8); PG8_WAIT_L(0); PG8_BAR; PG8_MMA(0, 0, At, B0); PG8_MMA(0, 1, At, B1); PG8_BAR; PG8_SCHED;
            PG8_LDA(At, 0, 1); PG8_STAGE(PG8_SB(0, 0), b2, voffB); PG8_STAGE(PG8_SB(0, 1), b2 + hstep, voffB); PG8_STAGE(PG8_SA(0, 0), a2, voffA);
            PG8_WAIT_V(8); PG8_WAIT_L(0); PG8_BAR; PG8_MMA(1, 0, At, B0); PG8_MMA(1, 1, At, B1); PG8_BAR; PG8_SCHED;
            PG8_LDB(B0, 1, 0); PG8_LDB(B1, 1, 1); PG8_SCHED; PG8_LDA(At, 1, 0); PG8_STAGE(PG8_SA(0, 1), a2 + hstep, voffA);
            PG8_WAIT_V(8); PG8_WAIT_L(0); PG8_BAR; PG8_MMA(0, 0, At, B0); PG8_MMA(0, 1, At, B1); PG8_BAR; PG8_SCHED;
            PG8_LDA(At, 1, 1); PG8_STAGE(PG8_SB(1, 0), b3, voffB); PG8_STAGE(PG8_SB(1, 1), b3 + hstep, voffB); PG8_STAGE(PG8_SA(1, 0), a3, voffA);
            PG8_WAIT_V(8); PG8_WAIT_L(0); PG8_BAR; PG8_MMA(1, 0, At, B0); PG8_MMA(1, 1, At, B1); PG8_BAR; PG8_SCHED;
            } else {
            PG8_LDB(B0, 0, 0); PG8_SCHED; PG8_LDA(At, 0, 0); PG8_STAGE(PG8_SA(1, 1), a1 + hstep, voffA);
            PG8_WAIT_L(8); PG8_BAR; PG8_WAIT_L(0); PG8_MMA(0, 0, At, B0); PG8_BAR; PG8_SCHED;
            PG8_LDB(B1, 0, 1); PG8_STAGE(PG8_SB(0, 0), b2, voffB);
            PG8_BAR; PG8_WAIT_L(0); PG8_MMA(0, 1, At, B1); PG8_BAR;
            PG8_LDA(At, 0, 1); PG8_STAGE(PG8_SA(0, 0), a2, voffA);
            PG8_BAR; PG8_WAIT_L(0); PG8_MMA(1, 0, At, B0); PG8_BAR; PG8_SCHED;
            PG8_STAGE(PG8_SB(0, 1), b2 + hstep, voffB);
            PG8_WAIT_V(6); PG8_BAR; PG8_MMA(1, 1, At, B1); PG8_BAR;
            PG8_LDB(B0, 1, 0); PG8_SCHED; PG8_LDA(At, 1, 0); PG8_STAGE(PG8_SA(0, 1), a2 + hstep, voffA);
            PG8_WAIT_L(8); PG8_BAR; PG8_WAIT_L(0); PG8_MMA(0, 0, At, B0); PG8_BAR; PG8_SCHED;
            PG8_LDB(B1, 1, 1); PG8_STAGE(PG8_SB(1, 0), b3, voffB);
            PG8_BAR; PG8_WAIT_L(0); PG8_MMA(0, 1, At, B1); PG8_BAR;
            PG8_LDA(At, 1, 1); PG8_STAGE(PG8_SA(1, 0), a3, voffA);
            PG8_BAR; PG8_WAIT_L(0); PG8_MMA(1, 0, At, B0); PG8_BAR; PG8_SCHED;
            PG8_STAGE(PG8_SB(1, 1), b3 + hstep, voffB);
            PG8_WAIT_V(6); PG8_BAR; PG8_MMA(1, 1, At, B1); PG8_BAR;
            }
        }
        if constexpr (ALIGN_EPI) { if (wr == 0) PG8_BAR; }
        if constexpr (!Epi::AFTER_DRAIN) { E(acc, cur, wr, wc, fr, fq); S.done(cur); }
        if (!has_next) break;
#pragma unroll
        for (int a = 0; a < 2; ++a)
#pragma unroll
            for (int b = 0; b < 2; ++b)
#pragma unroll
                for (int m = 0; m < 4; ++m)
#pragma unroll
                    for (int n = 0; n < 2; ++n) acc[a][b][m][n] = (f32x4){0.f, 0.f, 0.f, 0.f};
        cur = nxt; cA = nA; cB = nB; ++ui;
        if constexpr (ALIGN_EPI) { if (wr == 1) PG8_BAR; }
    }
    PG8_WAIT_V(0);
    if constexpr (!ALIGN_EPI) { if (wr == 0) PG8_BAR; }
    PG8_BAR;
    if constexpr (Epi::AFTER_DRAIN) { E.fused(acc, cur, wr, wc, fr, fq, lds, wid, lane); S.done(cur); }
#undef PG8_SA
#undef PG8_SB
#undef PG8_STAGE
#undef PG8_LDA
#undef PG8_LDB
#undef PG8_MMA
#undef PG8_WAIT_V
#undef PG8_WAIT_L
#undef PG8_BAR
#undef PG8_SCHED
}
}


#ifndef PG8_SP2
#define PG8_SP2 true
#endif
#ifndef PG8_ALIGN
#define PG8_ALIGN true
#endif
constexpr int NB = 2, T = 4096, DM = 4096, M = NB * T, DEPTH = 2, HD = 128;
constexpr int DIFF_H = 6, MOBA_H = 10, DSA_H = 10, KVL = 512, IDX_H = 32, IDX_D = 64, DFF = 16384, DIN = 12384, DINM = 12288, NTAIL = 96;
constexpr int O_DQ = 0, O_DK = 1536, O_DV = 3072, O_MQ = 4608, O_MK = 5888, O_MV = 7168, O_CQ = 8448, O_CKV = 9728, O_IQ = 10240, O_IK = 12288, O_IW = 12352;
constexpr float ALPHA = 1.4142135623730951f;
constexpr float LN_EPS = 1e-5f, RMS_EPS = 1e-5f, NEG_INF = -1e30f;
constexpr float SCALE = 0.08838834764831845f;
constexpr int NWAVES = 8;

constexpr size_t MiB = 1u << 20;
constexpr size_t WS_CTL = 0, CTL_ZERO_BYTES = 1 * MiB;
constexpr size_t SZ_WIN = 97 * MiB, SZ_WO = 32 * MiB, SZ_WUP = 128 * MiB, SZ_WDN = 128 * MiB, SZ_WL = SZ_WIN + SZ_WO + SZ_WUP + SZ_WDN;
constexpr size_t WS_W = 1 * MiB;
constexpr size_t WS_WUK = WS_W + 2 * SZ_WL;
constexpr size_t WS_WUVT = WS_WUK + 3 * MiB;
constexpr size_t WS_H = WS_WUVT + 3 * MiB;
constexpr size_t WS_XN = WS_H + 128 * MiB;
constexpr size_t WS_PROJ = WS_XN + 64 * MiB;
constexpr size_t WS_TAIL = WS_PROJ + 192 * MiB;
constexpr size_t WS_Y = WS_TAIL + 3 * MiB;
constexpr size_t WS_Z = WS_Y + 64 * MiB;
constexpr size_t WS_HID = WS_Z + 128 * MiB;
constexpr size_t WS_QLAT = WS_HID + 256 * MiB;
constexpr size_t WS_OLAT = WS_QLAT + 80 * MiB;
constexpr size_t WS_DIFFO = WS_OLAT + 80 * MiB;
constexpr size_t WS_CKVN = WS_DIFFO + 48 * MiB;
constexpr size_t WS_KI = WS_CKVN + 8 * MiB;
constexpr size_t WS_WI = WS_KI + 1 * MiB;
constexpr size_t WS_KMEAN = WS_WI + 1 * MiB;
constexpr size_t WS_MMASK = WS_KMEAN + 1 * MiB;
constexpr size_t WS_SEL = WS_MMASK + 1 * MiB;
constexpr size_t WS_END = WS_SEL + 4 * MiB;
static_assert(WS_END <= (size_t)2047 * MiB, "d_ws map must fit 4x the largest tensor (2048 MiB)");
constexpr int CW_TMO = 0, CW_CODE = 1;
constexpr int CW_BAR = 4096;
constexpr int MAX_LAUNCHES = 40;

constexpr int RING_OFF = 0, RING_BYTES = 159744;
constexpr int LDSCTL_OFF = RING_BYTES, MISC_OFF = LDSCTL_OFF + 320;
constexpr int LDS_BYTES = 163840;
static_assert(MISC_OFF + 128 <= LDS_BYTES, "LDS map");

#define GAS __attribute__((address_space(1)))
#define LAS __attribute__((address_space(3)))
typedef unsigned short bf16;
typedef unsigned v4u __attribute__((ext_vector_type(4)));
typedef unsigned v2u __attribute__((ext_vector_type(2)));
typedef float f32x4 __attribute__((ext_vector_type(4)));
typedef float f32x16 __attribute__((ext_vector_type(16)));
typedef short bf16x8 __attribute__((ext_vector_type(8)));
typedef short s16x4 __attribute__((ext_vector_type(4)));
typedef GAS unsigned gu32;
typedef GAS unsigned long long gu64;
#define RLX_AGENT __ATOMIC_RELAXED, __HIP_MEMORY_SCOPE_AGENT
#define LDS_WAIT() asm volatile("s_waitcnt lgkmcnt(0)" ::: "memory")
#define VM_WAIT() asm volatile("s_waitcnt vmcnt(0)" ::: "memory")
__device__ __forceinline__ unsigned f2bf(float f) { unsigned u = __builtin_bit_cast(unsigned, f); return (u + 0x7fffu + ((u >> 16) & 1u)) >> 16; }
__device__ __forceinline__ unsigned pk2(float lo, float hi) { return f2bf(lo) | (f2bf(hi) << 16); }
__device__ __forceinline__ float bf2f(unsigned short b) { return __builtin_bit_cast(float, (unsigned)b << 16); }
__device__ __forceinline__ float bflo(unsigned w) { return __builtin_bit_cast(float, w << 16); }
__device__ __forceinline__ float bfhi(unsigned w) { return __builtin_bit_cast(float, w & 0xffff0000u); }

__device__ __forceinline__ int lane_now() { int l; asm volatile("v_mbcnt_lo_u32_b32 %0, -1, 0\n\tv_mbcnt_hi_u32_b32 %0, -1, %0" : "=v"(l)); return l; }
__constant__ unsigned char c_bucket[128] = {0, 1, 2, 3, 4, 5, 6, 7, 8, 9, 10, 11, 12, 13, 14, 15, 16, 16, 16, 17, 17, 18, 18, 18, 19, 19, 19, 20, 20, 20, 20, 21, 21, 21, 21, 22, 22, 22, 22, 22, 23, 23, 23, 23, 23, 23, 24, 24, 24, 24, 24, 24, 25, 25, 25, 25, 25, 25, 25, 26, 26, 26, 26, 26, 26, 26, 26, 27, 27, 27, 27, 27, 27, 27, 27, 27, 27, 28, 28, 28, 28, 28, 28, 28, 28, 28, 28, 29, 29, 29, 29, 29, 29, 29, 29, 29, 29, 29, 29, 30, 30, 30, 30, 30, 30, 30, 30, 30, 30, 30, 30, 30, 30, 31, 31, 31, 31, 31, 31, 31, 31, 31, 31, 31, 31, 31, 31, 31};
__device__ __forceinline__ int bucket(int dist) { return dist < 0 ? 0 : (dist > 127 ? 31 : (int)c_bucket[dist]); }


#define XB_TMO      128
#define XB_XCNT(j)  (256  + 64 * (j))
#define XB_XSUB(j)  (1280 + 64 * (j))
#define XB_XGEN(j)  (2304 + 64 * (j))
#define XB_TOP      3328
#define XB_TOPGEN   3392
#define XCD_BAR_WORDS 3456
#define XB_SPIN_CAP (1u << 18)

__device__ __forceinline__ unsigned xb_ld(unsigned* p)              { return __hip_atomic_load(p, __ATOMIC_RELAXED, __HIP_MEMORY_SCOPE_AGENT); }
__device__ __forceinline__ unsigned xb_add(unsigned* p, unsigned v) { return __hip_atomic_fetch_add(p, v, __ATOMIC_RELAXED, __HIP_MEMORY_SCOPE_AGENT); }
__device__ __forceinline__ unsigned xb_xcc_id() { return (unsigned)__builtin_amdgcn_s_getreg((3 << 11) | 20) & 0xFu; }
#define XB_SPIN(cond, bar) do { unsigned _sp = 0; while (cond) { __builtin_amdgcn_s_sleep(1); \
    if ((++_sp & 255u) == 0u) { if (xb_ld(&(bar)[XB_TMO])) break; if (_sp > XB_SPIN_CAP) { atomicAdd(&(bar)[XB_TMO], 1u); break; } } } } while (0)

struct XcdBarrier {
    unsigned* bar; unsigned x;
    int wave;
    volatile LAS unsigned* st;
};

__device__ __forceinline__ XcdBarrier xcd_barrier_post(unsigned* bar, volatile LAS unsigned* st, int wave) {
    XcdBarrier b; b.bar = bar; b.x = xb_xcc_id(); b.st = st; b.wave = wave;
    if (wave == 0 && lane_now() == 0) (void)xb_add(&bar[XB_XCNT(b.x)], 1u);
    return b;
}
__device__ __forceinline__ void xcd_barrier_complete(unsigned* bar, unsigned x, unsigned& nloc, unsigned& nx) {
    const unsigned G = gridDim.x * gridDim.y * gridDim.z;
    unsigned sum, cnt, mine, sp = 0u;
    for (;;) {
        sum = 0u; cnt = 0u; mine = 0u;
#pragma unroll
        for (unsigned j = 0; j < 16; ++j) { const unsigned c = xb_ld(&bar[XB_XCNT(j)]); sum += c; cnt += (c > 0u) ? 1u : 0u; mine = (j == x) ? c : mine; }
        if (sum == G) break;
        __builtin_amdgcn_s_sleep(1);
        if ((++sp & 255u) == 0u) { if (xb_ld(&bar[XB_TMO])) break; if (sp > XB_SPIN_CAP) { atomicAdd(&bar[XB_TMO], 1u); break; } }
    }
    nloc = mine > 0u ? mine : 1u; nx = cnt > 0u ? cnt : 1u;
}

__device__ __forceinline__ void xcd_barrier(const XcdBarrier& b) {
    asm volatile("s_waitcnt vmcnt(0)" ::: "memory");
    __syncthreads();
    if (b.wave == 0 && lane_now() == 0) {
        unsigned* bar = b.bar;
        __builtin_amdgcn_s_waitcnt(0);
        unsigned nloc = b.st[0], nx = b.st[1];
        if (nloc == 0u) { xcd_barrier_complete(bar, b.x, nloc, nx); b.st[0] = nloc; b.st[1] = nx; }
        const unsigned old = xb_add(&bar[XB_XSUB(b.x)], 1u);
        const unsigned gen = old / nloc;
        if (old + 1u == (gen + 1u) * nloc) {
            __builtin_amdgcn_fence(__ATOMIC_RELEASE, "agent");
            asm volatile("s_waitcnt vmcnt(0)" ::: "memory");
            const unsigned og = xb_add(&bar[XB_TOP], 1u);
            const unsigned tg = og / nx;
            if (og + 1u == (tg + 1u) * nx) xb_add(&bar[XB_TOPGEN], 1u);
            else XB_SPIN(xb_ld(&bar[XB_TOPGEN]) == tg, bar);
            __builtin_amdgcn_fence(__ATOMIC_ACQUIRE, "agent");
            xb_add(&bar[XB_XGEN(b.x)], 1u);
            asm volatile("s_waitcnt vmcnt(0)" ::: "memory");
        } else {
            XB_SPIN(xb_ld(&bar[XB_XGEN(b.x)]) == gen, bar);
            __builtin_amdgcn_fence(__ATOMIC_ACQUIRE, "agent");
            asm volatile("s_waitcnt vmcnt(0)" ::: "memory");
        }
    }
    __syncthreads();
}


struct Frame {
    LAS unsigned char* lds;
    volatile LAS unsigned* MISC;
    gu32* ctl;
    int wave;
    int vcu, G;
    unsigned char* ws;
};
#define WSL(F) ws_opaque((F).ws)
#define WAVE(F) int_opaque((F).wave)
#define VCU(F) int_opaque((F).vcu)
__device__ __forceinline__ int int_opaque(int v) { asm volatile("" : "+s"(v)); return v; }
__device__ __forceinline__ unsigned char* ws_opaque(unsigned char* p) { asm volatile("" : "+s"(p)); return p; }
typedef const __attribute__((address_space(4))) char* kseg_t;
__device__ __forceinline__ const float* karg(int i) { kseg_t ka = (kseg_t)__builtin_amdgcn_kernarg_segment_ptr(); asm volatile("" : "+s"(ka)); return *(const float* const __attribute__((address_space(4)))*)(ka + 8 * i); }
__device__ __forceinline__ float wave_sum(float v) {
    v += __builtin_bit_cast(float, __builtin_amdgcn_mov_dpp(__builtin_bit_cast(int, v), 0xB1, 0xF, 0xF, true));
    v += __builtin_bit_cast(float, __builtin_amdgcn_mov_dpp(__builtin_bit_cast(int, v), 0x4E, 0xF, 0xF, true));
    v += __builtin_bit_cast(float, __builtin_amdgcn_mov_dpp(__builtin_bit_cast(int, v), 0x141, 0xF, 0xF, true));
    v += __builtin_bit_cast(float, __builtin_amdgcn_mov_dpp(__builtin_bit_cast(int, v), 0x140, 0xF, 0xF, true));
    { auto r = __builtin_amdgcn_permlane16_swap(__float_as_uint(v), __float_as_uint(v), false, false); v = __uint_as_float(r[0]) + __uint_as_float(r[1]); }
    { auto r = __builtin_amdgcn_permlane32_swap(__float_as_uint(v), __float_as_uint(v), false, false); v = __uint_as_float(r[0]) + __uint_as_float(r[1]); }
    return v;
}
__device__ __forceinline__ void p0_transpose_item(const float* W, int K, int N, bf16* WT, int row_off, LAS float* scr, int item, int lane) {
    const int nblk = N / 32, kb = item / nblk, nb = item % nblk, k0 = 64 * kb, n0 = 32 * nb;
    float wv[32];
#pragma unroll
    for (int i = 0; i < 32; ++i) wv[i] = __builtin_nontemporal_load(W + (size_t)(k0 + 2 * i + (lane >> 5)) * N + n0 + (lane & 31));
#pragma unroll
    for (int i = 0; i < 32; ++i) scr[(2 * i + (lane >> 5)) * 33 + (lane & 31)] = wv[i];
    LDS_WAIT(); asm volatile("" ::: "memory");
    const int c = lane & 7;
#pragma unroll
    for (int j = 0; j < 4; ++j) { const int n = (lane >> 3) + 8 * j; const LAS float* s = scr + (8 * c) * 33 + n;
        v4u o; o.x = pk2(s[0 * 33], s[1 * 33]); o.y = pk2(s[2 * 33], s[3 * 33]); o.z = pk2(s[4 * 33], s[5 * 33]); o.w = pk2(s[6 * 33], s[7 * 33]);
        __builtin_nontemporal_store(o, (GAS v4u*)(WT + (size_t)(row_off + n0 + n) * K + k0 + 8 * c)); }
    LDS_WAIT(); asm volatile("" ::: "memory");
}
template <bool IN_BF16>
__device__ __forceinline__ void ln_row(int lane, const void* zrow, const float* g, const float* b, float* hrow, bf16* xrow) {
    f32x4 v[16]; float s = 0.f;
    if (IN_BF16) { const GAS v2u* zr = (const GAS v2u*)zrow + lane;
#pragma unroll
        for (int j = 0; j < 16; ++j) { const v2u w = zr[64 * j]; v[j] = (f32x4){bflo(w.x), bfhi(w.x), bflo(w.y), bfhi(w.y)}; s += (v[j].x + v[j].y) + (v[j].z + v[j].w); } }
    else { const GAS f32x4* zr = (const GAS f32x4*)zrow + lane;
#pragma unroll
        for (int j = 0; j < 16; ++j) { v[j] = zr[64 * j]; s += (v[j].x + v[j].y) + (v[j].z + v[j].w); } }
    const float mean = wave_sum(s) * (1.f / DM); float s2 = 0.f;
#pragma unroll
    for (int j = 0; j < 16; ++j) { v[j] = v[j] - mean; s2 += (v[j].x * v[j].x + v[j].y * v[j].y) + (v[j].z * v[j].z + v[j].w * v[j].w); }
    const float rstd = 1.f / sqrtf(wave_sum(s2) * (1.f / DM) + LN_EPS);
    const GAS f32x4* gr = (const GAS f32x4*)g + lane; const GAS f32x4* br = (const GAS f32x4*)b + lane;
#pragma unroll
    for (int j = 0; j < 16; ++j) { const f32x4 o = v[j] * rstd * gr[64 * j] + br[64 * j];
        if (hrow) ((GAS f32x4*)hrow + lane)[64 * j] = o;
        if (xrow) ((GAS unsigned long long*)xrow + lane)[64 * j] = (unsigned long long)pk2(o.x, o.y) | ((unsigned long long)pk2(o.z, o.w) << 32); }
}
__device__ __forceinline__ bf16* w_layer(Frame& F, int l, int which) {
    const size_t o = WS_W + (size_t)l * SZ_WL + (which == 0 ? 0 : which == 1 ? SZ_WIN : which == 2 ? SZ_WIN + SZ_WO : SZ_WIN + SZ_WO + SZ_WUP);
    return (bf16*)(WSL(F) + o);
}
__device__ __forceinline__ void p0_prologue(Frame& F) {
    const int lane = lane_now();
    const int w_ = WAVE(F); LAS float* scr = (LAS float*)(F.lds + RING_OFF + w_ * 16384);
    const int gw = VCU(F) * NWAVES + w_, NGW = F.G * NWAVES;
    constexpr int I_IN = (DM / 64) * (DIN / 32), I_O = (DM / 64) * (DM / 32), I_UP = (DM / 64) * (DFF / 32), I_DN = (DFF / 64) * (DM / 32), I_UV = (KVL / 64) * (HD / 32) * DSA_H;
    constexpr int PER_L = I_IN + I_O + I_UP + I_DN + I_UV, NITEMS = DEPTH * PER_L;
    for (int it = gw; it < NITEMS; it += NGW) {
        const int l = it / PER_L; int r = it - l * PER_L;
        if (r < I_IN) { p0_transpose_item(karg(4) + (size_t)l * DM * DIN, DM, DIN, w_layer(F, l, 0), 0, scr, r, lane); continue; } r -= I_IN;
        if (r < I_O) { p0_transpose_item(karg(10) + (size_t)l * DM * DM, DM, DM, w_layer(F, l, 1), 0, scr, r, lane); continue; } r -= I_O;
        if (r < I_UP) { p0_transpose_item(karg(13) + (size_t)l * DM * DFF, DM, DFF, w_layer(F, l, 2), 0, scr, r, lane); continue; } r -= I_UP;
        if (r < I_DN) { p0_transpose_item(karg(14) + (size_t)l * DFF * DM, DFF, DM, w_layer(F, l, 3), 0, scr, r, lane); continue; } r -= I_DN;
        { const int h = r / ((KVL / 64) * (HD / 32)), rr = r % ((KVL / 64) * (HD / 32));
          p0_transpose_item(karg(9) + ((size_t)l * DSA_H + h) * KVL * HD, KVL, HD, (bf16*)(WSL(F) + WS_WUVT) + ((size_t)l * DSA_H + h) * HD * KVL, 0, scr, rr, lane); }
    }
    { const GAS f32x4* src = (const GAS f32x4*)karg(8); GAS v2u* dst = (GAS v2u*)(WSL(F) + WS_WUK); const int n4 = DEPTH * DSA_H * KVL * HD / 4;
      for (int i = gw * 64 + lane; i < n4; i += NGW * 64) { const f32x4 v = src[i]; v2u o; o.x = pk2(v.x, v.y); o.y = pk2(v.z, v.w); dst[i] = o; } }
    for (int m = gw; m < M; m += NGW) ln_row<false>(lane, karg(0) + (size_t)m * DM, karg(1), karg(2), nullptr, (bf16*)(WSL(F) + WS_XN) + (size_t)m * DM);
}
__device__ __forceinline__ void tail_phase(Frame& F, const bf16* XN, const bf16* WT, float* TAIL) {
    LAS float* part = (LAS float*)(F.lds + RING_OFF);
    const int lane = lane_now();
    const int w = WAVE(F), fr = lane & 15, fq = lane >> 4;
    for (int unit = VCU(F); unit < M / 32; unit += F.G) {
        const int m0 = unit * 32;
        f32x4 acc[2][6];
#pragma unroll
        for (int i = 0; i < 2; ++i)
#pragma unroll
            for (int j = 0; j < 6; ++j) acc[i][j] = (f32x4){0.f, 0.f, 0.f, 0.f};
        const bf16* ap = XN + (size_t)(m0 + fr) * DM + w * 512 + 8 * fq; const bf16* bp = WT + (size_t)fr * DM + w * 512 + 8 * fq;
#pragma unroll 4
        for (int ks = 0; ks < 16; ++ks) {
            bf16x8 a[2], b[6];
#pragma unroll
            for (int i = 0; i < 2; ++i) a[i] = *(const GAS bf16x8*)(ap + (size_t)i * 16 * DM + ks * 32);
#pragma unroll
            for (int j = 0; j < 6; ++j) b[j] = *(const GAS bf16x8*)(bp + (size_t)j * 16 * DM + ks * 32);
#pragma unroll
            for (int i = 0; i < 2; ++i)
#pragma unroll
                for (int j = 0; j < 6; ++j) acc[i][j] = __builtin_amdgcn_mfma_f32_16x16x32_bf16(a[i], b[j], acc[i][j], 0, 0, 0);
        }
#pragma unroll
        for (int i = 0; i < 2; ++i)
#pragma unroll
            for (int j = 0; j < 6; ++j)
#pragma unroll
                for (int r = 0; r < 4; ++r) part[(w * 32 + i * 16 + fq * 4 + r) * 96 + j * 16 + fr] = acc[i][j][r];
        __syncthreads();
        for (int o = w * 64 + lane; o < 32 * 96; o += NWAVES * 64) { float s = 0.f;
#pragma unroll
            for (int ww = 0; ww < 8; ++ww) s += part[ww * 32 * 96 + o];
            TAIL[(size_t)m0 * 96 + o] = s; }
        __syncthreads();
    }
}
__device__ __forceinline__ void ln_phase(Frame& F, const bf16* Z, const float* g, const float* b, float* Fout, bf16* Xout) {
    const int lane = lane_now();
    const int gw = VCU(F) * NWAVES + WAVE(F), NGW = F.G * NWAVES;
    for (int m = gw; m < M; m += NGW) ln_row<true>(lane, Z + (size_t)m * DM, g, b, Fout ? Fout + (size_t)m * DM : nullptr, Xout ? Xout + (size_t)m * DM : nullptr);
}

__constant__ unsigned short c_attn_sched[256][4] = {{660,132,65535,65535},{661,133,65535,65535},{662,134,65535,65535},{663,135,65535,65535},{664,136,65535,65535},{665,137,65535,65535},{666,138,65535,65535},{667,139,65535,65535},{668,140,65535,65535},{669,141,65535,65535},{670,142,65535,65535},{671,143,65535,65535},{672,144,65535,65535},{673,145,65535,65535},{674,146,65535,65535},{675,147,65535,65535},{676,148,65535,65535},{677,149,65535,65535},{678,150,65535,65535},{679,151,65535,65535},{680,152,65535,65535},{681,153,65535,65535},{682,154,65535,65535},{683,155,65535,65535},{616,196,65535,65535},{617,197,65535,65535},{618,198,65535,65535},{619,199,65535,65535},{620,288,65535,65535},{621,289,65535,65535},{622,290,65535,65535},{623,291,65535,65535},{624,292,65535,65535},{625,293,65535,65535},{626,294,65535,65535},{627,295,65535,65535},{628,296,65535,65535},{629,297,65535,65535},{630,298,65535,65535},{631,299,65535,65535},{632,300,65535,65535},{633,301,65535,65535},{634,302,65535,65535},{635,303,65535,65535},{636,304,65535,65535},{637,305,65535,65535},{638,306,65535,65535},{639,307,65535,65535},{572,348,65535,65535},{573,349,65535,65535},{574,350,65535,65535},{575,351,65535,65535},{576,176,28,65535},{577,177,29,65535},{578,178,30,65535},{579,179,31,65535},{580,180,32,65535},{581,181,33,65535},{582,182,34,65535},{583,183,35,65535},{584,184,36,65535},{585,185,37,65535},{586,186,38,65535},{587,187,39,65535},{588,188,40,65535},{589,189,41,65535},{590,190,42,65535},{591,191,43,65535},{592,192,65535,65535},{593,193,65535,65535},{594,194,65535,65535},{595,195,65535,65535},{528,388,65535,65535},{529,389,65535,65535},{530,390,65535,65535},{531,391,65535,65535},{532,392,65535,65535},{533,393,65535,65535},{534,394,65535,65535},{535,395,65535,65535},{536,332,12,65535},{537,333,13,65535},{538,334,14,65535},{539,335,15,65535},{540,336,16,65535},{541,337,17,65535},{542,338,18,65535},{543,339,19,65535},{544,340,20,65535},{545,341,21,65535},{546,342,22,65535},{547,343,23,65535},{548,344,24,65535},{549,345,25,65535},{550,346,26,65535},{551,347,27,65535},{484,232,128,65535},{485,233,129,65535},{486,234,130,65535},{487,235,131,65535},{488,236,68,65535},{489,237,69,65535},{490,238,70,65535},{491,239,71,65535},{492,240,72,65535},{493,241,73,65535},{494,242,74,65535},{495,243,75,65535},{496,376,76,65535},{497,377,77,65535},{498,378,78,65535},{499,379,79,65535},{500,380,80,65535},{501,381,81,65535},{502,382,82,65535},{503,383,83,65535},{504,384,84,65535},{505,385,85,65535},{506,386,86,65535},{507,387,87,65535},{440,428,48,65535},{441,429,49,65535},{442,430,50,65535},{443,431,51,65535},{444,432,52,65535},{445,433,53,65535},{446,434,54,65535},{447,435,55,65535},{448,436,56,65535},{449,437,57,65535},{450,438,58,65535},{451,439,59,65535},{452,220,244,65535},{453,221,245,65535},{454,222,246,65535},{455,223,247,65535},{456,224,248,65535},{457,225,249,65535},{458,226,250,65535},{459,227,251,65535},{460,228,252,65535},{461,229,253,65535},{462,230,254,65535},{463,231,255,65535},{684,276,60,65535},{685,277,61,65535},{686,278,62,65535},{687,279,63,65535},{688,280,64,65535},{689,281,65,65535},{690,282,66,65535},{691,283,67,65535},{692,284,112,65535},{693,285,113,65535},{694,286,114,65535},{695,287,115,65535},{696,420,216,65535},{697,421,217,65535},{698,422,218,65535},{699,423,219,65535},{700,424,88,65535},{701,425,89,65535},{702,426,90,65535},{703,427,91,65535},{396,516,0,65535},{397,517,1,65535},{398,518,2,65535},{399,519,3,65535},{400,520,4,65535},{401,521,5,65535},{402,522,6,65535},{403,523,7,65535},{404,524,8,65535},{405,525,9,65535},{406,526,10,65535},{407,527,11,65535},{408,464,92,65535},{409,465,93,65535},{410,466,94,65535},{411,467,95,65535},{412,468,96,65535},{413,469,97,65535},{414,470,98,65535},{415,471,99,65535},{416,472,100,65535},{417,473,101,65535},{418,474,102,65535},{419,475,103,65535},{640,476,104,65535},{641,477,105,65535},{642,478,106,65535},{643,479,107,65535},{644,480,108,65535},{645,481,109,65535},{646,482,110,65535},{647,483,111,65535},{648,264,256,65535},{649,265,257,65535},{650,266,258,65535},{651,267,259,65535},{652,268,260,65535},{653,269,261,65535},{654,270,262,65535},{655,271,263,65535},{656,272,200,65535},{657,273,201,65535},{658,274,202,65535},{659,275,203,65535},{596,320,156,65535},{597,321,157,65535},{598,322,158,65535},{599,323,159,65535},{600,324,160,65535},{601,325,161,65535},{602,326,162,65535},{603,327,163,65535},{604,328,164,65535},{605,329,165,65535},{606,330,166,65535},{607,331,167,65535},{608,508,168,65535},{609,509,169,65535},{610,510,170,65535},{611,511,171,65535},{612,512,172,65535},{613,513,173,65535},{614,514,174,65535},{615,515,175,65535},{352,560,116,65535},{353,561,117,65535},{354,562,118,65535},{355,563,119,65535},{356,564,120,65535},{357,565,121,65535},{358,566,122,65535},{359,567,123,65535},{360,568,124,65535},{361,569,125,65535},{362,570,126,65535},{363,571,127,65535},{364,308,204,65535},{365,309,205,65535},{366,310,206,65535},{367,311,207,65535},{368,312,208,65535},{369,313,209,65535},{370,314,210,65535},{371,315,211,65535},{372,316,212,65535},{373,317,213,65535},{374,318,214,65535},{375,319,215,65535},{552,556,44,65535},{553,557,45,65535},{554,558,46,65535},{555,559,47,65535}};


namespace fa {
constexpr int NW = 8, QBLK = 32, KVBLK = 64, QB = NW * QBLK, D = 128;
constexpr int SHM_V = KVBLK * D * 2, SHM_K = KVBLK * D * 2;
constexpr int NSLOT = 3, SLOT = SHM_K + 2 * SHM_V;
constexpr int OFF_RING = 0, OFF_WS = OFF_RING + NSLOT * SLOT, OFF_BT = OFF_WS + NW * 64 * 4, BT_PAD = 96, BT_N = BT_PAD + 256, LDS_BYTES = OFF_BT + BT_N * 4;
constexpr float THR = 8.f;
#define KSWZ(row, colB) ((row) * 256 + ((colB) ^ (((row) & 7) << 4)))
#define SBAR() __builtin_amdgcn_sched_barrier(0)
__device__ __forceinline__ int v_st(int k, int c) { const int kk = (k & ~0xC) | ((k & 4) << 1) | ((k & 8) >> 1); return ((kk >> 3) * 4 + (c >> 5)) * 512 + ((kk & 7) * 32 + (c & 31)) * 2; }
__device__ __forceinline__ int v_rd_base(int lane) { return ((lane & 3) << 3) | (((lane >> 2) & 3) << 6) | (((lane >> 4) & 1) << 5) | (((lane >> 5) & 1) << 8); }
constexpr int v_rd_off(int d0, int ks, int half) { return d0 * 512 + ks * 4096 + half * 2048; }
__device__ __forceinline__ int crow(int r, int hi) { return (r & 3) + 8 * (r >> 2) + 4 * hi; }
__device__ __forceinline__ unsigned cvtpk(float lo, float hi) { unsigned r; asm volatile("v_cvt_pk_bf16_f32 %0, %1, %2" : "=v"(r) : "v"(lo), "v"(hi)); return r; }

__device__ __forceinline__ void bias_mask_tile(f32x16& p0, f32x16& p1, int dq, const LAS float* bt) {
    const float NEG = -__builtin_inff();
    const LAS float* b = bt + BT_PAD + dq - 59;
#pragma unroll
    for (int r = 0; r < 16; ++r) {
        const int c = (r & 3) + 8 * (r >> 2);
        const float v0 = b[59 - c], v1 = b[59 - c - 32];
        p0[r] = (dq - c) >= 0 ? p0[r] + v0 : NEG;
        p1[r] = (dq - c - 32) >= 0 ? p1[r] + v1 : NEG;
    }
}
__device__ __forceinline__ void partialSM(f32x16& p0, f32x16& p1, float& m_reg, float& alpha, float bc) {
    float pmax = p0[0];
#pragma unroll
    for (int r = 1; r < 16; ++r) pmax = fmaxf(pmax, p0[r]);
#pragma unroll
    for (int r = 0; r < 16; ++r) pmax = fmaxf(pmax, p1[r]);
    { auto rr = __builtin_amdgcn_permlane32_swap(__float_as_uint(pmax), __float_as_uint(pmax), false, false);
      pmax = fmaxf(__uint_as_float(rr[0]), __uint_as_float(rr[1])); }
    pmax += bc;
    constexpr float C2 = 1.4426950408889634f * SCALE;
    float mn;
    if (__builtin_expect(__all((pmax - m_reg) * SCALE <= THR), 1)) { mn = m_reg; alpha = 1.f; }
    else { mn = fmaxf(m_reg, pmax); alpha = __builtin_amdgcn_exp2f((m_reg - mn) * C2); m_reg = mn; }
    const float mnL = (bc - mn) * C2;
#pragma unroll
    for (int r = 0; r < 16; ++r) p0[r] = __builtin_amdgcn_exp2f(fmaf(p0[r], C2, mnL));
#pragma unroll
    for (int r = 0; r < 16; ++r) p1[r] = __builtin_amdgcn_exp2f(fmaf(p1[r], C2, mnL));
}
__device__ __forceinline__ void finishSM(f32x16& p0, f32x16& p1, float alpha, float& l_reg, bf16x8& pa0, bf16x8& pa1, bf16x8& pa2, bf16x8& pa3) {
    float ps = 0;
#pragma unroll
    for (int r = 0; r < 16; ++r) ps += p0[r];
#pragma unroll
    for (int r = 0; r < 16; ++r) ps += p1[r];
    { auto rr = __builtin_amdgcn_permlane32_swap(__float_as_uint(ps), __float_as_uint(ps), false, false);
      ps = __uint_as_float(rr[0]) + __uint_as_float(rr[1]); }
    l_reg = l_reg * alpha + ps;
#define PK4(P, B_, OUT) do { unsigned a0 = cvtpk(P[B_+0], P[B_+1]), a1 = cvtpk(P[B_+2], P[B_+3]);                          \
        unsigned b0 = cvtpk(P[B_+4], P[B_+5]), b1 = cvtpk(P[B_+6], P[B_+7]);                                             \
        auto r0 = __builtin_amdgcn_permlane32_swap(a0, b0, false, false); auto r1 = __builtin_amdgcn_permlane32_swap(a1, b1, false, false); \
        v4u w = {r0[0], r1[0], r0[1], r1[1]}; OUT = __builtin_bit_cast(bf16x8, w); } while (0)
    PK4(p0, 0, pa0); PK4(p0, 8, pa1); PK4(p1, 0, pa2); PK4(p1, 8, pa3);
#undef PK4
}
__device__ __forceinline__ void qkt(f32x16& p0, f32x16& p1, const LAS char* Kb, int r32, int hi, const bf16x8* qr) {
    p0 = f32x16{}; p1 = f32x16{};
    const LAS char* kb[4];
#pragma unroll
    for (int dd = 0; dd < 4; ++dd) kb[dd] = Kb + KSWZ(r32, (dd * 16 + hi * 8) * 2);
#pragma unroll
    for (int d0 = 0; d0 < 8; ++d0) { const LAS char* a = kb[d0 & 3] + (d0 >> 2) * 128;
        const bf16x8 b0 = *(const LAS bf16x8*)a;
        const bf16x8 b1 = *(const LAS bf16x8*)(a + 32 * 256);
        p0 = __builtin_amdgcn_mfma_f32_32x32x16_bf16(b0, qr[d0], p0, 0, 0, 0);
        p1 = __builtin_amdgcn_mfma_f32_32x32x16_bf16(b1, qr[d0], p1, 0, 0, 0); }
}
__device__ __forceinline__ void pv_tile(f32x16* o, int vb0, bf16x8 pa0, bf16x8 pa1, bf16x8 pa2, bf16x8 pa3) {
#define TRRD(dst, off) asm volatile("ds_read_b64_tr_b16 %0, %1 offset:%2" : "=&v"(dst) : "v"(vb0), "i"(off) : "memory")
#define PV_D0(d0) do { s16x4 l0, l1, l2, l3, h0, h1, h2, h3; constexpr int b_ = v_rd_off(d0, 0, 0);   \
        TRRD(l0, b_); TRRD(h0, b_ + 2048); TRRD(l1, b_ + 4096); TRRD(h1, b_ + 6144); TRRD(l2, b_ + 8192); TRRD(h2, b_ + 10240); TRRD(l3, b_ + 12288); TRRD(h3, b_ + 14336); \
        asm volatile("s_waitcnt lgkmcnt(0)" ::: "memory"); SBAR();   \
        o[d0] = __builtin_amdgcn_mfma_f32_32x32x16_bf16(pa0, (bf16x8){l0[0], l0[1], l0[2], l0[3], h0[0], h0[1], h0[2], h0[3]}, o[d0], 0, 0, 0);   \
        o[d0] = __builtin_amdgcn_mfma_f32_32x32x16_bf16(pa1, (bf16x8){l1[0], l1[1], l1[2], l1[3], h1[0], h1[1], h1[2], h1[3]}, o[d0], 0, 0, 0);   \
        o[d0] = __builtin_amdgcn_mfma_f32_32x32x16_bf16(pa2, (bf16x8){l2[0], l2[1], l2[2], l2[3], h2[0], h2[1], h2[2], h2[3]}, o[d0], 0, 0, 0);   \
        o[d0] = __builtin_amdgcn_mfma_f32_32x32x16_bf16(pa3, (bf16x8){l3[0], l3[1], l3[2], l3[3], h3[0], h3[1], h3[2], h3[3]}, o[d0], 0, 0, 0); } while (0)
    PV_D0(0); PV_D0(1); PV_D0(2); PV_D0(3);
#undef PV_D0
#undef TRRD
}

template <bool MOBA, int VW>
__device__ __forceinline__ void unit(LAS unsigned char* lds, const bf16* Q, const bf16* K, const bf16* V, bf16* O, int ldq, int ldk, int ldv, int ldo, int P0,
                                     const float* biascol, const unsigned* mmask, int mstride, int wave) {
    const int wid = wave, lane = lane_now(), tid = wid * 64 + lane, r32 = lane & 31, hi = lane >> 5;
    LAS float* wsf = (LAS float*)(lds + OFF_WS) + wid * 64; LAS float* li_l = wsf; LAS float* al_l = wsf + 32;
    LAS float* bt = (LAS float*)(lds + OFF_BT);
    const float bfar = biascol[31 * 32] * (1.f / SCALE);
    const int NT = (P0 + QB) / KVBLK;
    const int qlo = P0 + wid * QBLK, qm = qlo + r32 - 4 * hi;
    const int own = P0 >> 8;
    unsigned mw = 0u; if (MOBA) mw = mmask[(size_t)(qlo + r32) * mstride];
    float m_reg = -1e30f, l_reg = 0.f; f32x16 o[4 * VW] = {};
    const int vrb = v_rd_base(lane);
    bf16x8 qr[8];
#pragma unroll
    for (int d0 = 0; d0 < 8; ++d0) qr[d0] = *(const GAS bf16x8*)(Q + (size_t)(qlo + r32) * ldq + d0 * 16 + hi * 8);
#define FA_ISSUE(t_) do { const int sl_ = (t_) % NSLOT; const bf16* kt_ = K + (size_t)((t_) * KVBLK) * ldk; const bf16* vt_ = V + (size_t)((t_) * KVBLK) * ldv; \
        int ln_ = lane; asm volatile("" : "+v"(ln_));     \
        _Pragma("unroll") for (int jj = 0; jj < 2; ++jj) { const int j_ = 2 * wid + jj, row_ = 4 * j_ + (ln_ >> 4), ks_ = row_ * ldk + (((ln_ & 15) ^ (row_ & 7)) << 3); \
            const int s_ = 2 * j_ + (ln_ >> 5), kk_ = (s_ >> 2) * 8 + ((ln_ & 31) >> 2), c_ = (s_ & 3) * 32 + (ln_ & 3) * 8, key_ = (kk_ & ~0xC) | ((kk_ & 4) << 1) | ((kk_ & 8) >> 1), vs_ = key_ * ldv + c_; \
            __builtin_amdgcn_global_load_lds((const GAS unsigned*)(kt_ + ks_), (LAS unsigned*)(lds + OFF_RING + sl_ * SLOT + (2 * wid + jj) * 1024), 16, 0, 0); \
            _Pragma("unroll") for (int vh_ = 0; vh_ < VW; ++vh_) __builtin_amdgcn_global_load_lds((const GAS unsigned*)(vt_ + vs_ + vh_ * 128), (LAS unsigned*)(lds + OFF_RING + sl_ * SLOT + SHM_K + vh_ * SHM_V + (2 * wid + jj) * 1024), 16, 0, 0); } } while (0)
    __syncthreads();
    for (int i = tid; i < BT_N; i += NW * 64) { const int d = i - BT_PAD; bt[i] = biascol[bucket(d < 0 ? 0 : d) * 32] * (1.f / SCALE); }
    asm volatile("s_waitcnt vmcnt(0) lgkmcnt(0)" ::: "memory");
    FA_ISSUE(0); if (NT > 1) FA_ISSUE(1);
    for (int t = 0; t < NT; ++t) {
        const int kb = t * KVBLK; const LAS unsigned char* slot = lds + OFF_RING + (t % NSLOT) * SLOT;
        if (t + 1 < NT) { if (VW == 2) asm volatile("s_waitcnt vmcnt(6)" ::: "memory"); else asm volatile("s_waitcnt vmcnt(4)" ::: "memory"); } else asm volatile("s_waitcnt vmcnt(0)" ::: "memory");
        __builtin_amdgcn_s_barrier();
        asm volatile("" ::: "memory"); SBAR();
        if (t + 2 < NT) FA_ISSUE(t + 2);
        if (kb <= qlo + QBLK - 1) {
        f32x16 p0, p1; float alpha; bf16x8 pa0, pa1, pa2, pa3;
        qkt(p0, p1, (const LAS char*)slot, r32, hi, qr);
        const bool near = kb + KVBLK - 1 > qlo - 113;
        float bc = near ? 0.f : bfar;
        if (MOBA) { const int n = kb >> 8; if (n < own && !((mw >> n) & 1u)) bc = -__builtin_inff(); }
        if (near) bias_mask_tile(p0, p1, qm - kb, bt);
        partialSM(p0, p1, m_reg, alpha, bc);
        finishSM(p0, p1, alpha, l_reg, pa0, pa1, pa2, pa3);
        if (__any(alpha < 1.f)) { if (hi == 0) al_l[r32] = alpha; asm volatile("s_waitcnt lgkmcnt(0)" ::: "memory");
#pragma unroll
            for (int d_ = 0; d_ < 4 * VW; ++d_)
#pragma unroll
                for (int r = 0; r < 16; ++r) o[d_][r] *= al_l[crow(r, hi)]; }
        SBAR();
        pv_tile(o, (int)(unsigned)(size_t)(slot + SHM_K) + vrb, pa0, pa1, pa2, pa3);
        if (VW == 2) pv_tile(o + 4, (int)(unsigned)(size_t)(slot + SHM_K + SHM_V) + vrb, pa0, pa1, pa2, pa3);
        }
    }
#undef FA_ISSUE
    if (hi == 0) li_l[r32] = l_reg; asm volatile("s_waitcnt lgkmcnt(0)" ::: "memory");
    bf16* Ow = O + (size_t)qlo * ldo;
#pragma unroll
    for (int r = 0; r < 16; ++r) { const int orow = crow(r, hi); const float rl = __builtin_amdgcn_rcpf(li_l[orow]);
#pragma unroll
        for (int d0 = 0; d0 < 4 * VW; ++d0) { const float v = o[d0][r] * rl; const float vn = __shfl_xor(v, 1);
            if ((r32 & 1) == 0) *(GAS unsigned*)(Ow + (size_t)orow * ldo + d0 * 32 + r32) = cvtpk(v, vn); } }
}
#undef KSWZ
#undef SBAR
}


__device__ __forceinline__ float lambda_init_of(int l) { return l == 0 ? 0.2f : 0.35550906759096925f; }

__device__ __forceinline__ void prep_phase(Frame& F, int l) {
    const int lane = lane_now();
    const int wv_ = WAVE(F), gw = VCU(F) * NWAVES + wv_, NGW = F.G * NWAVES;
    const bf16* PROJ = (const bf16*)(WSL(F) + WS_PROJ); const float* TAIL = (const float*)(WSL(F) + WS_TAIL);
    bf16* CKVN = (bf16*)(WSL(F) + WS_CKVN); bf16* KI = (bf16*)(WSL(F) + WS_KI); float* WI = (float*)(WSL(F) + WS_WI); float* KMEAN = (float*)(WSL(F) + WS_KMEAN);
    const float* kvg = karg(7) + (size_t)l * KVL;
    const f32x4 g0 = *(const GAS f32x4*)(kvg + lane * 8), g1 = *(const GAS f32x4*)(kvg + lane * 8 + 4);
    for (int m = gw; m < M; m += NGW) {
        const v4u cw = *(const GAS v4u*)(PROJ + (size_t)m * DINM + O_CKV + lane * 8);
        float c[8] = {bflo(cw.x), bfhi(cw.x), bflo(cw.y), bfhi(cw.y), bflo(cw.z), bfhi(cw.z), bflo(cw.w), bfhi(cw.w)};
        float ss = 0.f;
#pragma unroll
        for (int j = 0; j < 8; ++j) ss += c[j] * c[j];
        const float r = 1.f / sqrtf(wave_sum(ss) * (1.f / KVL) + RMS_EPS);
        v4u o; o.x = pk2(c[0] * r * g0.x, c[1] * r * g0.y); o.y = pk2(c[2] * r * g0.z, c[3] * r * g0.w); o.z = pk2(c[4] * r * g1.x, c[5] * r * g1.y); o.w = pk2(c[6] * r * g1.z, c[7] * r * g1.w);
        *(GAS v4u*)(CKVN + (size_t)m * KVL + lane * 8) = o;
        const float kv = TAIL[(size_t)m * NTAIL + lane];
        const float mean = wave_sum(kv) * (1.f / 64.f); const float d = kv - mean;
        const float var = wave_sum(d * d) * (1.f / 64.f);
        KI[(size_t)m * 64 + lane] = (bf16)f2bf(d / sqrtf(var + LN_EPS));
        if (lane < 32) WI[(size_t)m * 32 + lane] = TAIL[(size_t)m * NTAIL + 64 + lane] * (0.17677669529663687f * 0.125f);
    }
    { LAS float* red = (LAS float*)(F.lds + RING_OFF);
      for (int it = VCU(F); it < NB * MOBA_H * 16; it += F.G) {
        const int n = it & 15, bh = it >> 4, b = bh / MOBA_H, h = bh % MOBA_H;
        const bf16* kp = PROJ + (size_t)(b * T + n * 256 + wv_ * 32) * DINM + O_MK + h * HD + 2 * lane; unsigned wq[32];
#pragma unroll
        for (int j = 0; j < 32; ++j) wq[j] = *(const GAS unsigned*)(kp + (size_t)j * DINM);
        float s0 = 0.f, s1 = 0.f;
#pragma unroll
        for (int j = 0; j < 32; ++j) { s0 += bflo(wq[j]); s1 += bfhi(wq[j]); }
        __syncthreads();
        red[wv_ * 128 + 2 * lane] = s0; red[wv_ * 128 + 2 * lane + 1] = s1;
        __syncthreads();
        if (wv_ == 0) { float a0 = 0.f, a1 = 0.f;
#pragma unroll
            for (int ww = 0; ww < 8; ++ww) { a0 += red[ww * 128 + 2 * lane]; a1 += red[ww * 128 + 2 * lane + 1]; }
            KMEAN[(size_t)it * HD + 2 * lane] = a0 * (1.f / 256.f); KMEAN[(size_t)it * HD + 2 * lane + 1] = a1 * (1.f / 256.f); }
      } }
}
__device__ __forceinline__ float quad_sum(float v) {
    v += __builtin_bit_cast(float, __builtin_amdgcn_mov_dpp(__builtin_bit_cast(int, v), 0xB1, 0xF, 0xF, true));
    v += __builtin_bit_cast(float, __builtin_amdgcn_mov_dpp(__builtin_bit_cast(int, v), 0x4E, 0xF, 0xF, true));
    return v;
}
#ifdef MS_CHECK
__device__ __forceinline__ unsigned ms_ref_mask(float g, int own) {
    float v1 = 0.f, v2 = 0.f, v3 = 0.f; int i1 = -1, i2 = -1, i3 = -1;
#pragma unroll
    for (int nn = 0; nn < 15; ++nn) { const float gg = __builtin_bit_cast(float, __builtin_amdgcn_readlane(__builtin_bit_cast(int, g), 4 * nn));
        if (nn < own) {
            if (i1 < 0 || gg > v1) { v3 = v2; i3 = i2; v2 = v1; i2 = i1; v1 = gg; i1 = nn; }
            else if (i2 < 0 || gg > v2) { v3 = v2; i3 = i2; v2 = gg; i2 = nn; }
            else if (i3 < 0 || gg > v3) { v3 = gg; i3 = nn; } } }
    unsigned mask = 0u; if (i1 >= 0) mask |= 1u << i1; if (i2 >= 0) mask |= 1u << i2; if (i3 >= 0) mask |= 1u << i3;
    return mask;
}
#define MS_CHK(g_, mask_, row_) do { if (ms_ref_mask(g_, own) != ((mask_) ^ MS_CHECK_XOR) && lane == 0) ((unsigned short*)(WSL(F) + WS_XN))[(size_t)(row_) * DM] = 0x7FC0; } while (0)
#else
#define MS_CHK(g_, mask_, row_) do { } while (0)
#endif
__device__ __forceinline__ int quads_max(int v) {
    { const int o = __builtin_amdgcn_mov_dpp(v, 0x141, 0xF, 0xF, true); v = v > o ? v : o; }
    { const int o = __builtin_amdgcn_mov_dpp(v, 0x140, 0xF, 0xF, true); v = v > o ? v : o; }
    { auto r = __builtin_amdgcn_permlane16_swap((unsigned)v, (unsigned)v, false, false); const int a = (int)r[0], c = (int)r[1]; v = a > c ? a : c; }
    { auto r = __builtin_amdgcn_permlane32_swap((unsigned)v, (unsigned)v, false, false); const int a = (int)r[0], c = (int)r[1]; v = a > c ? a : c; }
    return v;
}
__device__ __forceinline__ void moba_select_phase(Frame& F) {
    const int lane = lane_now();
    const int wv_ = WAVE(F), gw = VCU(F) * NWAVES + wv_, NGW = F.G * NWAVES, n = lane >> 2, part = lane & 3;
    const bf16* PROJ = (const bf16*)(WSL(F) + WS_PROJ); const float* KMEAN = (const float*)(WSL(F) + WS_KMEAN); unsigned* MMASK = (unsigned*)(WSL(F) + WS_MMASK);
    for (int m4 = gw; m4 < M / 4; m4 += NGW) {
        const int m0 = m4 * 4, b = m0 / T, own = (m0 % T) >> 8;
        f32x4 kmA[8], kmB[8]; v4u qA[4][4], qB[4][4];
#define MS_LOAD(KM, QQ, h_) do { const float* kp_ = KMEAN + ((size_t)((b * MOBA_H + (h_)) * 16 + n)) * HD + part * 32; \
        _Pragma("unroll") for (int i = 0; i < 8; ++i) KM[i] = n < own ? *(const GAS f32x4*)(kp_ + 4 * i) : (f32x4){0.f, 0.f, 0.f, 0.f}; \
        _Pragma("unroll") for (int tk = 0; tk < 4; ++tk) { const bf16* qp_ = PROJ + (size_t)(m0 + tk) * DINM + O_MQ + (h_) * HD + part * 32; \
            _Pragma("unroll") for (int i = 0; i < 4; ++i) QQ[tk][i] = *(const GAS v4u*)(qp_ + 8 * i); } } while (0)
#define MS_HEAD(KM, QQ, h_) do { _Pragma("unroll") for (int tk = 0; tk < 4; ++tk) { float g = 0.f; \
            _Pragma("unroll") for (int i = 0; i < 4; ++i) { const v4u qw = QQ[tk][i]; \
                g += bflo(qw.x) * KM[2 * i].x + bfhi(qw.x) * KM[2 * i].y + bflo(qw.y) * KM[2 * i].z + bfhi(qw.y) * KM[2 * i].w \
                   + bflo(qw.z) * KM[2 * i + 1].x + bfhi(qw.z) * KM[2 * i + 1].y + bflo(qw.w) * KM[2 * i + 1].z + bfhi(qw.w) * KM[2 * i + 1].w; } \
            g = quad_sum(g); \
              \
            int key_ = __builtin_bit_cast(int, g); key_ ^= (key_ >> 31) & 0x7FFFFFFF; bool live_ = n < own; unsigned mask = 0u; \
            _Pragma("unroll") for (int rd_ = 0; rd_ < 3; ++rd_) { const int mx_ = quads_max(live_ ? key_ : (int)0x80000000); \
                const unsigned long long bal_ = __ballot(live_ && key_ == mx_); \
                if (bal_) { const int sel_ = (int)(__builtin_ctzll(bal_) >> 2); mask |= 1u << sel_; live_ = live_ && n != sel_; } } \
            MS_CHK(g, mask, m0 + tk); \
            if (lane == 0) MMASK[(size_t)(m0 + tk) * MOBA_H + (h_)] = mask; } } while (0)
        MS_LOAD(kmA, qA, 0);
        for (int h = 0; h < MOBA_H; h += 2) {
            MS_LOAD(kmB, qB, h + 1);
            MS_HEAD(kmA, qA, h);
            if (h + 2 < MOBA_H) MS_LOAD(kmA, qA, h + 2);
            MS_HEAD(kmB, qB, h + 1);
        }
#undef MS_LOAD
#undef MS_HEAD
#undef MS_CHK
    }
}
__device__ __forceinline__ void attn_phase(Frame& F) {
    const bf16* PROJ = (const bf16*)(WSL(F) + WS_PROJ); bf16* DIFFO = (bf16*)(WSL(F) + WS_DIFFO); bf16* Y = (bf16*)(WSL(F) + WS_Y);
    const unsigned* MMASK = (const unsigned*)(WSL(F) + WS_MMASK); const float* tab = karg(3);
    constexpr int ND = NB * DIFF_H * 2, PER_QB = ND + NB * MOBA_H, NU = 16 * PER_QB;
    const int vcu_ = VCU(F), wave_ = WAVE(F);
    for (int r = 0;; ++r) {
        int i;
        if (F.G == 256) { if (r >= 4) break; const int id = (int)c_attn_sched[vcu_][r]; if (id == 0xFFFF) break; i = (15 - id / PER_QB) * PER_QB + id % PER_QB; }
        else { i = r * F.G + ((r & 1) ? F.G - 1 - vcu_ : vcu_); if (i >= NU) break; }
        const int qb = 15 - i / PER_QB, j = i % PER_QB, P0 = qb * 256;
        if (j < ND) {
            const int b = j / (DIFF_H * 2), vh = j % (DIFF_H * 2), h = vh >> 1, mp = vh & 1;
            const bf16* base = PROJ + (size_t)(b * T) * DINM;
            fa::unit<false, 2>(F.lds + RING_OFF, base + O_DQ + h * 256 + mp * 128, base + O_DK + h * 256 + mp * 128, base + O_DV + h * 256,
                               DIFFO + (size_t)(b * T) * (DIFF_H * 512) + (h * 2 + mp) * 256, DINM, DINM, DINM, DIFF_H * 512, P0, tab + h * 2 + mp, nullptr, 0, wave_);
        } else {
            const int jj = j - ND, b = jj / MOBA_H, h = jj % MOBA_H;
            const bf16* base = PROJ + (size_t)(b * T) * DINM;
            fa::unit<true, 1>(F.lds + RING_OFF, base + O_MQ + h * HD, base + O_MK + h * HD, base + O_MV + h * HD, Y + (size_t)(b * T) * DM + 1536 + h * HD, DINM, DINM, DINM, DM, P0,
                              tab + 12 + h, MMASK + (size_t)(b * T) * MOBA_H + h, MOBA_H, wave_);
        }
    }
}
__device__ __forceinline__ void post_phase(Frame& F, int l) {
    const int lane = lane_now();
    const int wv_ = WAVE(F), gw = VCU(F) * NWAVES + wv_, NGW = F.G * NWAVES;
    const bf16* DIFFO = (const bf16*)(WSL(F) + WS_DIFFO); bf16* Y = (bf16*)(WSL(F) + WS_Y);
    const float* lv = karg(5) + (size_t)l * 512; const float* sg = karg(6) + (size_t)l * 256;
    const float e1 = wave_sum(lv[lane] * lv[128 + lane] + lv[64 + lane] * lv[192 + lane]), e2 = wave_sum(lv[256 + lane] * lv[384 + lane] + lv[320 + lane] * lv[448 + lane]);
    const float li = lambda_init_of(l), lam = expf(e1) - expf(e2) + li;
    const f32x4 g = *(const GAS f32x4*)(sg + lane * 4);
    for (int it0 = gw * 4; it0 < M * DIFF_H; it0 += NGW * 4) {
        v2u a[4], c[4];
#pragma unroll
        for (int u = 0; u < 4; ++u) { const int it = it0 + u, m = it / DIFF_H, h = it % DIFF_H; const bf16* p = DIFFO + (size_t)m * (DIFF_H * 512) + h * 512 + lane * 4;
            a[u] = *(const GAS v2u*)p; c[u] = *(const GAS v2u*)(p + 256); }
#pragma unroll
        for (int u = 0; u < 4; ++u) { const int it = it0 + u, m = it / DIFF_H, h = it % DIFF_H;
            const float o0 = bflo(a[u].x) - lam * bflo(c[u].x), o1 = bfhi(a[u].x) - lam * bfhi(c[u].x), o2 = bflo(a[u].y) - lam * bflo(c[u].y), o3 = bfhi(a[u].y) - lam * bfhi(c[u].y);
            const float r = 1.f / sqrtf(wave_sum(o0 * o0 + o1 * o1 + o2 * o2 + o3 * o3) * (1.f / 256.f) + RMS_EPS) * (1.f - li);
            v2u o; o.x = pk2(o0 * r * g.x, o1 * r * g.y); o.y = pk2(o2 * r * g.z, o3 * r * g.w);
            *(GAS v2u*)(Y + (size_t)m * DM + h * 256 + lane * 4) = o; }
    }
}


template <int KK, int NCT>
__device__ __forceinline__ void sg_unit(const bf16* A, int lda, const bf16* B, bf16* C, int ldc, int lane) {
    const int fr = lane & 15, fq = lane >> 4;
    f32x4 acc[2][NCT];
#pragma unroll
    for (int i = 0; i < 2; ++i)
#pragma unroll
        for (int j = 0; j < NCT; ++j) acc[i][j] = (f32x4){0.f, 0.f, 0.f, 0.f};
    const bf16* ap = A + (size_t)fr * lda + 8 * fq; const bf16* bp = B + (size_t)fr * KK + 8 * fq;
#pragma unroll 4
    for (int ks = 0; ks < KK / 32; ++ks) {
        bf16x8 a[2], b[NCT];
#pragma unroll
        for (int i = 0; i < 2; ++i) a[i] = *(const GAS bf16x8*)(ap + (size_t)i * 16 * lda + ks * 32);
#pragma unroll
        for (int j = 0; j < NCT; ++j) b[j] = *(const GAS bf16x8*)(bp + (size_t)j * 16 * KK + ks * 32);
#pragma unroll
        for (int i = 0; i < 2; ++i)
#pragma unroll
            for (int j = 0; j < NCT; ++j) acc[i][j] = __builtin_amdgcn_mfma_f32_16x16x32_bf16(b[j], a[i], acc[i][j], 0, 0, 0);
    }
#pragma unroll
    for (int i = 0; i < 2; ++i)
#pragma unroll
        for (int j = 0; j < NCT; ++j) { v2u o; o.x = pk2(acc[i][j][0], acc[i][j][1]); o.y = pk2(acc[i][j][2], acc[i][j][3]);
            *(GAS v2u*)(C + (size_t)(i * 16 + fr) * ldc + j * 16 + 4 * fq) = o; }
}
__device__ __forceinline__ void qlat_phase(Frame& F, int l) {
    const int lane = lane_now();
    const int gw = VCU(F) * NWAVES + WAVE(F), NGW = F.G * NWAVES;
    const bf16* PROJ = (const bf16*)(WSL(F) + WS_PROJ); const bf16* WUK = (const bf16*)(WSL(F) + WS_WUK) + (size_t)l * DSA_H * KVL * HD; bf16* QLAT = (bf16*)(WSL(F) + WS_QLAT);
    for (int wu = gw; wu < (M / 32) * DSA_H * 4; wu += NGW) { const int tt = wu / (DSA_H * 4), rem = wu % (DSA_H * 4), h = rem >> 2, cg = rem & 3;
        sg_unit<HD, 8>(PROJ + (size_t)(tt * 32) * DINM + O_CQ + h * HD, DINM, WUK + ((size_t)h * KVL + cg * 128) * HD, QLAT + (size_t)(tt * 32) * (DSA_H * KVL) + h * KVL + cg * 128, DSA_H * KVL, lane); }
}
__device__ __forceinline__ void dsa_out_phase(Frame& F, int l) {
    const int lane = lane_now();
    const int gw = VCU(F) * NWAVES + WAVE(F), NGW = F.G * NWAVES;
    const bf16* OLAT = (const bf16*)(WSL(F) + WS_OLAT); const bf16* WUVT = (const bf16*)(WSL(F) + WS_WUVT) + (size_t)l * DSA_H * HD * KVL; bf16* Y = (bf16*)(WSL(F) + WS_Y);
    for (int wu = gw; wu < (M / 32) * DSA_H * 2; wu += NGW) { const int tt = wu / (DSA_H * 2), rem = wu % (DSA_H * 2), h = rem >> 1, cg = rem & 1;
        sg_unit<KVL, 4>(OLAT + (size_t)(tt * 32) * (DSA_H * KVL) + h * KVL, DSA_H * KVL, WUVT + ((size_t)h * HD + cg * 64) * KVL, Y + (size_t)(tt * 32) * DM + 2816 + h * HD + cg * 64, DM, lane); }
}

typedef short v4i16_t __attribute__((ext_vector_type(4)));
namespace dsa {
constexpr int G = 4;
constexpr int KT = 256, KSTR = 144;
constexpr int NB1 = 1024;
constexpr int SZ_KI = KT * KSTR, OFF_KI = 0, OFF_SC = 2 * SZ_KI, OFF_HIST = OFF_SC + G * 16384, OFF_SEL = OFF_HIST + G * NB1 * 4, OFF_CNT = OFF_SEL + G * 512  , CNT_W = 64  , LDS_END = OFF_CNT + G * CNT_W * 4;
static_assert(LDS_END <= RING_BYTES, "dsa select LDS map");
__device__ __forceinline__ unsigned fkey(float f) { const unsigned u = __float_as_uint(f); return (u & 0x80000000u) ? ~u : (u | 0x80000000u); }
__device__ __forceinline__ int crow(int r, int hi) { return (r & 3) + 8 * (r >> 2) + 4 * hi; }
}
__device__ __forceinline__ void dsa_select_phase(Frame& F) {
    using namespace dsa;
    const int lane = lane_now(), w = WAVE(F), tid = w * 64 + lane, g = w >> 1, par = w & 1, r32 = lane & 31, hi = lane >> 5;
    LAS unsigned char* L = F.lds + RING_OFF;
    LAS float* sc = (LAS float*)(L + OFF_SC) + g * 4096; LAS unsigned* hist = (LAS unsigned*)(L + OFF_HIST) + g * NB1;
    LAS unsigned* bmp = (LAS unsigned*)(L + OFF_SEL) + g * 128; LAS unsigned* cnt = (LAS unsigned*)(L + OFF_CNT) + g * CNT_W;
    LAS unsigned* cnt_all = (LAS unsigned*)(L + OFF_CNT);
    const bf16* PROJ = (const bf16*)(WSL(F) + WS_PROJ); const bf16* KI = (const bf16*)(WSL(F) + WS_KI); const float* WI = (const float*)(WSL(F) + WS_WI); unsigned short* SEL = (unsigned short*)(WSL(F) + WS_SEL);
    constexpr int NGRP = M / G; const int vcu_ = VCU(F);
    for (int rr = 0;; ++rr) {
        const int i = rr * F.G + ((rr & 1) ? F.G - 1 - vcu_ : vcu_); if (i >= NGRP) break;
        const int b = i & 1, t0 = T - G - G * (i >> 1), t = t0 + g; const size_t row = (size_t)b * T + t;
        if (t0 + G - 1 < 256) {
            if (par == 0) { const unsigned e = lane * 4; v2u o; o.x = e | ((e + 1) << 16); o.y = (e + 2) | ((e + 3) << 16); *(GAS v2u*)(SEL + row * 256 + lane * 4) = o; }
            continue; }
        bf16x8 aq[4]; float wv[16];
#pragma unroll
        for (int ks = 0; ks < 4; ++ks) aq[ks] = *(const GAS bf16x8*)(PROJ + row * DINM + O_IQ + r32 * IDX_D + 16 * ks + 8 * hi);
#pragma unroll
        for (int r = 0; r < 16; ++r) wv[r] = WI[row * IDX_H + crow(r, hi)];
        const int ntile = (t0 + G - 1) / KT + 1;
        const bf16* kib = KI + (size_t)b * T * IDX_D;
        v4u sa0, sa1, sa2, sa3, sb0, sb1, sb2, sb3;
        const int p0k = tid >> 3, p0c = tid & 7;
#define DS_LOAD(R, tl) do { const bf16* s_ = kib + (size_t)((tl) * KT + p0k) * IDX_D + p0c * 8; R##0 = *(const GAS v4u*)s_; R##1 = *(const GAS v4u*)(s_ + 64 * IDX_D); R##2 = *(const GAS v4u*)(s_ + 128 * IDX_D); R##3 = *(const GAS v4u*)(s_ + 192 * IDX_D); } while (0)
#define DS_WRITE(R, bf) do { LAS unsigned char* d_ = L + OFF_KI + (bf) * SZ_KI + p0k * KSTR + p0c * 16; *(LAS v4u*)d_ = R##0; *(LAS v4u*)(d_ + 64 * KSTR) = R##1; *(LAS v4u*)(d_ + 128 * KSTR) = R##2; *(LAS v4u*)(d_ + 192 * KSTR) = R##3; } while (0)
        __syncthreads();
        if (tid < G * CNT_W) cnt_all[tid] = 0u;
        ((LAS unsigned*)(L + OFF_SEL))[tid] = 0u;
        DS_LOAD(sa, 0); if (ntile > 1) DS_LOAD(sb, 1);
        DS_WRITE(sa, 0);
        __syncthreads();
        float smin = 3.0e38f, smax = -3.0e38f;
#define DS_MF(ACC, sb_) do { ACC = (f32x16){}; _Pragma("unroll") for (int ks = 0; ks < 4; ++ks) ACC = __builtin_amdgcn_mfma_f32_32x32x16_bf16(aq[ks], kf[sb_][ks], ACC, 0, 0, 0); } while (0)
#define DS_EP(ACC, sb_, tl) do { const int key = (tl) * KT + (par + 2 * (sb_)) * 32 + r32; float s = 0.f; \
            _Pragma("unroll") for (int r = 0; r < 16; ++r) { const int ai_ = __float_as_int(ACC[r]); s += wv[r] * __int_as_float(ai_ > 0 ? ai_ : 0); }   \
            { auto rr = __builtin_amdgcn_permlane32_swap(__float_as_uint(s), __float_as_uint(s), false, false); s = __uint_as_float(rr[0]) + __uint_as_float(rr[1]); } \
            if (hi == 0 && key <= t) { sc[key] = s; smin = fminf(smin, s); smax = fmaxf(smax, s); } } while (0)
#define DS_STEP(tl, RL, RW) do { const int bufi = (tl) & 1; \
            if ((tl) + 2 < ntile) DS_LOAD(RL, (tl) + 2); \
            { const unsigned kbase = (unsigned)(size_t)(L + OFF_KI + bufi * SZ_KI + (par * 32 + r32) * KSTR + 16 * hi); \
              bf16x8 kf[4][4]; \
              _Pragma("unroll") for (int sb_ = 0; sb_ < 4; ++sb_) \
                  _Pragma("unroll") for (int ks = 0; ks < 4; ++ks) asm volatile("ds_read_b128 %0, %1 offset:%2" : "=v"(kf[sb_][ks]) : "v"(kbase), "i"(sb_ * 64 * KSTR + ks * 32) : "memory"); \
                \
              f32x16 accA, accB; \
              asm volatile("s_waitcnt lgkmcnt(12)" ::: "memory"); __builtin_amdgcn_sched_barrier(0); DS_MF(accA, 0); __builtin_amdgcn_sched_barrier(0); \
              asm volatile("s_waitcnt lgkmcnt(8)" ::: "memory"); __builtin_amdgcn_sched_barrier(0); DS_MF(accB, 1); __builtin_amdgcn_sched_barrier(0); \
              DS_EP(accA, 0, tl); __builtin_amdgcn_sched_barrier(0); \
              asm volatile("s_waitcnt lgkmcnt(4)" ::: "memory"); __builtin_amdgcn_sched_barrier(0); DS_MF(accA, 2); __builtin_amdgcn_sched_barrier(0); \
              DS_EP(accB, 1, tl); __builtin_amdgcn_sched_barrier(0); \
              asm volatile("s_waitcnt lgkmcnt(0)" ::: "memory"); __builtin_amdgcn_sched_barrier(0); DS_MF(accB, 3); __builtin_amdgcn_sched_barrier(0); \
              DS_EP(accA, 2, tl); __builtin_amdgcn_sched_barrier(0); \
              DS_EP(accB, 3, tl); } \
            if ((tl) + 1 < ntile) DS_WRITE(RW, bufi ^ 1); \
            asm volatile("s_waitcnt lgkmcnt(0)" ::: "memory"); __builtin_amdgcn_s_barrier(); asm volatile("" ::: "memory");   } while (0)
        for (int tl = 0; tl < ntile; tl += 2) { DS_STEP(tl, sa, sb); if (tl + 1 < ntile) DS_STEP(tl + 1, sb, sa); }
#undef DS_STEP
#undef DS_MF
#undef DS_EP
#undef DS_LOAD
#undef DS_WRITE
#ifndef REP_SELSTAGE
#define REP_SELSTAGE 1
#endif
        for (int rep_ = 0; rep_ < REP_SELSTAGE; ++rep_) {
        if (rep_) { __syncthreads(); if (tid < G * CNT_W) cnt_all[tid] = 0u; __syncthreads(); }
#pragma unroll
        for (int o = 1; o < 64; o <<= 1) { smin = fminf(smin, __shfl_xor(smin, o)); smax = fmaxf(smax, __shfl_xor(smax, o)); }
        if (lane == 0) { cnt[4 + 2 * par] = __float_as_uint(smin); cnt[5 + 2 * par] = __float_as_uint(smax); }
        for (int e = tid; e < G * NB1; e += NWAVES * 64) ((LAS unsigned*)(L + OFF_HIST))[e] = 0u;
        __syncthreads();
        const float lo = fminf(__uint_as_float(cnt[4]), __uint_as_float(cnt[6])), hi_ = fmaxf(__uint_as_float(cnt[5]), __uint_as_float(cnt[7]));
        const float bscale = hi_ > lo ? ((float)NB1 - 0.5f) / (hi_ - lo) : 0.f;
        const int n = t + 1;
        for (int e0 = par * 64 + lane; e0 < n; e0 += 512) {
            float sv_[4];
#pragma unroll
            for (int u = 0; u < 4; ++u) sv_[u] = sc[(e0 + 128 * u) & 4095];
#pragma unroll
            for (int u = 0; u < 4; ++u) if (e0 + 128 * u < n) { int bin = (int)((sv_[u] - lo) * bscale); bin = bin > NB1 - 1 ? NB1 - 1 : bin;
                __hip_atomic_fetch_add(&hist[bin], 1u, __ATOMIC_RELAXED, __HIP_MEMORY_SCOPE_WORKGROUP); } }
        __syncthreads();
        int B1, need; unsigned hB1;
        { unsigned hh[16]; unsigned tot = 0;
#pragma unroll
          for (int q = 0; q < 4; ++q) { const v4u v = *(const LAS v4u*)&hist[16 * lane + 4 * q]; hh[4 * q] = v.x; hh[4 * q + 1] = v.y; hh[4 * q + 2] = v.z; hh[4 * q + 3] = v.w; tot += v.x + v.y + v.z + v.w; }
          unsigned suf = tot;
#pragma unroll
          for (int o = 1; o < 64; o <<= 1) { const unsigned v = __shfl_down(suf, o); if (lane + o < 64) suf += v; }
          const unsigned long long bal = __ballot(suf >= 256u);
          const int ls = 63 - __builtin_clzll(bal | 1ull);
          unsigned cum = suf - tot; int bb = 0; unsigned cg = 0, hb = 0; bool found = false;
#pragma unroll
          for (int q = 15; q >= 0; --q) { if (!found) { if (cum + hh[q] >= 256u) { bb = q; cg = cum; hb = hh[q]; found = true; } else cum += hh[q]; } }
          B1 = 16 * ls + __shfl(bb, ls); need = 256 - (int)__shfl(cg, ls); hB1 = __shfl(hb, ls); }
        if (lane == 0 && par == 0) { unsigned z_ = 0u; asm volatile("" : "+v"(z_)); cnt[2] = ~z_; cnt[3] = z_; }
        __syncthreads();
        LAS unsigned short* cand = (LAS unsigned short*)(cnt + 8);
        { unsigned kmn = 0xFFFFFFFFu, kmx = 0u;
          for (int e0 = par * 64 + lane; e0 < n; e0 += 512) { float sv_[4];
#pragma unroll
            for (int u = 0; u < 4; ++u) sv_[u] = sc[(e0 + 128 * u) & 4095];
#pragma unroll
            for (int u = 0; u < 4; ++u) { const int e = e0 + 128 * u; if (e < n) { const float s = sv_[u]; int bin = (int)((s - lo) * bscale); bin = bin > NB1 - 1 ? NB1 - 1 : bin;
              if (bin > B1) __hip_atomic_fetch_or(&bmp[e >> 5], 1u << (e & 31), __ATOMIC_RELAXED, __HIP_MEMORY_SCOPE_WORKGROUP);
              else if (bin == B1) { const unsigned pos = __hip_atomic_fetch_add(&cnt[0], 1u, __ATOMIC_RELAXED, __HIP_MEMORY_SCOPE_WORKGROUP); if (pos < 64u) cand[pos] = (unsigned short)e;
                  const unsigned k = fkey(s); kmn = k < kmn ? k : kmn; kmx = k > kmx ? k : kmx; } } } }
          if (hB1 > 64u) {
#pragma unroll
              for (int o = 1; o < 64; o <<= 1) { const unsigned a = __shfl_xor(kmn, o), c2 = __shfl_xor(kmx, o); kmn = a < kmn ? a : kmn; kmx = c2 > kmx ? c2 : kmx; }
              if (lane == 0) { __hip_atomic_fetch_min(&cnt[2], kmn, __ATOMIC_RELAXED, __HIP_MEMORY_SCOPE_WORKGROUP); __hip_atomic_fetch_max(&cnt[3], kmx, __ATOMIC_RELAXED, __HIP_MEMORY_SCOPE_WORKGROUP); } } }
        if (lane == 0 && par == 0) cnt[1] = hB1 > 64u ? 0u : 1u;
        for (int e = tid; e < G * NB1; e += NWAVES * 64) ((LAS unsigned*)(L + OFF_HIST))[e] = 0u;
        __syncthreads();
        if (hB1 <= 64u) {
            if (par == 0) { const int nc = (int)hB1; const int me = lane < nc ? (int)cand[lane] : 0; const unsigned mk = lane < nc ? fkey(sc[me]) : 0u; int rank = 0;
                for (int jn = 0; jn < nc; ++jn) { const int oe = __builtin_amdgcn_readlane(me, jn); const unsigned ok = (unsigned)__builtin_amdgcn_readlane((int)mk, jn); rank += (ok > mk || (ok == mk && oe < me)) ? 1 : 0; }
                if (lane < nc && rank < need) __hip_atomic_fetch_or(&bmp[me >> 5], 1u << (me & 31), __ATOMIC_RELAXED, __HIP_MEMORY_SCOPE_WORKGROUP); } }
        const bool any_fb = (cnt_all[1] + cnt_all[CNT_W + 1] + cnt_all[2 * CNT_W + 1] + cnt_all[3 * CNT_W + 1]) != (unsigned)G;
        if (any_fb) {
        unsigned kmin = cnt[2], kmax = cnt[3];
        bool done = hB1 <= 64u;
        for (int lev = 0; lev < 4; ++lev) {
            const unsigned width = kmax - kmin; const int bits = 32 - __builtin_clz(width | 1u);
            int sh = bits - 8; if (sh < 0) sh = 0;
            if (!done) for (int e = par * 64 + lane; e < n; e += 128) { const unsigned k = fkey(sc[e]); if (k >= kmin && k <= kmax) __hip_atomic_fetch_add(&hist[(k - kmin) >> sh], 1u, __ATOMIC_RELAXED, __HIP_MEMORY_SCOPE_WORKGROUP); }
            __syncthreads();
            unsigned B = 0, cgt = 0, hB = 0;
            if (!done) {
                const unsigned h0 = hist[4 * lane], h1 = hist[4 * lane + 1], h2 = hist[4 * lane + 2], h3 = hist[4 * lane + 3];
                unsigned suf = h0 + h1 + h2 + h3;
#pragma unroll
                for (int o = 1; o < 64; o <<= 1) { const unsigned v = __shfl_down(suf, o); if (lane + o < 64) suf += v; }
                const unsigned long long bal = __ballot(suf >= (unsigned)need);
                const int ls = 63 - __builtin_clzll(bal | 1ull);
                unsigned cum = suf - (h0 + h1 + h2 + h3), bb = 0, cg = 0, hb = 0;
                if (cum + h3 >= (unsigned)need) { bb = 3; cg = cum; hb = h3; }
                else if (cum + h3 + h2 >= (unsigned)need) { bb = 2; cg = cum + h3; hb = h2; }
                else if (cum + h3 + h2 + h1 >= (unsigned)need) { bb = 1; cg = cum + h3 + h2; hb = h1; }
                else { bb = 0; cg = cum + h3 + h2 + h1; hb = h0; }
                B = 4 * ls + __shfl(bb, ls); cgt = __shfl(cg, ls); hB = __shfl(hb, ls);
            }
            __syncthreads();
            if (!done) {
                const bool all_b = (cgt + hB == (unsigned)need);
                const bool ties = !all_b && sh == 0;
                for (int e = par * 64 + lane; e < n; e += 128) { const unsigned k = fkey(sc[e]);
                    if (k >= kmin && k <= kmax) { const unsigned bin = (k - kmin) >> sh;
                        if (bin > B || (all_b && bin == B)) { __hip_atomic_fetch_or(&bmp[e >> 5], 1u << (e & 31), __ATOMIC_RELAXED, __HIP_MEMORY_SCOPE_WORKGROUP); } } }
                if (ties) { if (par == 0) { int left = need - (int)cgt; const unsigned kk = kmin + B;
                        for (int e0 = 0; e0 < n && left > 0; e0 += 64) { const int e = e0 + lane; const bool eq = e < n && fkey(sc[e]) == kk;
                            const unsigned long long bq = __ballot(eq); const int before = __popcll(bq & ((1ull << lane) - 1ull));
                            if (eq && before < left) { __hip_atomic_fetch_or(&bmp[e >> 5], 1u << (e & 31), __ATOMIC_RELAXED, __HIP_MEMORY_SCOPE_WORKGROUP); }
                            left -= __popcll(bq); } }
                    done = true; }
                else if (all_b) done = true;
                else { need -= (int)cgt; const unsigned long long lo2 = (unsigned long long)kmin + ((unsigned long long)B << sh), hi2 = lo2 + ((1ull << sh) - 1ull);
                    kmin = (unsigned)lo2; kmax = hi2 < (unsigned long long)kmax ? (unsigned)hi2 : kmax; }
            }
            if (lane == 0 && par == 0) cnt[1] = done ? 1u : 0u;
            for (int e = tid; e < G * NB1; e += NWAVES * 64) ((LAS unsigned*)(L + OFF_HIST))[e] = 0u;
            __syncthreads();
            if (cnt_all[1] + cnt_all[CNT_W + 1] + cnt_all[2 * CNT_W + 1] + cnt_all[3 * CNT_W + 1] == (unsigned)G) break;
        }
        }
        __syncthreads();
        if (par == 0) {
            unsigned w0 = bmp[2 * lane], w1 = bmp[2 * lane + 1]; const int c = __popc(w0) + __popc(w1); int pre = c;
#pragma unroll
            for (int o = 1; o < 64; o <<= 1) { const int v = __shfl_up(pre, o); if (lane >= o) pre += v; }
            int pos = pre - c; unsigned short* so = SEL + row * 256;
            while (w0) { const int bb = __builtin_ctz(w0); w0 &= w0 - 1u; if (pos < 256) so[pos] = (unsigned short)(lane * 64 + bb); ++pos; }
            while (w1) { const int bb = __builtin_ctz(w1); w1 &= w1 - 1u; if (pos < 256) so[pos] = (unsigned short)(lane * 64 + 32 + bb); ++pos; }
        }
        }
    }
}
#ifndef DA_GRP
#define DA_GRP 2
#endif
#ifndef REP_GATHER
#define REP_GATHER 1
#endif
constexpr int DA_XOFF = 131072, DA_SOFF = DA_XOFF + 8192;
constexpr int DA_BOFF = DA_SOFF + 2048;
static_assert(DA_BOFF + 8192 <= RING_BYTES, "dsa attention LDS map");
__device__ __forceinline__ void dsa_attn_phase(Frame& F, int hot = 0) {
    const int lane = lane_now(), w = WAVE(F), tid = w * 64 + lane, g = w >> 1, half = w & 1, fr = lane & 15, fq = lane >> 4;
    LAS unsigned char* cbuf = F.lds + RING_OFF + g * 32768; LAS unsigned char* xb = F.lds + RING_OFF + DA_XOFF + g * 2048;
    const bf16* CKVN = (const bf16*)(WSL(F) + WS_CKVN); const bf16* QLAT = (const bf16*)(WSL(F) + WS_QLAT); const unsigned short* SEL = (const unsigned short*)(WSL(F) + WS_SEL);
    bf16* OLAT = (bf16*)(WSL(F) + WS_OLAT); const float* tab = karg(3);
    const int hh = fr < DSA_H ? fr : DSA_H - 1;
    constexpr float LOG2E = 1.4426950408889634f;
    const int q4 = (lane >> 2) & 3, p4 = lane & 3, keyl = 4 * fq + q4;
    LAS float* btab = (LAS float*)(F.lds + RING_OFF + DA_BOFF);
    for (int e = tid; e < 128 * 16; e += NWAVES * 64) { const int d = e >> 4, h_ = e & 15; btab[e] = tab[bucket(d) * 32 + 22 + (h_ < DSA_H ? h_ : DSA_H - 1)] * LOG2E; }
    const int vcu_ = VCU(F), per_x = F.G >= 8 ? F.G / 8 : 1, xcd = vcu_ / per_x, jx = vcu_ % per_x, nxb = F.G >= 8 ? 4 : F.G;
    for (int r8 = 0;; ++r8) {
        int b, t0;
        if (F.G >= 8 && F.G % 8 == 0) { const int gi = r8 * (nxb * per_x) + (xcd >> 1) * per_x + jx; if (gi >= T / 4) break; b = xcd & 1; t0 = T - 4 - 4 * gi; }
        else { const int gi = r8 * F.G + vcu_; if (gi >= M / 4) break; b = gi & 1; t0 = T - 4 - 4 * (gi >> 1); }
        const int t = t0 + g, q = b * T + t, nsel = t + 1 < 256 ? t + 1 : 256;
        const int nmax = ((t0 + 4 < 256 ? t0 + 4 : 256) + 15) >> 4;
        bf16x8 ql[8];
#pragma unroll
        for (int ks = 0; ks < 8; ++ks) ql[ks] = __builtin_nontemporal_load((const GAS bf16x8*)(QLAT + (size_t)q * (DSA_H * KVL) + hh * KVL + half * 256 + 32 * ks + 8 * fq));
        f32x4 O[16];
#pragma unroll
        for (int ct = 0; ct < 16; ++ct) O[ct] = (f32x4){0.f, 0.f, 0.f, 0.f};
        float m_run = -1e30f, l_run = 0.f;
        const bf16* cb = CKVN + (size_t)b * T * KVL;
        const LAS unsigned short* srow = (const LAS unsigned short*)(F.lds + RING_OFF + DA_SOFF + g * 512);
        v2u selw; if (half == 0) selw = *(const GAS v2u*)(SEL + (size_t)q * 256 + lane * 4);
#define DA_RD128(dst, addr, off) asm volatile("ds_read_b128 %0, %1 offset:%2" : "=v"(dst) : "v"(addr), "i"(off) : "memory")
#define DA_RDTR(dst, addr, off) asm volatile("ds_read_b64_tr_b16 %0, %1 offset:%2" : "=v"(dst) : "v"(addr), "i"(off) : "memory")
#define DA_ISSUE_K(sv_, bf_, k0_, k1_) do { _Pragma("unroll") for (int k = (k0_); k < (k1_); ++k) { const int slot_ = half * 8 + k; const int idx_ = __builtin_amdgcn_readlane(sv_, slot_); \
        _Pragma("unroll") for (int rg_ = 0; rg_ < REP_GATHER; ++rg_) __builtin_amdgcn_global_load_lds((const GAS unsigned*)(cb + (size_t)idx_ * KVL + ((lane ^ slot_) & 63) * 8), (LAS unsigned*)(cbuf + (bf_) * 16384 + slot_ * 1024), 16, 0, 0); } } while (0)
#define DA_ISSUE(sv_, bf_) DA_ISSUE_K(sv_, bf_, 0, 8)
#define DA_NEXT(k0_) do { __builtin_amdgcn_sched_barrier(0); if (more) DA_ISSUE_K(selv, cur ^ 1, k0_, (k0_) + DA_GRP); __builtin_amdgcn_sched_barrier(0); } while (0)
        __syncthreads();
        if (half == 0) *(LAS v2u*)(F.lds + RING_OFF + DA_SOFF + g * 512 + lane * 8) = selw;
        __syncthreads();
        int selv = fr < nsel ? (int)srow[fr] : 0; if (hot) selv &= 255;
        DA_ISSUE(selv, 0);
        for (int c = 0; c < nmax; ++c) {
            const int cur = c & 1;
            asm volatile("s_waitcnt vmcnt(0)" ::: "memory");
            __builtin_amdgcn_s_barrier();
            asm volatile("" ::: "memory"); __builtin_amdgcn_sched_barrier(0);
            const bool more = c + 1 < nmax;
            if (more) { const int slot = (c + 1) * 16 + fr; selv = slot < nsel ? (int)srow[slot] : 0; if (hot) selv &= 255; }
            DA_NEXT(0);
            const LAS unsigned char* buf = cbuf + cur * 16384;
            f32x4 s4 = (f32x4){0.f, 0.f, 0.f, 0.f};
            { bf16x8 af[8];
#pragma unroll
              for (int i4 = 0; i4 < 4; ++i4) { const unsigned sa = (unsigned)(size_t)(buf + fr * 1024 + half * 512 + (((4 * i4 + fq) ^ fr) << 4));
                  DA_RD128(af[i4], sa, 0); DA_RD128(af[4 + i4], sa, 256); }
              asm volatile("s_waitcnt lgkmcnt(0)" ::: "memory"); __builtin_amdgcn_sched_barrier(0);
#pragma unroll
              for (int ks = 0; ks < 8; ++ks) s4 = __builtin_amdgcn_mfma_f32_16x16x32_bf16(af[ks], ql[ks], s4, 0, 0, 0); }
            DA_NEXT(DA_GRP);
            *(LAS f32x4*)(xb + half * 1024 + lane * 16) = s4;
            asm volatile("s_waitcnt lgkmcnt(0)" ::: "memory");
            __builtin_amdgcn_s_barrier();
            asm volatile("" ::: "memory"); __builtin_amdgcn_sched_barrier(0);
            DA_NEXT(2 * DA_GRP);
            s4 = s4 + *(const LAS f32x4*)(xb + (half ^ 1) * 1024 + lane * 16);
            float sv[4]; float cmax = -__builtin_inff();
#pragma unroll
            for (int r = 0; r < 4; ++r) { const int ks_ = 4 * fq + r; const bool valid = c * 16 + ks_ < nsel; const int idx = valid ? (int)srow[c * 16 + ks_] : 0;
                int dist = t - idx; dist = dist > 127 ? 127 : dist; const float bias = btab[dist * 16 + fr];
                sv[r] = valid ? s4[r] * (SCALE * LOG2E) + bias : -__builtin_inff(); cmax = fmaxf(cmax, sv[r]); }
            { auto r1 = __builtin_amdgcn_permlane16_swap(__float_as_uint(cmax), __float_as_uint(cmax), false, false); cmax = fmaxf(__uint_as_float(r1[0]), __uint_as_float(r1[1]));
              auto r2 = __builtin_amdgcn_permlane32_swap(__float_as_uint(cmax), __float_as_uint(cmax), false, false); cmax = fmaxf(__uint_as_float(r2[0]), __uint_as_float(r2[1])); }
            const bool grow = __any(cmax - m_run > 10.f);
            const float m_new = grow ? fmaxf(m_run, cmax) : m_run, alpha = grow ? __builtin_amdgcn_exp2f(m_run - m_new) : 1.f;
            float p[4], ps = 0.f;
#pragma unroll
            for (int r = 0; r < 4; ++r) { p[r] = __builtin_amdgcn_exp2f(sv[r] - m_new); ps += p[r]; }
            { auto r1 = __builtin_amdgcn_permlane16_swap(__float_as_uint(ps), __float_as_uint(ps), false, false); ps = __uint_as_float(r1[0]) + __uint_as_float(r1[1]);
              auto r2 = __builtin_amdgcn_permlane32_swap(__float_as_uint(ps), __float_as_uint(ps), false, false); ps = __uint_as_float(r2[0]) + __uint_as_float(r2[1]); }
            l_run = l_run * alpha + ps; m_run = m_new;
            if (grow) { float ar[4];
#pragma unroll
                for (int r = 0; r < 4; ++r) ar[r] = __shfl(alpha, 4 * fq + r);
#pragma unroll
                for (int ct = 0; ct < 16; ++ct)
#pragma unroll
                    for (int r = 0; r < 4; ++r) O[ct][r] *= ar[r]; }
            DA_NEXT(3 * DA_GRP);
            v2u pw; pw.x = pk2(p[0], p[1]); pw.y = pk2(p[2], p[3]);
            const s16x4 pa = __builtin_bit_cast(s16x4, pw);
            { const unsigned rb = (unsigned)(size_t)(buf + keyl * 1024 + half * 512 + (p4 & 1) * 8); s16x4 bvv[16];
#pragma unroll
              for (int i8 = 0; i8 < 8; ++i8) { const unsigned ad = rb + (((2 * i8 + (p4 >> 1)) ^ keyl) << 4);
                  DA_RDTR(bvv[i8], ad, 0); DA_RDTR(bvv[8 + i8], ad, 256); }
              asm volatile("s_waitcnt lgkmcnt(0)" ::: "memory"); __builtin_amdgcn_sched_barrier(0);
#pragma unroll
              for (int ct = 0; ct < 16; ++ct) O[ct] = __builtin_amdgcn_mfma_f32_16x16x16bf16_1k(pa, bvv[ct], O[ct], 0, 0, 0); }
        }
#undef DA_ISSUE
#undef DA_ISSUE_K
#undef DA_NEXT
#undef DA_RD128
#undef DA_RDTR
        float rl[4];
#pragma unroll
        for (int r = 0; r < 4; ++r) rl[r] = 1.f / __shfl(l_run, 4 * fq + r);
        { LAS unsigned char* stg = cbuf + (nmax & 1) * 16384 + half * 8192;
          LAS unsigned char* wb = stg + (4 * fq * 256 + fr) * 2;
#pragma unroll
          for (int r = 0; r < 4; ++r) if (4 * fq + r < DSA_H) {
#pragma unroll
              for (int ct = 0; ct < 16; ++ct) *(LAS unsigned short*)(wb + r * 512 + ct * 32) = (unsigned short)f2bf(O[ct][r] * rl[r]); }
          asm volatile("s_waitcnt lgkmcnt(0)" ::: "memory");
#pragma unroll
          for (int i5 = 0; i5 < 5; ++i5) { const int e = i5 * 512 + lane * 8, hd = e >> 8, col = e & 255;
              __builtin_nontemporal_store(*(const LAS v4u*)(stg + i5 * 1024 + lane * 16), (GAS v4u*)(OLAT + (size_t)q * (DSA_H * KVL) + hd * KVL + half * 256 + col)); } }
    }
}


template <class P> __device__ __forceinline__ P* lnd(P* p) { asm volatile("" : "+s"(p)); return p; }
#ifndef DA_HOT
#define DA_HOT 0
#endif
#ifndef REP_FA
#define REP_FA 1
#endif
#ifndef REP_DA
#define REP_DA 1
#endif
#ifndef REP_MS
#define REP_MS 1
#endif
#ifndef REP_TAIL
#define REP_TAIL 1
#endif
#ifndef REP_P0
#define REP_P0 1
#endif
#ifndef REP_PROJ
#define REP_PROJ 1
#endif
#ifndef REP_PREP
#define REP_PREP 1
#endif
#ifndef REP_SEL
#define REP_SEL 1
#endif
#ifndef REP_ATTN
#define REP_ATTN 1
#endif
#ifndef REP_POST
#define REP_POST 1
#endif
#ifndef REP_WO
#define REP_WO 1
#endif
#ifndef REP_LN
#define REP_LN 1
#endif
#ifndef REP_UP
#define REP_UP 1
#endif
#ifndef REP_DN
#define REP_DN 1
#endif
constexpr int PH_PER_LAYER = 10, N_PHASES = 1 + DEPTH * PH_PER_LAYER;
struct Args { const float* in[17]; float* out; unsigned char* ws; int ph_lo, ph_hi, li, pad; };
__global__ void __launch_bounds__(NWAVES * 64, 2) mk_fwd(Args args) {
    extern __shared__ __attribute__((aligned(16))) unsigned char lds[];
    Frame F;
    F.lds = (LAS unsigned char*)lds;
    F.MISC = (volatile LAS unsigned*)(F.lds + MISC_OFF);
    F.wave = __builtin_amdgcn_readfirstlane((int)threadIdx.x >> 6);
    F.G = gridDim.x; { const int bx = blockIdx.x; F.vcu = (F.G % 8 == 0) ? (bx % 8) * (F.G / 8) + bx / 8 : bx; }
    F.ws = args.ws; F.ctl = (gu32*)(args.ws + WS_CTL);
    { for (int u = F.wave * 64 + lane_now(); u < (LDS_BYTES - LDSCTL_OFF) / 4; u += NWAVES * 64) ((LAS unsigned*)(F.lds + LDSCTL_OFF))[u] = 0u; }
    __syncthreads();
    XcdBarrier bar = xcd_barrier_post((unsigned*)(F.ctl + CW_BAR) + args.li * XCD_BAR_WORDS, F.MISC + 8, F.wave);
    const int lo = args.ph_lo, hi = args.ph_hi;
#define IN(k) (lo <= (k) && (k) < hi)
#ifndef REP_BAR
#define REP_BAR 1
#endif
#define SEAM(k) do { if (IN(k) && IN((k) + 1)) { for (int rb_ = 0; rb_ < REP_BAR; ++rb_) xcd_barrier(bar); } } while (0)

#define XN ((bf16*)(WSL(F) + WS_XN))
#define PROJ ((bf16*)(WSL(F) + WS_PROJ))
#define TAIL ((float*)(WSL(F) + WS_TAIL))
#define Y ((bf16*)(WSL(F) + WS_Y))
#define Z ((bf16*)(WSL(F) + WS_Z))
#define HID ((bf16*)(WSL(F) + WS_HID))

    for (int rep_ = 0; rep_ < REP_P0; ++rep_) { if (IN(0)) { p0_prologue(F); }
    SEAM(0); }
    for (int l = 0; l < DEPTH; ++l) {
        const int pb = 1 + l * PH_PER_LAYER;
        for (int rep_ = 0; rep_ < REP_PROJ; ++rep_) { if (IN(pb + 0)) {
            pg8::Gemm g{lnd(XN), lnd(w_layer(F, l, 0)), M, DINM, DM}; pg8::StaticOrder S; S.init(M, DINM, F.G, (int)blockIdx.x);
            pg8::EpiBf16<0> E{lnd(PROJ), DINM};
            pg8::gemm_phase<pg8::EpiBf16<0>, pg8::StaticOrder, PG8_ALIGN, PG8_SP2>(F.lds + RING_OFF, g, S, E, WAVE(F));
            for (int rt_ = 0; rt_ < REP_TAIL; ++rt_) tail_phase(F, lnd(XN), lnd(w_layer(F, l, 0) + (size_t)DINM * DM), lnd(TAIL));
        }
        SEAM(pb + 0); }
        for (int rep_ = 0; rep_ < REP_PREP; ++rep_) { if (IN(pb + 1)) { prep_phase(F, l); qlat_phase(F, l); }
        SEAM(pb + 1); }
        for (int rep_ = 0; rep_ < REP_SEL; ++rep_) { if (IN(pb + 2)) { for (int r2_ = 0; r2_ < REP_MS; ++r2_) moba_select_phase(F); dsa_select_phase(F); }
        SEAM(pb + 2); }
        for (int rep_ = 0; rep_ < REP_ATTN; ++rep_) { if (IN(pb + 3)) { for (int r2_ = 0; r2_ < REP_FA; ++r2_) { attn_phase(F); __syncthreads(); } for (int r2_ = 0; r2_ < REP_DA; ++r2_) { dsa_attn_phase(F, DA_HOT && (r2_ + 1 < REP_DA)); __syncthreads(); } }
        SEAM(pb + 3); }
        for (int rep_ = 0; rep_ < REP_POST; ++rep_) { if (IN(pb + 4)) { post_phase(F, l); dsa_out_phase(F, l); }
        SEAM(pb + 4); }
        for (int rep_ = 0; rep_ < REP_WO; ++rep_) { if (IN(pb + 5)) {
            pg8::Gemm g{lnd(Y), lnd(w_layer(F, l, 1)), M, DM, DM}; pg8::StaticOrder S; S.init(M, DM, F.G, (int)blockIdx.x);
            pg8::EpiResBf16 E{lnd(Z), lnd(XN), DM, ALPHA};
            pg8::gemm_phase<pg8::EpiResBf16, pg8::StaticOrder, PG8_ALIGN, PG8_SP2>(F.lds + RING_OFF, g, S, E, WAVE(F));
        }
        SEAM(pb + 5); }
        for (int rep_ = 0; rep_ < REP_LN; ++rep_) { if (IN(pb + 6)) ln_phase(F, lnd(Z), lnd(karg(11) + (size_t)l * DM), lnd(karg(12) + (size_t)l * DM), nullptr, lnd(XN));
        SEAM(pb + 6); }
        for (int rep_ = 0; rep_ < REP_UP; ++rep_) { if (IN(pb + 7)) {
            pg8::Gemm g{lnd(XN), lnd(w_layer(F, l, 2)), M, DFF, DM}; pg8::StaticOrder S; S.init(M, DFF, F.G, (int)blockIdx.x);
            pg8::EpiBf16<1> E{lnd(HID), DFF};
            pg8::gemm_phase<pg8::EpiBf16<1>, pg8::StaticOrder, PG8_ALIGN, PG8_SP2>(F.lds + RING_OFF, g, S, E, WAVE(F));
        }
        SEAM(pb + 7); }
        for (int rep_ = 0; rep_ < REP_DN; ++rep_) { if (IN(pb + 8)) {
            pg8::Gemm g{lnd(HID), lnd(w_layer(F, l, 3)), M, DM, DFF}; pg8::StaticOrder S; S.init(M, DM, F.G, (int)blockIdx.x);
            pg8::EpiResBf16 E{lnd(Z), lnd(XN), DM, ALPHA};
            pg8::gemm_phase<pg8::EpiResBf16, pg8::StaticOrder, PG8_ALIGN, PG8_SP2>(F.lds + RING_OFF, g, S, E, WAVE(F));
        }
        SEAM(pb + 8); }
        for (int rep_ = 0; rep_ < REP_LN; ++rep_) { if (IN(pb + 9)) { const bool fin = (l == DEPTH - 1); ln_phase(F, lnd(Z), lnd(karg(15) + (size_t)l * DM), lnd(karg(16) + (size_t)l * DM), fin ? lnd((float*)karg(17)) : nullptr, fin ? nullptr : lnd(XN)); }
        SEAM(pb + 9); }
    }
#undef IN
#undef SEAM
#undef XN
#undef PROJ
#undef TAIL
#undef Y
#undef Z
#undef HID
}


extern "C" void kernel_launch(void* const* d_in, const int* in_sizes, int n_in, void* d_out, int out_size, void* d_ws, size_t ws_size, hipStream_t stream) {
    static int grid = 0;
    if (grid == 0) {
        if (n_in != 17 || in_sizes[0] != M * DM || out_size != M * DM || ws_size < WS_END) { fprintf(stderr, "kernel_launch: unexpected shapes / workspace (n_in %d, ws %zu need %zu); nothing launched\n", n_in, ws_size, (size_t)WS_END); grid = -1; return; }
        int dev = 0, cus = 0, per_cu = 0;
        if (hipGetDevice(&dev) != hipSuccess || hipDeviceGetAttribute(&cus, hipDeviceAttributeMultiprocessorCount, dev) != hipSuccess) { grid = -1; return; }
        if (hipFuncSetAttribute((const void*)mk_fwd, hipFuncAttributeMaxDynamicSharedMemorySize, LDS_BYTES) != hipSuccess) { fprintf(stderr, "kernel_launch: hipFuncSetAttribute failed\n"); grid = -1; return; }
        if (hipOccupancyMaxActiveBlocksPerMultiprocessor(&per_cu, (const void*)mk_fwd, NWAVES * 64, LDS_BYTES) != hipSuccess || per_cu < 1)
            fprintf(stderr, "kernel_launch: note: occupancy query reports %d workgroups per CU\n", per_cu);
        (void)hipGetLastError();
        grid = cus;
    }
    if (grid < 0) return;
    (void)hipMemsetAsync((char*)d_ws + WS_CTL, 0, CTL_ZERO_BYTES, stream);
    Args a{};
    for (int i = 0; i < 17; ++i) a.in[i] = (const float*)d_in[i];
    a.out = (float*)d_out; a.ws = (unsigned char*)d_ws; a.ph_lo = 0; a.ph_hi = N_PHASES; a.li = 0; a.pad = 0;
    hipLaunchKernelGGL(mk_fwd, dim3(grid), dim3(NWAVES * 64), LDS_BYTES, stream, a);
    const hipError_t le = hipPeekAtLastError();
    if (le != hipSuccess) fprintf(stderr, "kernel_launch: launch failed: %s\n", hipGetErrorName(le));
}
```

```cpp
#include <hip/hip_runtime.h>
#include <cstdio>
#include <cstdint>
#include <cmath>
namespace pg8 {
#define PG8_LAS __attribute__((address_space(3)))
typedef unsigned short bf16_t;
typedef short bf16x8 __attribute__((ext_vector_type(8)));
typedef float f32x4 __attribute__((ext_vector_type(4)));
typedef unsigned u32x4 __attribute__((ext_vector_type(4)));
constexpr int BM = 256, BK = 64, HALF = 128, HTB = HALF * BK * 2  , STAGE_BYTES = 8 * HTB, NXCD = 8, WGM = 8;

__host__ __device__ __forceinline__ int lds_byte(int r, int c) { const int st = (r >> 4) * 2 + (c >> 5), rr = r & 15, cc = c & 31, ob = rr * 64 + cc * 2; return st * 1024 + (ob ^ (((ob >> 9) & 1) << 5)); }
__host__ __device__ __forceinline__ void stage_rc(int b, int& R, int& C) { const int st = b / 1024, sb = b % 1024, swz = sb ^ (((sb >> 9) & 1) << 5); R = (st >> 1) * 16 + swz / 64; C = (st & 1) * 32 + (swz % 64) / 2; }
__host__ __device__ __forceinline__ int perm32(int rho) { const int n = rho >> 4, i = rho & 15; return 8 * (i >> 2) + 4 * n + (i & 3); }

struct Unit { int pm, pn; };
struct Gemm { const bf16_t* A; const bf16_t* Bt; int M, N, K; int lda; };

struct StaticOrder {
    int nM, nN, nwg, G, c;
    __host__ __device__ void init(int M, int N, int G_, int c_) { nM = M / BM; nN = N / BM; nwg = nM * nN; G = G_; c = c_; }
    __host__ __device__ bool next(int i, Unit& u) const {
        const long L = (long)i * G + c; if (L >= nwg) return false;
        int wgid = (int)L; { const int q = nwg / NXCD, r = nwg % NXCD, xcd = wgid % NXCD, off = wgid / NXCD; wgid = (xcd < r ? xcd * (q + 1) : r * (q + 1) + (xcd - r) * q) + off; }
        const int nig = WGM * nN, gid = wgid / nig, fm = gid * WGM, gsz = (nM - fm) < WGM ? (nM - fm) : WGM;
        u.pm = fm + ((wgid % nig) % gsz); u.pn = (wgid % nig) / gsz; return true;
    }
    __device__ __forceinline__ int acol(const Unit&) const { return 0; }
    __device__ __forceinline__ void a_ready(const Unit&) const {}
    __device__ __forceinline__ void done(const Unit&) const {}
};


__device__ __forceinline__ unsigned cvt_pk_bf16(float lo, float hi) { unsigned r; asm volatile("v_cvt_pk_bf16_f32 %0, %1, %2" : "=v"(r) : "v"(lo), "v"(hi)); return r; }
template <int ACT> struct EpiBf16 {
    static constexpr bool PERM = true, AFTER_DRAIN = false;
    bf16_t* O; int ldc;
    __device__ __forceinline__ void operator()(const f32x4 (&acc)[2][2][4][2], const Unit& u, int wr, int wc, int fr, int fq) const {
        const int row0 = u.pm * BM + wr * 64 + fr, col0 = u.pn * BM + wc * 32 + 8 * fq;
#pragma unroll
        for (int ai = 0; ai < 2; ++ai)
#pragma unroll
            for (int m = 0; m < 4; ++m) { bf16_t* rowp = O + (size_t)(row0 + ai * HALF + m * 16) * ldc + col0;
#pragma unroll
                for (int bj = 0; bj < 2; ++bj) { f32x4 v0 = acc[ai][bj][m][0], v1 = acc[ai][bj][m][1];
                    if (ACT == 1) {
#pragma unroll
                        for (int j = 0; j < 4; ++j) { const float a = fmaxf(v0[j], 0.f), b = fmaxf(v1[j], 0.f); v0[j] = a * a; v1[j] = b * b; } }
                    u32x4 w; w.x = cvt_pk_bf16(v0[0], v0[1]); w.y = cvt_pk_bf16(v0[2], v0[3]); w.z = cvt_pk_bf16(v1[0], v1[1]); w.w = cvt_pk_bf16(v1[2], v1[3]);
                    *(u32x4*)(rowp + bj * HALF) = w; } }
    }
};
struct EpiBf16Late {
    static constexpr bool PERM = true, AFTER_DRAIN = false;
    bf16_t* O; int ldc;
    __device__ __forceinline__ void operator()(const f32x4 (&acc)[2][2][4][2], const Unit& u, int wr, int wc, int, int) const {
        int l_; asm volatile("v_mbcnt_lo_u32_b32 %0, -1, 0\n\tv_mbcnt_hi_u32_b32 %0, -1, %0" : "=v"(l_));
        const int fr = l_ & 15, fq = l_ >> 4;
        const int row0 = u.pm * BM + wr * 64 + fr, col0 = u.pn * BM + wc * 32 + 8 * fq;
#pragma unroll
        for (int ai = 0; ai < 2; ++ai)
#pragma unroll
            for (int m = 0; m < 4; ++m) { bf16_t* rowp = O + (size_t)(row0 + ai * HALF + m * 16) * ldc + col0;
#pragma unroll
                for (int bj = 0; bj < 2; ++bj) { const f32x4 v0 = acc[ai][bj][m][0], v1 = acc[ai][bj][m][1];
                    u32x4 w; w.x = cvt_pk_bf16(v0[0], v0[1]); w.y = cvt_pk_bf16(v0[2], v0[3]); w.z = cvt_pk_bf16(v1[0], v1[1]); w.w = cvt_pk_bf16(v1[2], v1[3]);
                    *(u32x4*)(rowp + bj * HALF) = w; } }
    }
};
struct EpiResBf16 {
    static constexpr bool PERM = true, AFTER_DRAIN = false;
    bf16_t* C; const bf16_t* R; int ldc; float alpha;
    __device__ __forceinline__ void operator()(const f32x4 (&acc)[2][2][4][2], const Unit& u, int wr, int wc, int fr, int fq) const {
        const int row0 = u.pm * BM + wr * 64 + fr, col0 = u.pn * BM + wc * 32 + 8 * fq;
#pragma unroll
        for (int ai = 0; ai < 2; ++ai)
#pragma unroll
            for (int m = 0; m < 4; ++m) { const size_t off = (size_t)(row0 + ai * HALF + m * 16) * ldc + col0;
#pragma unroll
                for (int bj = 0; bj < 2; ++bj) { const u32x4 rv = *(const u32x4*)(R + off + bj * HALF); const f32x4 v0 = acc[ai][bj][m][0], v1 = acc[ai][bj][m][1];
#define PG8_BL(w) __builtin_bit_cast(float, (w) << 16)
#define PG8_BH(w) __builtin_bit_cast(float, (w) & 0xffff0000u)
                    u32x4 w; w.x = cvt_pk_bf16(PG8_BL(rv.x) * alpha + v0[0], PG8_BH(rv.x) * alpha + v0[1]); w.y = cvt_pk_bf16(PG8_BL(rv.y) * alpha + v0[2], PG8_BH(rv.y) * alpha + v0[3]);
                    w.z = cvt_pk_bf16(PG8_BL(rv.z) * alpha + v1[0], PG8_BH(rv.z) * alpha + v1[1]); w.w = cvt_pk_bf16(PG8_BL(rv.w) * alpha + v1[2], PG8_BH(rv.w) * alpha + v1[3]);
#undef PG8_BL
#undef PG8_BH
                    *(u32x4*)(C + off + bj * HALF) = w; } }
    }
};

template <class Epi, class Sched, bool ALIGN_EPI = false, bool SP2 = false, bool GEN = false>
__device__ __forceinline__ void gemm_phase(PG8_LAS unsigned char* lds, const Gemm g, const Sched& S, const Epi& E, int wave_) {
    int lane_; asm volatile("v_mbcnt_lo_u32_b32 %0, -1, 0\n\tv_mbcnt_hi_u32_b32 %0, -1, %0" : "=v"(lane_));
    const int wid = wave_, lane = lane_, tid = wid * 64 + lane, wr = wid >> 2, wc = wid & 3, fr = lane & 15, fq = lane >> 4;
    const int K = g.K, nt = K / BK, lda = GEN ? g.lda : K;
    unsigned voffA[2], voffB[2];
#pragma unroll
    for (int i = 0; i < 2; ++i) { int R, C; stage_rc(tid * 16 + i * 8192, R, C); const int Rb = Epi::PERM ? ((R & ~31) + perm32(R & 31)) : R;
        voffA[i] = (unsigned)(R * lda + C) * 2u; voffB[i] = (unsigned)(Rb * K + C) * 2u; }
    const size_t kstep = (size_t)(BK * 2);
    const size_t hstepB = (size_t)HALF * K * 2, hstepA = (size_t)HALF * lda * 2;
    const size_t tstepB = 2 * hstepB, tstepA = 2 * hstepA;
    const unsigned ldsw = (unsigned)wid * 1024u;
    const int aoff = lds_byte(wr * 64 + fr, fq * 8), boff = lds_byte(wc * 32 + fr, fq * 8);
#define PG8_SA(b, h) (((b) * 2 + (h)) * HTB)
#define PG8_SB(b, h) ((4 + (b) * 2 + (h)) * HTB)
#define PG8_STAGE(bufoff, gbase, voff) do { _Pragma("unroll") for (int _i = 0; _i < 2; ++_i) \
        __builtin_amdgcn_global_load_lds((const unsigned*)((const char*)(gbase) + (voff)[_i]), (PG8_LAS unsigned*)(lds + (bufoff) + ldsw + _i * 8192), 16, 0, 0); } while (0)
#define PG8_LDA(dst, b, h) do { _Pragma("unroll") for (int m = 0; m < 4; ++m) _Pragma("unroll") for (int k = 0; k < 2; ++k) dst[m][k] = *(const PG8_LAS bf16x8*)(lds + PG8_SA(b, h) + aoff + m * 2048 + k * 1024); } while (0)
#define PG8_LDB(dst, b, h) do { _Pragma("unroll") for (int n = 0; n < 2; ++n) _Pragma("unroll") for (int k = 0; k < 2; ++k) dst[n][k] = *(const PG8_LAS bf16x8*)(lds + PG8_SB(b, h) + boff + n * 2048 + k * 1024); } while (0)
#define PG8_MMA(ai, bj, At, Bt) do { __builtin_amdgcn_s_setprio(1); _Pragma("unroll") for (int m = 0; m < 4; ++m) _Pragma("unroll") for (int n = 0; n < 2; ++n) _Pragma("unroll") for (int k = 0; k < 2; ++k) \
        acc[ai][bj][m][n] = __builtin_amdgcn_mfma_f32_16x16x32_bf16(Bt[n][k], At[m][k], acc[ai][bj][m][n], 0, 0, 0); __builtin_amdgcn_s_setprio(0); } while (0)
#define PG8_WAIT_V(n) asm volatile("s_waitcnt vmcnt(" #n ")" ::: "memory")
#define PG8_WAIT_L(n) asm volatile("s_waitcnt lgkmcnt(" #n ")" ::: "memory")
#define PG8_BAR __builtin_amdgcn_s_barrier()
#define PG8_SCHED __builtin_amdgcn_sched_barrier(0)
    Unit cur, nxt; int ui = 0;
    if (!S.next(0, cur)) return;
    f32x4 acc[2][2][4][2];
#pragma unroll
    for (int a = 0; a < 2; ++a)
#pragma unroll
        for (int b = 0; b < 2; ++b)
#pragma unroll
            for (int m = 0; m < 4; ++m)
#pragma unroll
                for (int n = 0; n < 2; ++n) acc[a][b][m][n] = (f32x4){0.f, 0.f, 0.f, 0.f};
    bf16x8 At[4][2], B0[2][2], B1[2][2];
    const char* cA = (const char*)g.A + (size_t)cur.pm * tstepA + (GEN ? S.acol(cur) * 2 : 0); const char* cB = (const char*)g.Bt + (size_t)cur.pn * tstepB;
    S.a_ready(cur);
    if constexpr (SP2) {
        PG8_STAGE(PG8_SB(0, 0), cB, voffB); PG8_STAGE(PG8_SB(0, 1), cB + hstepB, voffB); PG8_STAGE(PG8_SA(0, 0), cA, voffA); PG8_STAGE(PG8_SA(0, 1), cA + hstepA, voffA);
        if (wr == 1) PG8_BAR;
        PG8_WAIT_V(2); PG8_BAR;
        PG8_STAGE(PG8_SB(1, 0), cB + kstep, voffB); PG8_STAGE(PG8_SA(1, 0), cA + kstep, voffA); PG8_STAGE(PG8_SB(1, 1), cB + hstepB + kstep, voffB);
        PG8_WAIT_V(6); PG8_BAR;
    } else {
        PG8_STAGE(PG8_SB(0, 0), cB, voffB); PG8_STAGE(PG8_SA(0, 0), cA, voffA); PG8_STAGE(PG8_SB(0, 1), cB + hstepB, voffB); PG8_STAGE(PG8_SA(0, 1), cA + hstepA, voffA);
        if (wr == 1) PG8_BAR;
        PG8_WAIT_V(4); PG8_BAR;
        PG8_STAGE(PG8_SB(1, 0), cB + kstep, voffB); PG8_STAGE(PG8_SA(1, 0), cA + kstep, voffA); PG8_STAGE(PG8_SB(1, 1), cB + hstepB + kstep, voffB);
        PG8_WAIT_V(6); PG8_BAR;
    }
    for (;;) {
        const bool has_next = S.next(ui + 1, nxt);
        const char* nA = has_next ? (const char*)g.A + (size_t)nxt.pm * tstepA + (GEN ? S.acol(nxt) * 2 : 0) : cA; const char* nB = has_next ? (const char*)g.Bt + (size_t)nxt.pn * tstepB : cB;
        for (int t = 0; t < nt; t += 2) {
            const bool last = (t == nt - 2);
            const char* a1 = cA + (size_t)(t + 1) * kstep;
            const char* a2 = last ? nA : cA + (size_t)(t + 2) * kstep; const char* b2 = last ? nB : cB + (size_t)(t + 2) * kstep;
            const char* a3 = a2 + kstep; const char* b3 = b2 + kstep;
            if (last && has_next) S.a_ready(nxt);
            if constexpr (SP2) {
            PG8_LDB(B0, 0, 0); PG8_LDB(B1, 0, 1); PG8_SCHED; PG8_LDA(At, 0, 0); PG8_STAGE(PG8_SA(1, 1), a1 + hstepA, voffA);
            PG8_WAIT_V(8); PG8_WAIT_L(0); PG8_BAR; PG8_MMA(0, 0, At, B0); PG8_MMA(0, 1, At, B1); PG8_BAR; PG8_SCHED;
            PG8_LDA(At, 0, 1); PG8_STAGE(PG8_SB(0, 0), b2, voffB); PG8_STAGE(PG8_SB(0, 1), b2 + hstepB, voffB); PG8_STAGE(PG8_SA(0, 0), a2, voffA);
            PG8_WAIT_V(8); PG8_WAIT_L(0); PG8_BAR; PG8_MMA(1, 0, At, B0); PG8_MMA(1, 1, At, B1); PG8_BAR; PG8_SCHED;
            PG8_LDB(B0, 1, 0); PG8_LDB(B1, 1, 1); PG8_SCHED; PG8_LDA(At, 1, 0); PG8_STAGE(PG8_SA(0, 1), a2 + hstepA, voffA);
            PG8_WAIT_V(8); PG8_WAIT_L(0); PG8_BAR; PG8_MMA(0, 0, At, B0); PG8_MMA(0, 1, At, B1); PG8_BAR; PG8_SCHED;
            PG8_LDA(At, 1, 1); PG8_STAGE(PG8_SB(1, 0), b3, voffB); PG8_STAGE(PG8_SB(1, 1), b3 + hstepB, voffB); PG8_STAGE(PG8_SA(1, 0), a3, voffA);
            PG8_WAIT_V(8); PG8_WAIT_L(0); PG8_BAR; PG8_MMA(1, 0, At, B0); PG8_MMA(1, 1, At, B1); PG8_BAR; PG8_SCHED;
            } else {
            PG8_LDB(B0, 0, 0); PG8_SCHED; PG8_LDA(At, 0, 0); PG8_STAGE(PG8_SA(1, 1), a1 + hstepA, voffA);
            PG8_WAIT_L(8); PG8_BAR; PG8_WAIT_L(0); PG8_MMA(0, 0, At, B0); PG8_BAR; PG8_SCHED;
            PG8_LDB(B1, 0, 1); PG8_STAGE(PG8_SB(0, 0), b2, voffB);
            PG8_BAR; PG8_WAIT_L(0); PG8_MMA(0, 1, At, B1); PG8_BAR;
            PG8_LDA(At, 0, 1); PG8_STAGE(PG8_SA(0, 0), a2, voffA);
            PG8_BAR; PG8_WAIT_L(0); PG8_MMA(1, 0, At, B0); PG8_BAR; PG8_SCHED;
            PG8_STAGE(PG8_SB(0, 1), b2 + hstepB, voffB);
            PG8_WAIT_V(6); PG8_BAR; PG8_MMA(1, 1, At, B1); PG8_BAR;
            PG8_LDB(B0, 1, 0); PG8_SCHED; PG8_LDA(At, 1, 0); PG8_STAGE(PG8_SA(0, 1), a2 + hstepA, voffA);
            PG8_WAIT_L(8); PG8_BAR; PG8_WAIT_L(0); PG8_MMA(0, 0, At, B0); PG8_BAR; PG8_SCHED;
            PG8_LDB(B1, 1, 1); PG8_STAGE(PG8_SB(1, 0), b3, voffB);
            PG8_BAR; PG8_WAIT_L(0); PG8_MMA(0, 1, At, B1); PG8_BAR;
            PG8_LDA(At, 1, 1); PG8_STAGE(PG8_SA(1, 0), a3, voffA);
            PG8_BAR; PG8_WAIT_L(0); PG8_MMA(1, 0, At, B0); PG8_BAR; PG8_SCHED;
            PG8_STAGE(PG8_SB(1, 1), b3 + hstepB, voffB);
            PG8_WAIT_V(6); PG8_BAR; PG8_MMA(1, 1, At, B1); PG8_BAR;
            }
        }
        if constexpr (ALIGN_EPI) { if (wr == 0) PG8_BAR; }
        if constexpr (!Epi::AFTER_DRAIN) { E(acc, cur, wr, wc, fr, fq); S.done(cur); }
        if (!has_next) break;
#pragma unroll
        for (int a = 0; a < 2; ++a)
#pragma unroll
            for (int b = 0; b < 2; ++b)
#pragma unroll
                for (int m = 0; m < 4; ++m)
#pragma unroll
                    for (int n = 0; n < 2; ++n) acc[a][b][m][n] = (f32x4){0.f, 0.f, 0.f, 0.f};
        cur = nxt; cA = nA; cB = nB; ++ui;
        if constexpr (ALIGN_EPI) { if (wr == 1) PG8_BAR; }
    }
    PG8_WAIT_V(0);
    if constexpr (!ALIGN_EPI) { if (wr == 0) PG8_BAR; }
    PG8_BAR;
    if constexpr (Epi::AFTER_DRAIN) { E.fused(acc, cur, wr, wc, fr, fq, lds, wid, lane); S.done(cur); }
#undef PG8_SA
#undef PG8_SB
#undef PG8_STAGE
#undef PG8_LDA
#undef PG8_LDB
#undef PG8_MMA
#undef PG8_WAIT_V
#undef PG8_WAIT_L
#undef PG8_BAR
#undef PG8_SCHED
}
}


#ifndef PG8_SP2
#define PG8_SP2 true
#endif
#ifndef PG8_ALIGN
#define PG8_ALIGN true
#endif
constexpr int NB = 2, T = 4096, DM = 4096, M = NB * T, DEPTH = 2, HD = 128;
constexpr int DIFF_H = 6, MOBA_H = 10, DSA_H = 10, KVL = 512, IDX_H = 32, IDX_D = 64, DFF = 16384, DIN = 12384, DINM = 12288, NTAIL = 96;
constexpr int O_DQ = 0, O_DK = 1536, O_DV = 3072, O_MQ = 4608, O_MK = 5888, O_MV = 7168, O_CQ = 8448, O_CKV = 9728, O_IQ = 10240, O_IK = 12288, O_IW = 12352;
constexpr float ALPHA = 1.4142135623730951f;
constexpr float LN_EPS = 1e-5f, RMS_EPS = 1e-5f, NEG_INF = -1e30f;
constexpr float SCALE = 0.08838834764831845f;
constexpr int NWAVES = 8;

constexpr size_t MiB = 1u << 20;
constexpr size_t WS_CTL = 0, CTL_ZERO_BYTES = 1 * MiB;
constexpr size_t SZ_WIN = 97 * MiB, SZ_WO = 32 * MiB, SZ_WUP = 128 * MiB, SZ_WDN = 128 * MiB, SZ_WL = SZ_WIN + SZ_WO + SZ_WUP + SZ_WDN;
constexpr size_t WS_W = 1 * MiB;
constexpr size_t WS_WUK = WS_W + 2 * SZ_WL;
constexpr size_t WS_WUVT = WS_WUK + 3 * MiB;
constexpr size_t WS_H = WS_WUVT + 3 * MiB;
constexpr size_t WS_XN = WS_H + 128 * MiB;
constexpr size_t WS_PROJ = WS_XN + 64 * MiB;
constexpr size_t WS_TAIL = WS_PROJ + 192 * MiB;
constexpr size_t WS_Y = WS_TAIL + 3 * MiB;
constexpr size_t WS_Z = WS_Y + 64 * MiB;
constexpr size_t WS_HID = WS_Z + 128 * MiB;
constexpr size_t WS_QLAT = WS_HID + 256 * MiB;
constexpr size_t WS_OLAT = WS_QLAT + 80 * MiB;
constexpr size_t WS_DIFFO = WS_OLAT + 80 * MiB;
constexpr size_t WS_CKVN = WS_DIFFO + 48 * MiB;
constexpr size_t WS_KI = WS_CKVN + 8 * MiB;
constexpr size_t WS_WI = WS_KI + 1 * MiB;
constexpr size_t WS_KMEAN = WS_WI + 1 * MiB;
constexpr size_t WS_MMASK = WS_KMEAN + 1 * MiB;
constexpr size_t WS_SEL = WS_MMASK + 1 * MiB;
constexpr size_t WS_END = WS_SEL + 4 * MiB;
static_assert(WS_END <= (size_t)2047 * MiB, "d_ws map must fit 4x the largest tensor (2048 MiB)");
constexpr int CW_TMO = 0, CW_CODE = 1;
constexpr int CW_BAR = 4096;
constexpr int MAX_LAUNCHES = 40;

constexpr int RING_OFF = 0, RING_BYTES = 159744;
constexpr int LDSCTL_OFF = RING_BYTES, MISC_OFF = LDSCTL_OFF + 320;
constexpr int LDS_BYTES = 163840;
static_assert(MISC_OFF + 128 <= LDS_BYTES, "LDS map");

#define GAS __attribute__((address_space(1)))
#define LAS __attribute__((address_space(3)))
typedef unsigned short bf16;
typedef unsigned v4u __attribute__((ext_vector_type(4)));
typedef unsigned v2u __attribute__((ext_vector_type(2)));
typedef float f32x4 __attribute__((ext_vector_type(4)));
typedef float f32x16 __attribute__((ext_vector_type(16)));
typedef short bf16x8 __attribute__((ext_vector_type(8)));
typedef short s16x4 __attribute__((ext_vector_type(4)));
typedef GAS unsigned gu32;
typedef GAS unsigned long long gu64;
#define RLX_AGENT __ATOMIC_RELAXED, __HIP_MEMORY_SCOPE_AGENT
#define LDS_WAIT() asm volatile("s_waitcnt lgkmcnt(0)" ::: "memory")
#define VM_WAIT() asm volatile("s_waitcnt vmcnt(0)" ::: "memory")
__device__ __forceinline__ unsigned f2bf(float f) { unsigned u = __builtin_bit_cast(unsigned, f); return (u + 0x7fffu + ((u >> 16) & 1u)) >> 16; }
__device__ __forceinline__ unsigned pk2(float lo, float hi) { return f2bf(lo) | (f2bf(hi) << 16); }
__device__ __forceinline__ float bf2f(unsigned short b) { return __builtin_bit_cast(float, (unsigned)b << 16); }
__device__ __forceinline__ float bflo(unsigned w) { return __builtin_bit_cast(float, w << 16); }
__device__ __forceinline__ float bfhi(unsigned w) { return __builtin_bit_cast(float, w & 0xffff0000u); }

__device__ __forceinline__ int lane_now() { int l; asm volatile("v_mbcnt_lo_u32_b32 %0, -1, 0\n\tv_mbcnt_hi_u32_b32 %0, -1, %0" : "=v"(l)); return l; }
__constant__ unsigned char c_bucket[128] = {0, 1, 2, 3, 4, 5, 6, 7, 8, 9, 10, 11, 12, 13, 14, 15, 16, 16, 16, 17, 17, 18, 18, 18, 19, 19, 19, 20, 20, 20, 20, 21, 21, 21, 21, 22, 22, 22, 22, 22, 23, 23, 23, 23, 23, 23, 24, 24, 24, 24, 24, 24, 25, 25, 25, 25, 25, 25, 25, 26, 26, 26, 26, 26, 26, 26, 26, 27, 27, 27, 27, 27, 27, 27, 27, 27, 27, 28, 28, 28, 28, 28, 28, 28, 28, 28, 28, 29, 29, 29, 29, 29, 29, 29, 29, 29, 29, 29, 29, 30, 30, 30, 30, 30, 30, 30, 30, 30, 30, 30, 30, 30, 30, 31, 31, 31, 31, 31, 31, 31, 31, 31, 31, 31, 31, 31, 31, 31};
__device__ __forceinline__ int bucket(int dist) { return dist < 0 ? 0 : (dist > 127 ? 31 : (int)c_bucket[dist]); }


#define XB_TMO      128
#define XB_XCNT(j)  (256  + 64 * (j))
#define XB_XSUB(j)  (1280 + 64 * (j))
#define XB_XGEN(j)  (2304 + 64 * (j))
#define XB_TOP      3328
#define XB_TOPGEN   3392
#define XCD_BAR_WORDS 3456
#define XB_SPIN_CAP (1u << 18)

__device__ __forceinline__ unsigned xb_ld(unsigned* p)              { return __hip_atomic_load(p, __ATOMIC_RELAXED, __HIP_MEMORY_SCOPE_AGENT); }
__device__ __forceinline__ unsigned xb_add(unsigned* p, unsigned v) { return __hip_atomic_fetch_add(p, v, __ATOMIC_RELAXED, __HIP_MEMORY_SCOPE_AGENT); }
__device__ __forceinline__ unsigned xb_xcc_id() { return (unsigned)__builtin_amdgcn_s_getreg((3 << 11) | 20) & 0xFu; }
#define XB_SPIN(cond, bar) do { unsigned _sp = 0; while (cond) { __builtin_amdgcn_s_sleep(1); \
    if ((++_sp & 255u) == 0u) { if (xb_ld(&(bar)[XB_TMO])) break; if (_sp > XB_SPIN_CAP) { atomicAdd(&(bar)[XB_TMO], 1u); break; } } } } while (0)

struct XcdBarrier {
    unsigned* bar; unsigned x;
    int wave;
    volatile LAS unsigned* st;
};

__device__ __forceinline__ XcdBarrier xcd_barrier_post(unsigned* bar, volatile LAS unsigned* st, int wave) {
    XcdBarrier b; b.bar = bar; b.x = xb_xcc_id(); b.st = st; b.wave = wave;
    if (wave == 0 && lane_now() == 0) (void)xb_add(&bar[XB_XCNT(b.x)], 1u);
    return b;
}
__device__ __forceinline__ void xcd_barrier_complete(unsigned* bar, unsigned x, unsigned& nloc, unsigned& nx) {
    const unsigned G = gridDim.x * gridDim.y * gridDim.z;
    unsigned sum, cnt, mine, sp = 0u;
    for (;;) {
        sum = 0u; cnt = 0u; mine = 0u;
#pragma unroll
        for (unsigned j = 0; j < 16; ++j) { const unsigned c = xb_ld(&bar[XB_XCNT(j)]); sum += c; cnt += (c > 0u) ? 1u : 0u; mine = (j == x) ? c : mine; }
        if (sum == G) break;
        __builtin_amdgcn_s_sleep(1);
        if ((++sp & 255u) == 0u) { if (xb_ld(&bar[XB_TMO])) break; if (sp > XB_SPIN_CAP) { atomicAdd(&bar[XB_TMO], 1u); break; } }
    }
    nloc = mine > 0u ? mine : 1u; nx = cnt > 0u ? cnt : 1u;
}

__device__ __forceinline__ void xcd_barrier(const XcdBarrier& b) {
    asm volatile("s_waitcnt vmcnt(0)" ::: "memory");
    __syncthreads();
    if (b.wave == 0 && lane_now() == 0) {
        unsigned* bar = b.bar;
        __builtin_amdgcn_s_waitcnt(0);
        unsigned nloc = b.st[0], nx = b.st[1];
        if (nloc == 0u) { xcd_barrier_complete(bar, b.x, nloc, nx); b.st[0] = nloc; b.st[1] = nx; }
        const unsigned old = xb_add(&bar[XB_XSUB(b.x)], 1u);
        const unsigned gen = old / nloc;
        if (old + 1u == (gen + 1u) * nloc) {
            __builtin_amdgcn_fence(__ATOMIC_RELEASE, "agent");
            asm volatile("s_waitcnt vmcnt(0)" ::: "memory");
            const unsigned og = xb_add(&bar[XB_TOP], 1u);
            const unsigned tg = og / nx;
            if (og + 1u == (tg + 1u) * nx) xb_add(&bar[XB_TOPGEN], 1u);
            else XB_SPIN(xb_ld(&bar[XB_TOPGEN]) == tg, bar);
            __builtin_amdgcn_fence(__ATOMIC_ACQUIRE, "agent");
            xb_add(&bar[XB_XGEN(b.x)], 1u);
            asm volatile("s_waitcnt vmcnt(0)" ::: "memory");
        } else {
            XB_SPIN(xb_ld(&bar[XB_XGEN(b.x)]) == gen, bar);
            __builtin_amdgcn_fence(__ATOMIC_ACQUIRE, "agent");
            asm volatile("s_waitcnt vmcnt(0)" ::: "memory");
        }
    }
    __syncthreads();
}


struct Frame {
    LAS unsigned char* lds;
    volatile LAS unsigned* MISC;
    gu32* ctl;
    int wave;
    int vcu, G;
    unsigned char* ws;
};
#define WSL(F) ws_opaque((F).ws)
#define WAVE(F) int_opaque((F).wave)
#define VCU(F) int_opaque((F).vcu)
__device__ __forceinline__ int int_opaque(int v) { asm volatile("" : "+s"(v)); return v; }
__device__ __forceinline__ unsigned char* ws_opaque(unsigned char* p) { asm volatile("" : "+s"(p)); return p; }
typedef const __attribute__((address_space(4))) char* kseg_t;
__device__ __forceinline__ const float* karg(int i) { kseg_t ka = (kseg_t)__builtin_amdgcn_kernarg_segment_ptr(); asm volatile("" : "+s"(ka)); return *(const float* const __attribute__((address_space(4)))*)(ka + 8 * i); }
__device__ __forceinline__ float wave_sum(float v) {
    v += __builtin_bit_cast(float, __builtin_amdgcn_mov_dpp(__builtin_bit_cast(int, v), 0xB1, 0xF, 0xF, true));
    v += __builtin_bit_cast(float, __builtin_amdgcn_mov_dpp(__builtin_bit_cast(int, v), 0x4E, 0xF, 0xF, true));
    v += __builtin_bit_cast(float, __builtin_amdgcn_mov_dpp(__builtin_bit_cast(int, v), 0x141, 0xF, 0xF, true));
    v += __builtin_bit_cast(float, __builtin_amdgcn_mov_dpp(__builtin_bit_cast(int, v), 0x140, 0xF, 0xF, true));
    { auto r = __builtin_amdgcn_permlane16_swap(__float_as_uint(v), __float_as_uint(v), false, false); v = __uint_as_float(r[0]) + __uint_as_float(r[1]); }
    { auto r = __builtin_amdgcn_permlane32_swap(__float_as_uint(v), __float_as_uint(v), false, false); v = __uint_as_float(r[0]) + __uint_as_float(r[1]); }
    return v;
}
__device__ __forceinline__ void p0_transpose_item(const float* W, int K, int N, bf16* WT, int row_off, LAS float* scr, int item, int lane) {
    const int nblk = N / 32, kb = item / nblk, nb = item % nblk, k0 = 64 * kb, n0 = 32 * nb;
    float wv[32];
#pragma unroll
    for (int i = 0; i < 32; ++i) wv[i] = __builtin_nontemporal_load(W + (size_t)(k0 + 2 * i + (lane >> 5)) * N + n0 + (lane & 31));
#pragma unroll
    for (int i = 0; i < 32; ++i) scr[(2 * i + (lane >> 5)) * 33 + (lane & 31)] = wv[i];
    LDS_WAIT(); asm volatile("" ::: "memory");
    const int c = lane & 7;
#pragma unroll
    for (int j = 0; j < 4; ++j) { const int n = (lane >> 3) + 8 * j; const LAS float* s = scr + (8 * c) * 33 + n;
        v4u o; o.x = pk2(s[0 * 33], s[1 * 33]); o.y = pk2(s[2 * 33], s[3 * 33]); o.z = pk2(s[4 * 33], s[5 * 33]); o.w = pk2(s[6 * 33], s[7 * 33]);
        __builtin_nontemporal_store(o, (GAS v4u*)(WT + (size_t)(row_off + n0 + n) * K + k0 + 8 * c)); }
    LDS_WAIT(); asm volatile("" ::: "memory");
}
template <bool IN_BF16>
__device__ __forceinline__ void ln_row(int lane, const void* zrow, const float* g, const float* b, float* hrow, bf16* xrow) {
    f32x4 v[16]; float s = 0.f;
    if (IN_BF16) { const GAS v2u* zr = (const GAS v2u*)zrow + lane;
#pragma unroll
        for (int j = 0; j < 16; ++j) { const v2u w = zr[64 * j]; v[j] = (f32x4){bflo(w.x), bfhi(w.x), bflo(w.y), bfhi(w.y)}; s += (v[j].x + v[j].y) + (v[j].z + v[j].w); } }
    else { const GAS f32x4* zr = (const GAS f32x4*)zrow + lane;
#pragma unroll
        for (int j = 0; j < 16; ++j) { v[j] = zr[64 * j]; s += (v[j].x + v[j].y) + (v[j].z + v[j].w); } }
    const float mean = wave_sum(s) * (1.f / DM); float s2 = 0.f;
#pragma unroll
    for (int j = 0; j < 16; ++j) { v[j] = v[j] - mean; s2 += (v[j].x * v[j].x + v[j].y * v[j].y) + (v[j].z * v[j].z + v[j].w * v[j].w); }
    const float rstd = 1.f / sqrtf(wave_sum(s2) * (1.f / DM) + LN_EPS);
    const GAS f32x4* gr = (const GAS f32x4*)g + lane; const GAS f32x4* br = (const GAS f32x4*)b + lane;
#pragma unroll
    for (int j = 0; j < 16; ++j) { const f32x4 o = v[j] * rstd * gr[64 * j] + br[64 * j];
        if (hrow) ((GAS f32x4*)hrow + lane)[64 * j] = o;
        if (xrow) ((GAS unsigned long long*)xrow + lane)[64 * j] = (unsigned long long)pk2(o.x, o.y) | ((unsigned long long)pk2(o.z, o.w) << 32); }
}
__device__ __forceinline__ bf16* w_layer(Frame& F, int l, int which) {
    const size_t o = WS_W + (size_t)l * SZ_WL + (which == 0 ? 0 : which == 1 ? SZ_WIN : which == 2 ? SZ_WIN + SZ_WO : SZ_WIN + SZ_WO + SZ_WUP);
    return (bf16*)(WSL(F) + o);
}
__device__ __forceinline__ void p0_prologue(Frame& F) {
    const int lane = lane_now();
    const int w_ = WAVE(F); LAS float* scr = (LAS float*)(F.lds + RING_OFF + w_ * 16384);
    const int gw = VCU(F) * NWAVES + w_, NGW = F.G * NWAVES;
    constexpr int I_IN = (DM / 64) * (DIN / 32), I_O = (DM / 64) * (DM / 32), I_UP = (DM / 64) * (DFF / 32), I_DN = (DFF / 64) * (DM / 32), I_UV = (KVL / 64) * (HD / 32) * DSA_H;
    constexpr int PER_L = I_IN + I_O + I_UP + I_DN + I_UV, NITEMS = DEPTH * PER_L;
    for (int it = gw; it < NITEMS; it += NGW) {
        const int l = it / PER_L; int r = it - l * PER_L;
        if (r < I_IN) { p0_transpose_item(karg(4) + (size_t)l * DM * DIN, DM, DIN, w_layer(F, l, 0), 0, scr, r, lane); continue; } r -= I_IN;
        if (r < I_O) { p0_transpose_item(karg(10) + (size_t)l * DM * DM, DM, DM, w_layer(F, l, 1), 0, scr, r, lane); continue; } r -= I_O;
        if (r < I_UP) { p0_transpose_item(karg(13) + (size_t)l * DM * DFF, DM, DFF, w_layer(F, l, 2), 0, scr, r, lane); continue; } r -= I_UP;
        if (r < I_DN) { p0_transpose_item(karg(14) + (size_t)l * DFF * DM, DFF, DM, w_layer(F, l, 3), 0, scr, r, lane); continue; } r -= I_DN;
        { const int h = r / ((KVL / 64) * (HD / 32)), rr = r % ((KVL / 64) * (HD / 32));
          p0_transpose_item(karg(9) + ((size_t)l * DSA_H + h) * KVL * HD, KVL, HD, (bf16*)(WSL(F) + WS_WUVT) + ((size_t)l * DSA_H + h) * HD * KVL, 0, scr, rr, lane); }
    }
    { const GAS f32x4* src = (const GAS f32x4*)karg(8); GAS v2u* dst = (GAS v2u*)(WSL(F) + WS_WUK); const int n4 = DEPTH * DSA_H * KVL * HD / 4;
      for (int i = gw * 64 + lane; i < n4; i += NGW * 64) { const f32x4 v = src[i]; v2u o; o.x = pk2(v.x, v.y); o.y = pk2(v.z, v.w); dst[i] = o; } }
    for (int m = gw; m < M; m += NGW) ln_row<false>(lane, karg(0) + (size_t)m * DM, karg(1), karg(2), nullptr, (bf16*)(WSL(F) + WS_XN) + (size_t)m * DM);
}
__device__ __forceinline__ void tail_phase(Frame& F, const bf16* XN, const bf16* WT, float* TAIL) {
    LAS float* part = (LAS float*)(F.lds + RING_OFF);
    const int lane = lane_now();
    const int w = WAVE(F), fr = lane & 15, fq = lane >> 4;
    for (int unit = VCU(F); unit < M / 32; unit += F.G) {
        const int m0 = unit * 32;
        f32x4 acc[2][6];
#pragma unroll
        for (int i = 0; i < 2; ++i)
#pragma unroll
            for (int j = 0; j < 6; ++j) acc[i][j] = (f32x4){0.f, 0.f, 0.f, 0.f};
        const bf16* ap = XN + (size_t)(m0 + fr) * DM + w * 512 + 8 * fq; const bf16* bp = WT + (size_t)fr * DM + w * 512 + 8 * fq;
#pragma unroll 4
        for (int ks = 0; ks < 16; ++ks) {
            bf16x8 a[2], b[6];
#pragma unroll
            for (int i = 0; i < 2; ++i) a[i] = *(const GAS bf16x8*)(ap + (size_t)i * 16 * DM + ks * 32);
#pragma unroll
            for (int j = 0; j < 6; ++j) b[j] = *(const GAS bf16x8*)(bp + (size_t)j * 16 * DM + ks * 32);
#pragma unroll
            for (int i = 0; i < 2; ++i)
#pragma unroll
                for (int j = 0; j < 6; ++j) acc[i][j] = __builtin_amdgcn_mfma_f32_16x16x32_bf16(a[i], b[j], acc[i][j], 0, 0, 0);
        }
#pragma unroll
        for (int i = 0; i < 2; ++i)
#pragma unroll
            for (int j = 0; j < 6; ++j)
#pragma unroll
                for (int r = 0; r < 4; ++r) part[(w * 32 + i * 16 + fq * 4 + r) * 96 + j * 16 + fr] = acc[i][j][r];
        __syncthreads();
        for (int o = w * 64 + lane; o < 32 * 96; o += NWAVES * 64) { float s = 0.f;
#pragma unroll
            for (int ww = 0; ww < 8; ++ww) s += part[ww * 32 * 96 + o];
            TAIL[(size_t)m0 * 96 + o] = s; }
        __syncthreads();
    }
}
__device__ __forceinline__ void ln_phase(Frame& F, const bf16* Z, const float* g, const float* b, float* Fout, bf16* Xout) {
    const int lane = lane_now();
    const int gw = VCU(F) * NWAVES + WAVE(F), NGW = F.G * NWAVES;
    for (int m = gw; m < M; m += NGW) ln_row<true>(lane, Z + (size_t)m * DM, g, b, Fout ? Fout + (size_t)m * DM : nullptr, Xout ? Xout + (size_t)m * DM : nullptr);
}

__constant__ unsigned short c_attn_sched[256][4] = {{660,132,65535,65535},{661,133,65535,65535},{662,134,65535,65535},{663,135,65535,65535},{664,136,65535,65535},{665,137,65535,65535},{666,138,65535,65535},{667,139,65535,65535},{668,140,65535,65535},{669,141,65535,65535},{670,142,65535,65535},{671,143,65535,65535},{672,144,65535,65535},{673,145,65535,65535},{674,146,65535,65535},{675,147,65535,65535},{676,148,65535,65535},{677,149,65535,65535},{678,150,65535,65535},{679,151,65535,65535},{680,152,65535,65535},{681,153,65535,65535},{682,154,65535,65535},{683,155,65535,65535},{616,196,65535,65535},{617,197,65535,65535},{618,198,65535,65535},{619,199,65535,65535},{620,288,65535,65535},{621,289,65535,65535},{622,290,65535,65535},{623,291,65535,65535},{624,292,65535,65535},{625,293,65535,65535},{626,294,65535,65535},{627,295,65535,65535},{628,296,65535,65535},{629,297,65535,65535},{630,298,65535,65535},{631,299,65535,65535},{632,300,65535,65535},{633,301,65535,65535},{634,302,65535,65535},{635,303,65535,65535},{636,304,65535,65535},{637,305,65535,65535},{638,306,65535,65535},{639,307,65535,65535},{572,348,65535,65535},{573,349,65535,65535},{574,350,65535,65535},{575,351,65535,65535},{576,176,28,65535},{577,177,29,65535},{578,178,30,65535},{579,179,31,65535},{580,180,32,65535},{581,181,33,65535},{582,182,34,65535},{583,183,35,65535},{584,184,36,65535},{585,185,37,65535},{586,186,38,65535},{587,187,39,65535},{588,188,40,65535},{589,189,41,65535},{590,190,42,65535},{591,191,43,65535},{592,192,65535,65535},{593,193,65535,65535},{594,194,65535,65535},{595,195,65535,65535},{528,388,65535,65535},{529,389,65535,65535},{530,390,65535,65535},{531,391,65535,65535},{532,392,65535,65535},{533,393,65535,65535},{534,394,65535,65535},{535,395,65535,65535},{536,332,12,65535},{537,333,13,65535},{538,334,14,65535},{539,335,15,65535},{540,336,16,65535},{541,337,17,65535},{542,338,18,65535},{543,339,19,65535},{544,340,20,65535},{545,341,21,65535},{546,342,22,65535},{547,343,23,65535},{548,344,24,65535},{549,345,25,65535},{550,346,26,65535},{551,347,27,65535},{484,232,128,65535},{485,233,129,65535},{486,234,130,65535},{487,235,131,65535},{488,236,68,65535},{489,237,69,65535},{490,238,70,65535},{491,239,71,65535},{492,240,72,65535},{493,241,73,65535},{494,242,74,65535},{495,243,75,65535},{496,376,76,65535},{497,377,77,65535},{498,378,78,65535},{499,379,79,65535},{500,380,80,65535},{501,381,81,65535},{502,382,82,65535},{503,383,83,65535},{504,384,84,65535},{505,385,85,65535},{506,386,86,65535},{507,387,87,65535},{440,428,48,65535},{441,429,49,65535},{442,430,50,65535},{443,431,51,65535},{444,432,52,65535},{445,433,53,65535},{446,434,54,65535},{447,435,55,65535},{448,436,56,65535},{449,437,57,65535},{450,438,58,65535},{451,439,59,65535},{452,220,244,65535},{453,221,245,65535},{454,222,246,65535},{455,223,247,65535},{456,224,248,65535},{457,225,249,65535},{458,226,250,65535},{459,227,251,65535},{460,228,252,65535},{461,229,253,65535},{462,230,254,65535},{463,231,255,65535},{684,276,60,65535},{685,277,61,65535},{686,278,62,65535},{687,279,63,65535},{688,280,64,65535},{689,281,65,65535},{690,282,66,65535},{691,283,67,65535},{692,284,112,65535},{693,285,113,65535},{694,286,114,65535},{695,287,115,65535},{696,420,216,65535},{697,421,217,65535},{698,422,218,65535},{699,423,219,65535},{700,424,88,65535},{701,425,89,65535},{702,426,90,65535},{703,427,91,65535},{396,516,0,65535},{397,517,1,65535},{398,518,2,65535},{399,519,3,65535},{400,520,4,65535},{401,521,5,65535},{402,522,6,65535},{403,523,7,65535},{404,524,8,65535},{405,525,9,65535},{406,526,10,65535},{407,527,11,65535},{408,464,92,65535},{409,465,93,65535},{410,466,94,65535},{411,467,95,65535},{412,468,96,65535},{413,469,97,65535},{414,470,98,65535},{415,471,99,65535},{416,472,100,65535},{417,473,101,65535},{418,474,102,65535},{419,475,103,65535},{640,476,104,65535},{641,477,105,65535},{642,478,106,65535},{643,479,107,65535},{644,480,108,65535},{645,481,109,65535},{646,482,110,65535},{647,483,111,65535},{648,264,256,65535},{649,265,257,65535},{650,266,258,65535},{651,267,259,65535},{652,268,260,65535},{653,269,261,65535},{654,270,262,65535},{655,271,263,65535},{656,272,200,65535},{657,273,201,65535},{658,274,202,65535},{659,275,203,65535},{596,320,156,65535},{597,321,157,65535},{598,322,158,65535},{599,323,159,65535},{600,324,160,65535},{601,325,161,65535},{602,326,162,65535},{603,327,163,65535},{604,328,164,65535},{605,329,165,65535},{606,330,166,65535},{607,331,167,65535},{608,508,168,65535},{609,509,169,65535},{610,510,170,65535},{611,511,171,65535},{612,512,172,65535},{613,513,173,65535},{614,514,174,65535},{615,515,175,65535},{352,560,116,65535},{353,561,117,65535},{354,562,118,65535},{355,563,119,65535},{356,564,120,65535},{357,565,121,65535},{358,566,122,65535},{359,567,123,65535},{360,568,124,65535},{361,569,125,65535},{362,570,126,65535},{363,571,127,65535},{364,308,204,65535},{365,309,205,65535},{366,310,206,65535},{367,311,207,65535},{368,312,208,65535},{369,313,209,65535},{370,314,210,65535},{371,315,211,65535},{372,316,212,65535},{373,317,213,65535},{374,318,214,65535},{375,319,215,65535},{552,556,44,65535},{553,557,45,65535},{554,558,46,65535},{555,559,47,65535}};


namespace fa {
constexpr int NW = 8, QBLK = 32, KVBLK = 64, QB = NW * QBLK, D = 128;
constexpr int SHM_V = KVBLK * D * 2, SHM_K = KVBLK * D * 2;
constexpr int NSLOT = 3, SLOT = SHM_K + 2 * SHM_V;
constexpr int OFF_RING = 0, OFF_WS = OFF_RING + NSLOT * SLOT, OFF_BT = OFF_WS + NW * 64 * 4, BT_PAD = 96, BT_N = BT_PAD + 256, LDS_BYTES = OFF_BT + BT_N * 4;
constexpr float THR = 8.f;
#define KSWZ(row, colB) ((row) * 256 + ((colB) ^ (((row) & 7) << 4)))
#define SBAR() __builtin_amdgcn_sched_barrier(0)
__device__ __forceinline__ int v_st(int k, int c) { const int kk = (k & ~0xC) | ((k & 4) << 1) | ((k & 8) >> 1); return ((kk >> 3) * 4 + (c >> 5)) * 512 + ((kk & 7) * 32 + (c & 31)) * 2; }
__device__ __forceinline__ int v_rd_base(int lane) { return ((lane & 3) << 3) | (((lane >> 2) & 3) << 6) | (((lane >> 4) & 1) << 5) | (((lane >> 5) & 1) << 8); }
constexpr int v_rd_off(int d0, int ks, int half) { return d0 * 512 + ks * 4096 + half * 2048; }
__device__ __forceinline__ int crow(int r, int hi) { return (r & 3) + 8 * (r >> 2) + 4 * hi; }
__device__ __forceinline__ unsigned cvtpk(float lo, float hi) { unsigned r; asm volatile("v_cvt_pk_bf16_f32 %0, %1, %2" : "=v"(r) : "v"(lo), "v"(hi)); return r; }

__device__ __forceinline__ void bias_mask_tile(f32x16& p0, f32x16& p1, int dq, const LAS float* bt) {
    const float NEG = -__builtin_inff();
    const LAS float* b = bt + BT_PAD + dq - 59;
#pragma unroll
    for (int r = 0; r < 16; ++r) {
        const int c = (r & 3) + 8 * (r >> 2);
        const float v0 = b[59 - c], v1 = b[59 - c - 32];
        p0[r] = (dq - c) >= 0 ? p0[r] + v0 : NEG;
        p1[r] = (dq - c - 32) >= 0 ? p1[r] + v1 : NEG;
    }
}
__device__ __forceinline__ void partialSM(f32x16& p0, f32x16& p1, float& m_reg, float& alpha, float bc) {
    float pmax = p0[0];
#pragma unroll
    for (int r = 1; r < 16; ++r) pmax = fmaxf(pmax, p0[r]);
#pragma unroll
    for (int r = 0; r < 16; ++r) pmax = fmaxf(pmax, p1[r]);
    { auto rr = __builtin_amdgcn_permlane32_swap(__float_as_uint(pmax), __float_as_uint(pmax), false, false);
      pmax = fmaxf(__uint_as_float(rr[0]), __uint_as_float(rr[1])); }
    pmax += bc;
    constexpr float C2 = 1.4426950408889634f * SCALE;
    float mn;
    if (__builtin_expect(__all((pmax - m_reg) * SCALE <= THR), 1)) { mn = m_reg; alpha = 1.f; }
    else { mn = fmaxf(m_reg, pmax); alpha = __builtin_amdgcn_exp2f((m_reg - mn) * C2); m_reg = mn; }
    const float mnL = (bc - mn) * C2;
#pragma unroll
    for (int r = 0; r < 16; ++r) p0[r] = __builtin_amdgcn_exp2f(fmaf(p0[r], C2, mnL));
#pragma unroll
    for (int r = 0; r < 16; ++r) p1[r] = __builtin_amdgcn_exp2f(fmaf(p1[r], C2, mnL));
}
__device__ __forceinline__ void finishSM(f32x16& p0, f32x16& p1, float alpha, float& l_reg, bf16x8& pa0, bf16x8& pa1, bf16x8& pa2, bf16x8& pa3) {
    float ps = 0;
#pragma unroll
    for (int r = 0; r < 16; ++r) ps += p0[r];
#pragma unroll
    for (int r = 0; r < 16; ++r) ps += p1[r];
    { auto rr = __builtin_amdgcn_permlane32_swap(__float_as_uint(ps), __float_as_uint(ps), false, false);
      ps = __uint_as_float(rr[0]) + __uint_as_float(rr[1]); }
    l_reg = l_reg * alpha + ps;
#define PK4(P, B_, OUT) do { unsigned a0 = cvtpk(P[B_+0], P[B_+1]), a1 = cvtpk(P[B_+2], P[B_+3]);                          \
        unsigned b0 = cvtpk(P[B_+4], P[B_+5]), b1 = cvtpk(P[B_+6], P[B_+7]);                                             \
        auto r0 = __builtin_amdgcn_permlane32_swap(a0, b0, false, false); auto r1 = __builtin_amdgcn_permlane32_swap(a1, b1, false, false); \
        v4u w = {r0[0], r1[0], r0[1], r1[1]}; OUT = __builtin_bit_cast(bf16x8, w); } while (0)
    PK4(p0, 0, pa0); PK4(p0, 8, pa1); PK4(p1, 0, pa2); PK4(p1, 8, pa3);
#undef PK4
}
__device__ __forceinline__ void qkt(f32x16& p0, f32x16& p1, const LAS char* Kb, int r32, int hi, const bf16x8* qr) {
    p0 = f32x16{}; p1 = f32x16{};
    const LAS char* kb[4];
#pragma unroll
    for (int dd = 0; dd < 4; ++dd) kb[dd] = Kb + KSWZ(r32, (dd * 16 + hi * 8) * 2);
#pragma unroll
    for (int d0 = 0; d0 < 8; ++d0) { const LAS char* a = kb[d0 & 3] + (d0 >> 2) * 128;
        const bf16x8 b0 = *(const LAS bf16x8*)a;
        const bf16x8 b1 = *(const LAS bf16x8*)(a + 32 * 256);
        p0 = __builtin_amdgcn_mfma_f32_32x32x16_bf16(b0, qr[d0], p0, 0, 0, 0);
        p1 = __builtin_amdgcn_mfma_f32_32x32x16_bf16(b1, qr[d0], p1, 0, 0, 0); }
}
__device__ __forceinline__ void pv_tile(f32x16* o, int vb0, bf16x8 pa0, bf16x8 pa1, bf16x8 pa2, bf16x8 pa3) {
#define TRRD(dst, off) asm volatile("ds_read_b64_tr_b16 %0, %1 offset:%2" : "=&v"(dst) : "v"(vb0), "i"(off) : "memory")
#define PV_D0(d0) do { s16x4 l0, l1, l2, l3, h0, h1, h2, h3; constexpr int b_ = v_rd_off(d0, 0, 0);   \
        TRRD(l0, b_); TRRD(h0, b_ + 2048); TRRD(l1, b_ + 4096); TRRD(h1, b_ + 6144); TRRD(l2, b_ + 8192); TRRD(h2, b_ + 10240); TRRD(l3, b_ + 12288); TRRD(h3, b_ + 14336); \
        asm volatile("s_waitcnt lgkmcnt(0)" ::: "memory"); SBAR();   \
        o[d0] = __builtin_amdgcn_mfma_f32_32x32x16_bf16(pa0, (bf16x8){l0[0], l0[1], l0[2], l0[3], h0[0], h0[1], h0[2], h0[3]}, o[d0], 0, 0, 0);   \
        o[d0] = __builtin_amdgcn_mfma_f32_32x32x16_bf16(pa1, (bf16x8){l1[0], l1[1], l1[2], l1[3], h1[0], h1[1], h1[2], h1[3]}, o[d0], 0, 0, 0);   \
        o[d0] = __builtin_amdgcn_mfma_f32_32x32x16_bf16(pa2, (bf16x8){l2[0], l2[1], l2[2], l2[3], h2[0], h2[1], h2[2], h2[3]}, o[d0], 0, 0, 0);   \
        o[d0] = __builtin_amdgcn_mfma_f32_32x32x16_bf16(pa3, (bf16x8){l3[0], l3[1], l3[2], l3[3], h3[0], h3[1], h3[2], h3[3]}, o[d0], 0, 0, 0); } while (0)
    PV_D0(0); PV_D0(1); PV_D0(2); PV_D0(3);
#undef PV_D0
#undef TRRD
}

template <bool MOBA, int VW>
__device__ __forceinline__ void unit(LAS unsigned char* lds, const bf16* Q, const bf16* K, const bf16* V, bf16* O, int ldq, int ldk, int ldv, int ldo, int P0,
                                     const float* biascol, const unsigned* mmask, int mstride, int wave) {
    const int wid = wave, lane = lane_now(), tid = wid * 64 + lane, r32 = lane & 31, hi = lane >> 5;
    LAS float* wsf = (LAS float*)(lds + OFF_WS) + wid * 64; LAS float* li_l = wsf; LAS float* al_l = wsf + 32;
    LAS float* bt = (LAS float*)(lds + OFF_BT);
    const float bfar = biascol[31 * 32] * (1.f / SCALE);
    const int NT = (P0 + QB) / KVBLK;
    const int qlo = P0 + wid * QBLK, qm = qlo + r32 - 4 * hi;
    const int own = P0 >> 8;
    unsigned mw = 0u; if (MOBA) mw = mmask[(size_t)(qlo + r32) * mstride];
    float m_reg = -1e30f, l_reg = 0.f; f32x16 o[4 * VW] = {};
    const int vrb = v_rd_base(lane);
    bf16x8 qr[8];
#pragma unroll
    for (int d0 = 0; d0 < 8; ++d0) qr[d0] = *(const GAS bf16x8*)(Q + (size_t)(qlo + r32) * ldq + d0 * 16 + hi * 8);
#define FA_ISSUE(t_) do { const int sl_ = (t_) % NSLOT; const bf16* kt_ = K + (size_t)((t_) * KVBLK) * ldk; const bf16* vt_ = V + (size_t)((t_) * KVBLK) * ldv; \
        int ln_ = lane; asm volatile("" : "+v"(ln_));     \
        _Pragma("unroll") for (int jj = 0; jj < 2; ++jj) { const int j_ = 2 * wid + jj, row_ = 4 * j_ + (ln_ >> 4), ks_ = row_ * ldk + (((ln_ & 15) ^ (row_ & 7)) << 3); \
            const int s_ = 2 * j_ + (ln_ >> 5), kk_ = (s_ >> 2) * 8 + ((ln_ & 31) >> 2), c_ = (s_ & 3) * 32 + (ln_ & 3) * 8, key_ = (kk_ & ~0xC) | ((kk_ & 4) << 1) | ((kk_ & 8) >> 1), vs_ = key_ * ldv + c_; \
            __builtin_amdgcn_global_load_lds((const GAS unsigned*)(kt_ + ks_), (LAS unsigned*)(lds + OFF_RING + sl_ * SLOT + (2 * wid + jj) * 1024), 16, 0, 0); \
            _Pragma("unroll") for (int vh_ = 0; vh_ < VW; ++vh_) __builtin_amdgcn_global_load_lds((const GAS unsigned*)(vt_ + vs_ + vh_ * 128), (LAS unsigned*)(lds + OFF_RING + sl_ * SLOT + SHM_K + vh_ * SHM_V + (2 * wid + jj) * 1024), 16, 0, 0); } } while (0)
    __syncthreads();
    for (int i = tid; i < BT_N; i += NW * 64) { const int d = i - BT_PAD; bt[i] = biascol[bucket(d < 0 ? 0 : d) * 32] * (1.f / SCALE); }
    asm volatile("s_waitcnt vmcnt(0) lgkmcnt(0)" ::: "memory");
    FA_ISSUE(0); if (NT > 1) FA_ISSUE(1);
    for (int t = 0; t < NT; ++t) {
        const int kb = t * KVBLK; const LAS unsigned char* slot = lds + OFF_RING + (t % NSLOT) * SLOT;
        if (t + 1 < NT) { if (VW == 2) asm volatile("s_waitcnt vmcnt(6)" ::: "memory"); else asm volatile("s_waitcnt vmcnt(4)" ::: "memory"); } else asm volatile("s_waitcnt vmcnt(0)" ::: "memory");
        __builtin_amdgcn_s_barrier();
        asm volatile("" ::: "memory"); SBAR();
        if (t + 2 < NT) FA_ISSUE(t + 2);
        if (kb <= qlo + QBLK - 1) {
        f32x16 p0, p1; float alpha; bf16x8 pa0, pa1, pa2, pa3;
        qkt(p0, p1, (const LAS char*)slot, r32, hi, qr);
        const bool near = kb + KVBLK - 1 > qlo - 113;
        float bc = near ? 0.f : bfar;
        if (MOBA) { const int n = kb >> 8; if (n < own && !((mw >> n) & 1u)) bc = -__builtin_inff(); }
        if (near) bias_mask_tile(p0, p1, qm - kb, bt);
        partialSM(p0, p1, m_reg, alpha, bc);
        finishSM(p0, p1, alpha, l_reg, pa0, pa1, pa2, pa3);
        if (__any(alpha < 1.f)) { if (hi == 0) al_l[r32] = alpha; asm volatile("s_waitcnt lgkmcnt(0)" ::: "memory");
#pragma unroll
            for (int d_ = 0; d_ < 4 * VW; ++d_)
#pragma unroll
                for (int r = 0; r < 16; ++r) o[d_][r] *= al_l[crow(r, hi)]; }
        SBAR();
        pv_tile(o, (int)(unsigned)(size_t)(slot + SHM_K) + vrb, pa0, pa1, pa2, pa3);
        if (VW == 2) pv_tile(o + 4, (int)(unsigned)(size_t)(slot + SHM_K + SHM_V) + vrb, pa0, pa1, pa2, pa3);
        }
    }
#undef FA_ISSUE
    if (hi == 0) li_l[r32] = l_reg; asm volatile("s_waitcnt lgkmcnt(0)" ::: "memory");
    bf16* Ow = O + (size_t)qlo * ldo;
#ifndef REP_FAEPI
#define REP_FAEPI 1
#endif
    for (int rep_ = 0; rep_ < REP_FAEPI; ++rep_)
#pragma unroll
    for (int r = 0; r < 16; ++r) { const int orow = crow(r, hi); const float rl = __builtin_amdgcn_rcpf(li_l[orow]);
#pragma unroll
        for (int d0 = 0; d0 < 4 * VW; ++d0) { const float v = o[d0][r] * rl; const float vn = __shfl_xor(v, 1);
            if ((r32 & 1) == 0) *(GAS unsigned*)(Ow + (size_t)orow * ldo + d0 * 32 + r32) = cvtpk(v, vn); } }
}
#undef KSWZ
#undef SBAR
}


__device__ __forceinline__ float lambda_init_of(int l) { return l == 0 ? 0.2f : 0.35550906759096925f; }

__device__ __forceinline__ void prep_phase(Frame& F, int l) {
    const int lane = lane_now();
    const int wv_ = WAVE(F), gw = VCU(F) * NWAVES + wv_, NGW = F.G * NWAVES;
    const bf16* PROJ = (const bf16*)(WSL(F) + WS_PROJ); const float* TAIL = (const float*)(WSL(F) + WS_TAIL);
    bf16* CKVN = (bf16*)(WSL(F) + WS_CKVN); bf16* KI = (bf16*)(WSL(F) + WS_KI); float* WI = (float*)(WSL(F) + WS_WI); float* KMEAN = (float*)(WSL(F) + WS_KMEAN);
    const float* kvg = karg(7) + (size_t)l * KVL;
    const f32x4 g0 = *(const GAS f32x4*)(kvg + lane * 8), g1 = *(const GAS f32x4*)(kvg + lane * 8 + 4);
    for (int m = gw; m < M; m += NGW) {
        const v4u cw = *(const GAS v4u*)(PROJ + (size_t)m * DINM + O_CKV + lane * 8);
        float c[8] = {bflo(cw.x), bfhi(cw.x), bflo(cw.y), bfhi(cw.y), bflo(cw.z), bfhi(cw.z), bflo(cw.w), bfhi(cw.w)};
        float ss = 0.f;
#pragma unroll
        for (int j = 0; j < 8; ++j) ss += c[j] * c[j];
        const float r = 1.f / sqrtf(wave_sum(ss) * (1.f / KVL) + RMS_EPS);
        v4u o; o.x = pk2(c[0] * r * g0.x, c[1] * r * g0.y); o.y = pk2(c[2] * r * g0.z, c[3] * r * g0.w); o.z = pk2(c[4] * r * g1.x, c[5] * r * g1.y); o.w = pk2(c[6] * r * g1.z, c[7] * r * g1.w);
        *(GAS v4u*)(CKVN + (size_t)m * KVL + lane * 8) = o;
        const float kv = TAIL[(size_t)m * NTAIL + lane];
        const float mean = wave_sum(kv) * (1.f / 64.f); const float d = kv - mean;
        const float var = wave_sum(d * d) * (1.f / 64.f);
        KI[(size_t)m * 64 + lane] = (bf16)f2bf(d / sqrtf(var + LN_EPS));
        if (lane < 32) WI[(size_t)m * 32 + lane] = TAIL[(size_t)m * NTAIL + 64 + lane] * (0.17677669529663687f * 0.125f);
    }
    { LAS float* red = (LAS float*)(F.lds + RING_OFF);
      for (int it = VCU(F); it < NB * MOBA_H * 16; it += F.G) {
        const int n = it & 15, bh = it >> 4, b = bh / MOBA_H, h = bh % MOBA_H;
        const bf16* kp = PROJ + (size_t)(b * T + n * 256 + wv_ * 32) * DINM + O_MK + h * HD + 2 * lane; unsigned wq[32];
#pragma unroll
        for (int j = 0; j < 32; ++j) wq[j] = *(const GAS unsigned*)(kp + (size_t)j * DINM);
        float s0 = 0.f, s1 = 0.f;
#pragma unroll
        for (int j = 0; j < 32; ++j) { s0 += bflo(wq[j]); s1 += bfhi(wq[j]); }
        __syncthreads();
        red[wv_ * 128 + 2 * lane] = s0; red[wv_ * 128 + 2 * lane + 1] = s1;
        __syncthreads();
        if (wv_ == 0) { float a0 = 0.f, a1 = 0.f;
#pragma unroll
            for (int ww = 0; ww < 8; ++ww) { a0 += red[ww * 128 + 2 * lane]; a1 += red[ww * 128 + 2 * lane + 1]; }
            KMEAN[(size_t)it * HD + 2 * lane] = a0 * (1.f / 256.f); KMEAN[(size_t)it * HD + 2 * lane + 1] = a1 * (1.f / 256.f); }
      } }
}
__device__ __forceinline__ float quad_sum(float v) {
    v += __builtin_bit_cast(float, __builtin_amdgcn_mov_dpp(__builtin_bit_cast(int, v), 0xB1, 0xF, 0xF, true));
    v += __builtin_bit_cast(float, __builtin_amdgcn_mov_dpp(__builtin_bit_cast(int, v), 0x4E, 0xF, 0xF, true));
    return v;
}
#ifdef MS_CHECK
__device__ __forceinline__ unsigned ms_ref_mask(float g, int own) {
    float v1 = 0.f, v2 = 0.f, v3 = 0.f; int i1 = -1, i2 = -1, i3 = -1;
#pragma unroll
    for (int nn = 0; nn < 15; ++nn) { const float gg = __builtin_bit_cast(float, __builtin_amdgcn_readlane(__builtin_bit_cast(int, g), 4 * nn));
        if (nn < own) {
            if (i1 < 0 || gg > v1) { v3 = v2; i3 = i2; v2 = v1; i2 = i1; v1 = gg; i1 = nn; }
            else if (i2 < 0 || gg > v2) { v3 = v2; i3 = i2; v2 = gg; i2 = nn; }
            else if (i3 < 0 || gg > v3) { v3 = gg; i3 = nn; } } }
    unsigned mask = 0u; if (i1 >= 0) mask |= 1u << i1; if (i2 >= 0) mask |= 1u << i2; if (i3 >= 0) mask |= 1u << i3;
    return mask;
}
#define MS_CHK(g_, mask_, row_) do { if (ms_ref_mask(g_, own) != ((mask_) ^ MS_CHECK_XOR) && lane == 0) ((unsigned short*)(WSL(F) + WS_XN))[(size_t)(row_) * DM] = 0x7FC0; } while (0)
#else
#define MS_CHK(g_, mask_, row_) do { } while (0)
#endif
__device__ __forceinline__ int quads_max(int v) {
    { const int o = __builtin_amdgcn_mov_dpp(v, 0x141, 0xF, 0xF, true); v = v > o ? v : o; }
    { const int o = __builtin_amdgcn_mov_dpp(v, 0x140, 0xF, 0xF, true); v = v > o ? v : o; }
    { auto r = __builtin_amdgcn_permlane16_swap((unsigned)v, (unsigned)v, false, false); const int a = (int)r[0], c = (int)r[1]; v = a > c ? a : c; }
    { auto r = __builtin_amdgcn_permlane32_swap((unsigned)v, (unsigned)v, false, false); const int a = (int)r[0], c = (int)r[1]; v = a > c ? a : c; }
    return v;
}
__device__ __forceinline__ void moba_select_phase(Frame& F) {
    const int lane = lane_now();
    const int wv_ = WAVE(F), gw = VCU(F) * NWAVES + wv_, NGW = F.G * NWAVES, n = lane >> 2, part = lane & 3;
    const bf16* PROJ = (const bf16*)(WSL(F) + WS_PROJ); const float* KMEAN = (const float*)(WSL(F) + WS_KMEAN); unsigned* MMASK = (unsigned*)(WSL(F) + WS_MMASK);
    for (int m4 = gw; m4 < M / 4; m4 += NGW) {
        const int m0 = m4 * 4, b = m0 / T, own = (m0 % T) >> 8;
        f32x4 kmA[8], kmB[8]; v4u qA[4][4], qB[4][4];
#define MS_LOAD(KM, QQ, h_) do { const float* kp_ = KMEAN + ((size_t)((b * MOBA_H + (h_)) * 16 + n)) * HD + part * 32; \
        _Pragma("unroll") for (int i = 0; i < 8; ++i) KM[i] = n < own ? *(const GAS f32x4*)(kp_ + 4 * i) : (f32x4){0.f, 0.f, 0.f, 0.f}; \
        _Pragma("unroll") for (int tk = 0; tk < 4; ++tk) { const bf16* qp_ = PROJ + (size_t)(m0 + tk) * DINM + O_MQ + (h_) * HD + part * 32; \
            _Pragma("unroll") for (int i = 0; i < 4; ++i) QQ[tk][i] = *(const GAS v4u*)(qp_ + 8 * i); } } while (0)
#define MS_HEAD(KM, QQ, h_) do { _Pragma("unroll") for (int tk = 0; tk < 4; ++tk) { float g = 0.f; \
            _Pragma("unroll") for (int i = 0; i < 4; ++i) { const v4u qw = QQ[tk][i]; \
                g += bflo(qw.x) * KM[2 * i].x + bfhi(qw.x) * KM[2 * i].y + bflo(qw.y) * KM[2 * i].z + bfhi(qw.y) * KM[2 * i].w \
                   + bflo(qw.z) * KM[2 * i + 1].x + bfhi(qw.z) * KM[2 * i + 1].y + bflo(qw.w) * KM[2 * i + 1].z + bfhi(qw.w) * KM[2 * i + 1].w; } \
            g = quad_sum(g); \
              \
            int key_ = __builtin_bit_cast(int, g); key_ ^= (key_ >> 31) & 0x7FFFFFFF; bool live_ = n < own; unsigned mask = 0u; \
            _Pragma("unroll") for (int rd_ = 0; rd_ < 3; ++rd_) { const int mx_ = quads_max(live_ ? key_ : (int)0x80000000); \
                const unsigned long long bal_ = __ballot(live_ && key_ == mx_); \
                if (bal_) { const int sel_ = (int)(__builtin_ctzll(bal_) >> 2); mask |= 1u << sel_; live_ = live_ && n != sel_; } } \
            MS_CHK(g, mask, m0 + tk); \
            if (lane == 0) MMASK[(size_t)(m0 + tk) * MOBA_H + (h_)] = mask; } } while (0)
        MS_LOAD(kmA, qA, 0);
        for (int h = 0; h < MOBA_H; h += 2) {
            MS_LOAD(kmB, qB, h + 1);
            MS_HEAD(kmA, qA, h);
            if (h + 2 < MOBA_H) MS_LOAD(kmA, qA, h + 2);
            MS_HEAD(kmB, qB, h + 1);
        }
#undef MS_LOAD
#undef MS_HEAD
#undef MS_CHK
    }
}
__device__ __forceinline__ void attn_phase(Frame& F) {
    const bf16* PROJ = (const bf16*)(WSL(F) + WS_PROJ); bf16* DIFFO = (bf16*)(WSL(F) + WS_DIFFO); bf16* Y = (bf16*)(WSL(F) + WS_Y);
    const unsigned* MMASK = (const unsigned*)(WSL(F) + WS_MMASK); const float* tab = karg(3);
    constexpr int ND = NB * DIFF_H * 2, PER_QB = ND + NB * MOBA_H, NU = 16 * PER_QB;
    const int vcu_ = VCU(F), wave_ = WAVE(F);
    for (int r = 0;; ++r) {
        int i;
        if (F.G == 256) { if (r >= 4) break; const int id = (int)c_attn_sched[vcu_][r]; if (id == 0xFFFF) break; i = (15 - id / PER_QB) * PER_QB + id % PER_QB; }
        else { i = r * F.G + ((r & 1) ? F.G - 1 - vcu_ : vcu_); if (i >= NU) break; }
        const int qb = 15 - i / PER_QB, j = i % PER_QB, P0 = qb * 256;
        if (j < ND) {
            const int b = j / (DIFF_H * 2), vh = j % (DIFF_H * 2), h = vh >> 1, mp = vh & 1;
            const bf16* base = PROJ + (size_t)(b * T) * DINM;
            fa::unit<false, 2>(F.lds + RING_OFF, base + O_DQ + h * 256 + mp * 128, base + O_DK + h * 256 + mp * 128, base + O_DV + h * 256,
                               DIFFO + (size_t)(b * T) * (DIFF_H * 512) + (h * 2 + mp) * 256, DINM, DINM, DINM, DIFF_H * 512, P0, tab + h * 2 + mp, nullptr, 0, wave_);
        } else {
            const int jj = j - ND, b = jj / MOBA_H, h = jj % MOBA_H;
            const bf16* base = PROJ + (size_t)(b * T) * DINM;
            fa::unit<true, 1>(F.lds + RING_OFF, base + O_MQ + h * HD, base + O_MK + h * HD, base + O_MV + h * HD, Y + (size_t)(b * T) * DM + 1536 + h * HD, DINM, DINM, DINM, DM, P0,
                              tab + 12 + h, MMASK + (size_t)(b * T) * MOBA_H + h, MOBA_H, wave_);
        }
    }
}
__device__ __forceinline__ void post_phase(Frame& F, int l) {
    const int lane = lane_now();
    const int wv_ = WAVE(F), gw = VCU(F) * NWAVES + wv_, NGW = F.G * NWAVES;
    const bf16* DIFFO = (const bf16*)(WSL(F) + WS_DIFFO); bf16* Y = (bf16*)(WSL(F) + WS_Y);
    const float* lv = karg(5) + (size_t)l * 512; const float* sg = karg(6) + (size_t)l * 256;
    const float e1 = wave_sum(lv[lane] * lv[128 + lane] + lv[64 + lane] * lv[192 + lane]), e2 = wave_sum(lv[256 + lane] * lv[384 + lane] + lv[320 + lane] * lv[448 + lane]);
    const float li = lambda_init_of(l), lam = expf(e1) - expf(e2) + li;
    const f32x4 g = *(const GAS f32x4*)(sg + lane * 4);
    for (int it0 = gw * 4; it0 < M * DIFF_H; it0 += NGW * 4) {
        v2u a[4], c[4];
#pragma unroll
        for (int u = 0; u < 4; ++u) { const int it = it0 + u, m = it / DIFF_H, h = it % DIFF_H; const bf16* p = DIFFO + (size_t)m * (DIFF_H * 512) + h * 512 + lane * 4;
            a[u] = *(const GAS v2u*)p; c[u] = *(const GAS v2u*)(p + 256); }
#pragma unroll
        for (int u = 0; u < 4; ++u) { const int it = it0 + u, m = it / DIFF_H, h = it % DIFF_H;
            const float o0 = bflo(a[u].x) - lam * bflo(c[u].x), o1 = bfhi(a[u].x) - lam * bfhi(c[u].x), o2 = bflo(a[u].y) - lam * bflo(c[u].y), o3 = bfhi(a[u].y) - lam * bfhi(c[u].y);
            const float r = 1.f / sqrtf(wave_sum(o0 * o0 + o1 * o1 + o2 * o2 + o3 * o3) * (1.f / 256.f) + RMS_EPS) * (1.f - li);
            v2u o; o.x = pk2(o0 * r * g.x, o1 * r * g.y); o.y = pk2(o2 * r * g.z, o3 * r * g.w);
            *(GAS v2u*)(Y + (size_t)m * DM + h * 256 + lane * 4) = o; }
    }
}


template <int KK, int NCT>
__device__ __forceinline__ void sg_unit(const bf16* A, int lda, const bf16* B, bf16* C, int ldc, int lane) {
    const int fr = lane & 15, fq = lane >> 4;
    f32x4 acc[2][NCT];
#pragma unroll
    for (int i = 0; i < 2; ++i)
#pragma unroll
        for (int j = 0; j < NCT; ++j) acc[i][j] = (f32x4){0.f, 0.f, 0.f, 0.f};
    const bf16* ap = A + (size_t)fr * lda + 8 * fq; const bf16* bp = B + (size_t)(8 * (fr >> 2) + (fr & 3)) * KK + 8 * fq;
#pragma unroll 4
    for (int ks = 0; ks < KK / 32; ++ks) {
        bf16x8 a[2], b[NCT];
#pragma unroll
        for (int i = 0; i < 2; ++i) a[i] = *(const GAS bf16x8*)(ap + (size_t)i * 16 * lda + ks * 32);
#pragma unroll
        for (int j = 0; j < NCT; ++j) b[j] = *(const GAS bf16x8*)(bp + (size_t)((j >> 1) * 32 + 4 * (j & 1)) * KK + ks * 32);
#pragma unroll
        for (int i = 0; i < 2; ++i)
#pragma unroll
            for (int j = 0; j < NCT; ++j) acc[i][j] = __builtin_amdgcn_mfma_f32_16x16x32_bf16(b[j], a[i], acc[i][j], 0, 0, 0);
    }
#pragma unroll
    for (int i = 0; i < 2; ++i)
#pragma unroll
        for (int jp = 0; jp < NCT / 2; ++jp) { v4u o; o.x = pk2(acc[i][2 * jp][0], acc[i][2 * jp][1]); o.y = pk2(acc[i][2 * jp][2], acc[i][2 * jp][3]);
            o.z = pk2(acc[i][2 * jp + 1][0], acc[i][2 * jp + 1][1]); o.w = pk2(acc[i][2 * jp + 1][2], acc[i][2 * jp + 1][3]);
            *(GAS v4u*)(C + (size_t)(i * 16 + fr) * ldc + jp * 32 + 8 * fq) = o; }
}
__device__ __forceinline__ void qlat_phase(Frame& F, int l) {
    const int lane = lane_now();
    const int gw = VCU(F) * NWAVES + WAVE(F), NGW = F.G * NWAVES;
    const bf16* PROJ = (const bf16*)(WSL(F) + WS_PROJ); const bf16* WUK = (const bf16*)(WSL(F) + WS_WUK) + (size_t)l * DSA_H * KVL * HD; bf16* QLAT = (bf16*)(WSL(F) + WS_QLAT);
    for (int wu = gw; wu < (M / 32) * DSA_H * 4; wu += NGW) { const int tt = wu / (DSA_H * 4), rem = wu % (DSA_H * 4), h = rem >> 2, cg = rem & 3;
        sg_unit<HD, 8>(PROJ + (size_t)(tt * 32) * DINM + O_CQ + h * HD, DINM, WUK + ((size_t)h * KVL + cg * 128) * HD, QLAT + (size_t)(tt * 32) * (DSA_H * KVL) + h * KVL + cg * 128, DSA_H * KVL, lane); }
}
__device__ __forceinline__ void dsa_out_phase(Frame& F, int l) {
    const int lane = lane_now();
    const int gw = VCU(F) * NWAVES + WAVE(F), NGW = F.G * NWAVES;
    const bf16* OLAT = (const bf16*)(WSL(F) + WS_OLAT); const bf16* WUVT = (const bf16*)(WSL(F) + WS_WUVT) + (size_t)l * DSA_H * HD * KVL; bf16* Y = (bf16*)(WSL(F) + WS_Y);
    for (int wu = gw; wu < (M / 32) * DSA_H * 2; wu += NGW) { const int tt = wu / (DSA_H * 2), rem = wu % (DSA_H * 2), h = rem >> 1, cg = rem & 1;
        sg_unit<KVL, 4>(OLAT + (size_t)(tt * 32) * (DSA_H * KVL) + h * KVL, DSA_H * KVL, WUVT + ((size_t)h * HD + cg * 64) * KVL, Y + (size_t)(tt * 32) * DM + 2816 + h * HD + cg * 64, DM, lane); }
}

typedef short v4i16_t __attribute__((ext_vector_type(4)));
namespace dsa {
constexpr int G = 4;
constexpr int KT = 256, KSTR = 144;
constexpr int NB1 = 1024;
constexpr int SZ_KI = KT * KSTR, OFF_KI = 0, OFF_SC = 2 * SZ_KI, OFF_HIST = OFF_SC + G * 16384, OFF_SEL = OFF_HIST + G * NB1 * 4, OFF_CNT = OFF_SEL + G * 512  , CNT_W = 64  , LDS_END = OFF_CNT + G * CNT_W * 4;
static_assert(LDS_END <= RING_BYTES, "dsa select LDS map");
__device__ __forceinline__ unsigned fkey(float f) { const unsigned u = __float_as_uint(f); return (u & 0x80000000u) ? ~u : (u | 0x80000000u); }
__device__ __forceinline__ int crow(int r, int hi) { return (r & 3) + 8 * (r >> 2) + 4 * hi; }
}
__device__ __forceinline__ void dsa_select_phase(Frame& F) {
    using namespace dsa;
    const int lane = lane_now(), w = WAVE(F), tid = w * 64 + lane, g = w >> 1, par = w & 1, r32 = lane & 31, hi = lane >> 5;
    LAS unsigned char* L = F.lds + RING_OFF;
    LAS float* sc = (LAS float*)(L + OFF_SC) + g * 4096; LAS unsigned* hist = (LAS unsigned*)(L + OFF_HIST) + g * NB1;
    LAS unsigned* bmp = (LAS unsigned*)(L + OFF_SEL) + g * 128; LAS unsigned* cnt = (LAS unsigned*)(L + OFF_CNT) + g * CNT_W;
    LAS unsigned* cnt_all = (LAS unsigned*)(L + OFF_CNT);
    const bf16* PROJ = (const bf16*)(WSL(F) + WS_PROJ); const bf16* KI = (const bf16*)(WSL(F) + WS_KI); const float* WI = (const float*)(WSL(F) + WS_WI); unsigned short* SEL = (unsigned short*)(WSL(F) + WS_SEL);
    constexpr int NGRP = M / G; const int vcu_ = VCU(F);
    for (int rr = 0;; ++rr) {
        const int i = rr * F.G + ((rr & 1) ? F.G - 1 - vcu_ : vcu_); if (i >= NGRP) break;
        const int b = i & 1, t0 = T - G - G * (i >> 1), t = t0 + g; const size_t row = (size_t)b * T + t;
        if (t0 + G - 1 < 256) {
            if (par == 0) { const unsigned e = lane * 4; v2u o; o.x = e | ((e + 1) << 16); o.y = (e + 2) | ((e + 3) << 16); *(GAS v2u*)(SEL + row * 256 + lane * 4) = o; }
            continue; }
        bf16x8 aq[4]; float wv[16];
#pragma unroll
        for (int ks = 0; ks < 4; ++ks) aq[ks] = *(const GAS bf16x8*)(PROJ + row * DINM + O_IQ + r32 * IDX_D + 16 * ks + 8 * hi);
#pragma unroll
        for (int r = 0; r < 16; ++r) wv[r] = WI[row * IDX_H + crow(r, hi)];
        const int ntile = (t0 + G - 1) / KT + 1;
        const bf16* kib = KI + (size_t)b * T * IDX_D;
        v4u sa0, sa1, sa2, sa3, sb0, sb1, sb2, sb3;
        const int p0k = tid >> 3, p0c = tid & 7;
#define DS_LOAD(R, tl) do { const bf16* s_ = kib + (size_t)((tl) * KT + p0k) * IDX_D + p0c * 8; R##0 = *(const GAS v4u*)s_; R##1 = *(const GAS v4u*)(s_ + 64 * IDX_D); R##2 = *(const GAS v4u*)(s_ + 128 * IDX_D); R##3 = *(const GAS v4u*)(s_ + 192 * IDX_D); } while (0)
#define DS_WRITE(R, bf) do { LAS unsigned char* d_ = L + OFF_KI + (bf) * SZ_KI + p0k * KSTR + p0c * 16; *(LAS v4u*)d_ = R##0; *(LAS v4u*)(d_ + 64 * KSTR) = R##1; *(LAS v4u*)(d_ + 128 * KSTR) = R##2; *(LAS v4u*)(d_ + 192 * KSTR) = R##3; } while (0)
        __syncthreads();
        if (tid < G * CNT_W) cnt_all[tid] = 0u;
        ((LAS unsigned*)(L + OFF_SEL))[tid] = 0u;
        DS_LOAD(sa, 0); if (ntile > 1) DS_LOAD(sb, 1);
        DS_WRITE(sa, 0);
        __syncthreads();
        float smin = 3.0e38f, smax = -3.0e38f;
#define DS_MF(ACC, sb_) do { ACC = (f32x16){}; _Pragma("unroll") for (int ks = 0; ks < 4; ++ks) ACC = __builtin_amdgcn_mfma_f32_32x32x16_bf16(aq[ks], kf[sb_][ks], ACC, 0, 0, 0); } while (0)
#define DS_EP(ACC, sb_, tl) do { const int key = (tl) * KT + (par + 2 * (sb_)) * 32 + r32; float s = 0.f; \
            _Pragma("unroll") for (int r = 0; r < 16; ++r) { const int ai_ = __float_as_int(ACC[r]); s += wv[r] * __int_as_float(ai_ > 0 ? ai_ : 0); }   \
            { auto rr = __builtin_amdgcn_permlane32_swap(__float_as_uint(s), __float_as_uint(s), false, false); s = __uint_as_float(rr[0]) + __uint_as_float(rr[1]); } \
            if (hi == 0 && key <= t) { sc[key] = s; smin = fminf(smin, s); smax = fmaxf(smax, s); } } while (0)
#define DS_STEP(tl, RL, RW) do { const int bufi = (tl) & 1; \
            if ((tl) + 2 < ntile) DS_LOAD(RL, (tl) + 2); \
            { const unsigned kbase = (unsigned)(size_t)(L + OFF_KI + bufi * SZ_KI + (par * 32 + r32) * KSTR + 16 * hi); \
              bf16x8 kf[4][4]; \
              _Pragma("unroll") for (int sb_ = 0; sb_ < 4; ++sb_) \
                  _Pragma("unroll") for (int ks = 0; ks < 4; ++ks) asm volatile("ds_read_b128 %0, %1 offset:%2" : "=v"(kf[sb_][ks]) : "v"(kbase), "i"(sb_ * 64 * KSTR + ks * 32) : "memory"); \
                \
              f32x16 accA, accB; \
              asm volatile("s_waitcnt lgkmcnt(12)" ::: "memory"); __builtin_amdgcn_sched_barrier(0); DS_MF(accA, 0); __builtin_amdgcn_sched_barrier(0); \
              asm volatile("s_waitcnt lgkmcnt(8)" ::: "memory"); __builtin_amdgcn_sched_barrier(0); DS_MF(accB, 1); __builtin_amdgcn_sched_barrier(0); \
              DS_EP(accA, 0, tl); __builtin_amdgcn_sched_barrier(0); \
              asm volatile("s_waitcnt lgkmcnt(4)" ::: "memory"); __builtin_amdgcn_sched_barrier(0); DS_MF(accA, 2); __builtin_amdgcn_sched_barrier(0); \
              DS_EP(accB, 1, tl); __builtin_amdgcn_sched_barrier(0); \
              asm volatile("s_waitcnt lgkmcnt(0)" ::: "memory"); __builtin_amdgcn_sched_barrier(0); DS_MF(accB, 3); __builtin_amdgcn_sched_barrier(0); \
              DS_EP(accA, 2, tl); __builtin_amdgcn_sched_barrier(0); \
              DS_EP(accB, 3, tl); } \
            if ((tl) + 1 < ntile) DS_WRITE(RW, bufi ^ 1); \
            asm volatile("s_waitcnt lgkmcnt(0)" ::: "memory"); __builtin_amdgcn_s_barrier(); asm volatile("" ::: "memory");   } while (0)
        for (int tl = 0; tl < ntile; tl += 2) { DS_STEP(tl, sa, sb); if (tl + 1 < ntile) DS_STEP(tl + 1, sb, sa); }
#undef DS_STEP
#undef DS_MF
#undef DS_EP
#undef DS_LOAD
#undef DS_WRITE
#ifndef REP_SELSTAGE
#define REP_SELSTAGE 1
#endif
        for (int rep_ = 0; rep_ < REP_SELSTAGE; ++rep_) {
        if (rep_) { __syncthreads(); if (tid < G * CNT_W) cnt_all[tid] = 0u; __syncthreads(); }
#pragma unroll
        for (int o = 1; o < 64; o <<= 1) { smin = fminf(smin, __shfl_xor(smin, o)); smax = fmaxf(smax, __shfl_xor(smax, o)); }
        if (lane == 0) { cnt[4 + 2 * par] = __float_as_uint(smin); cnt[5 + 2 * par] = __float_as_uint(smax); }
        for (int e = tid; e < G * NB1; e += NWAVES * 64) ((LAS unsigned*)(L + OFF_HIST))[e] = 0u;
        __syncthreads();
        const float lo = fminf(__uint_as_float(cnt[4]), __uint_as_float(cnt[6])), hi_ = fmaxf(__uint_as_float(cnt[5]), __uint_as_float(cnt[7]));
        const float bscale = hi_ > lo ? ((float)NB1 - 0.5f) / (hi_ - lo) : 0.f;
        const int n = t + 1;
        for (int e0 = par * 64 + lane; e0 < n; e0 += 512) {
            float sv_[4];
#pragma unroll
            for (int u = 0; u < 4; ++u) sv_[u] = sc[(e0 + 128 * u) & 4095];
#pragma unroll
            for (int u = 0; u < 4; ++u) if (e0 + 128 * u < n) { int bin = (int)((sv_[u] - lo) * bscale); bin = bin > NB1 - 1 ? NB1 - 1 : bin;
                __hip_atomic_fetch_add(&hist[bin], 1u, __ATOMIC_RELAXED, __HIP_MEMORY_SCOPE_WORKGROUP); } }
        __syncthreads();
        int B1, need; unsigned hB1;
        { unsigned hh[16]; unsigned tot = 0;
#pragma unroll
          for (int q = 0; q < 4; ++q) { const v4u v = *(const LAS v4u*)&hist[16 * lane + 4 * q]; hh[4 * q] = v.x; hh[4 * q + 1] = v.y; hh[4 * q + 2] = v.z; hh[4 * q + 3] = v.w; tot += v.x + v.y + v.z + v.w; }
          unsigned suf = tot;
#pragma unroll
          for (int o = 1; o < 64; o <<= 1) { const unsigned v = __shfl_down(suf, o); if (lane + o < 64) suf += v; }
          const unsigned long long bal = __ballot(suf >= 256u);
          const int ls = 63 - __builtin_clzll(bal | 1ull);
          unsigned cum = suf - tot; int bb = 0; unsigned cg = 0, hb = 0; bool found = false;
#pragma unroll
          for (int q = 15; q >= 0; --q) { if (!found) { if (cum + hh[q] >= 256u) { bb = q; cg = cum; hb = hh[q]; found = true; } else cum += hh[q]; } }
          B1 = 16 * ls + __shfl(bb, ls); need = 256 - (int)__shfl(cg, ls); hB1 = __shfl(hb, ls); }
        if (lane == 0 && par == 0) { unsigned z_ = 0u; asm volatile("" : "+v"(z_)); cnt[2] = ~z_; cnt[3] = z_; }
        __syncthreads();
        LAS unsigned short* cand = (LAS unsigned short*)(cnt + 8);
        { unsigned kmn = 0xFFFFFFFFu, kmx = 0u;
          for (int e0 = par * 64 + lane; e0 < n; e0 += 512) { float sv_[4];
#pragma unroll
            for (int u = 0; u < 4; ++u) sv_[u] = sc[(e0 + 128 * u) & 4095];
#pragma unroll
            for (int u = 0; u < 4; ++u) { const int e = e0 + 128 * u; if (e < n) { const float s = sv_[u]; int bin = (int)((s - lo) * bscale); bin = bin > NB1 - 1 ? NB1 - 1 : bin;
              if (bin > B1) __hip_atomic_fetch_or(&bmp[e >> 5], 1u << (e & 31), __ATOMIC_RELAXED, __HIP_MEMORY_SCOPE_WORKGROUP);
              else if (bin == B1) { const unsigned pos = __hip_atomic_fetch_add(&cnt[0], 1u, __ATOMIC_RELAXED, __HIP_MEMORY_SCOPE_WORKGROUP); if (pos < 64u) cand[pos] = (unsigned short)e;
                  const unsigned k = fkey(s); kmn = k < kmn ? k : kmn; kmx = k > kmx ? k : kmx; } } } }
          if (hB1 > 64u) {
#pragma unroll
              for (int o = 1; o < 64; o <<= 1) { const unsigned a = __shfl_xor(kmn, o), c2 = __shfl_xor(kmx, o); kmn = a < kmn ? a : kmn; kmx = c2 > kmx ? c2 : kmx; }
              if (lane == 0) { __hip_atomic_fetch_min(&cnt[2], kmn, __ATOMIC_RELAXED, __HIP_MEMORY_SCOPE_WORKGROUP); __hip_atomic_fetch_max(&cnt[3], kmx, __ATOMIC_RELAXED, __HIP_MEMORY_SCOPE_WORKGROUP); } } }
        if (lane == 0 && par == 0) cnt[1] = hB1 > 64u ? 0u : 1u;
        for (int e = tid; e < G * NB1; e += NWAVES * 64) ((LAS unsigned*)(L + OFF_HIST))[e] = 0u;
        __syncthreads();
        if (hB1 <= 64u) {
            if (par == 0) { const int nc = (int)hB1; const int me = lane < nc ? (int)cand[lane] : 0; const unsigned mk = lane < nc ? fkey(sc[me]) : 0u; int rank = 0;
                for (int jn = 0; jn < nc; ++jn) { const int oe = __builtin_amdgcn_readlane(me, jn); const unsigned ok = (unsigned)__builtin_amdgcn_readlane((int)mk, jn); rank += (ok > mk || (ok == mk && oe < me)) ? 1 : 0; }
                if (lane < nc && rank < need) __hip_atomic_fetch_or(&bmp[me >> 5], 1u << (me & 31), __ATOMIC_RELAXED, __HIP_MEMORY_SCOPE_WORKGROUP); } }
        const bool any_fb = (cnt_all[1] + cnt_all[CNT_W + 1] + cnt_all[2 * CNT_W + 1] + cnt_all[3 * CNT_W + 1]) != (unsigned)G;
        if (any_fb) {
        unsigned kmin = cnt[2], kmax = cnt[3];
        bool done = hB1 <= 64u;
        for (int lev = 0; lev < 4; ++lev) {
            const unsigned width = kmax - kmin; const int bits = 32 - __builtin_clz(width | 1u);
            int sh = bits - 8; if (sh < 0) sh = 0;
            if (!done) for (int e = par * 64 + lane; e < n; e += 128) { const unsigned k = fkey(sc[e]); if (k >= kmin && k <= kmax) __hip_atomic_fetch_add(&hist[(k - kmin) >> sh], 1u, __ATOMIC_RELAXED, __HIP_MEMORY_SCOPE_WORKGROUP); }
            __syncthreads();
            unsigned B = 0, cgt = 0, hB = 0;
            if (!done) {
                const unsigned h0 = hist[4 * lane], h1 = hist[4 * lane + 1], h2 = hist[4 * lane + 2], h3 = hist[4 * lane + 3];
                unsigned suf = h0 + h1 + h2 + h3;
#pragma unroll
                for (int o = 1; o < 64; o <<= 1) { const unsigned v = __shfl_down(suf, o); if (lane + o < 64) suf += v; }
                const unsigned long long bal = __ballot(suf >= (unsigned)need);
                const int ls = 63 - __builtin_clzll(bal | 1ull);
                unsigned cum = suf - (h0 + h1 + h2 + h3), bb = 0, cg = 0, hb = 0;
                if (cum + h3 >= (unsigned)need) { bb = 3; cg = cum; hb = h3; }
                else if (cum + h3 + h2 >= (unsigned)need) { bb = 2; cg = cum + h3; hb = h2; }
                else if (cum + h3 + h2 + h1 >= (unsigned)need) { bb = 1; cg = cum + h3 + h2; hb = h1; }
                else { bb = 0; cg = cum + h3 + h2 + h1; hb = h0; }
                B = 4 * ls + __shfl(bb, ls); cgt = __shfl(cg, ls); hB = __shfl(hb, ls);
            }
            __syncthreads();
            if (!done) {
                const bool all_b = (cgt + hB == (unsigned)need);
                const bool ties = !all_b && sh == 0;
                for (int e = par * 64 + lane; e < n; e += 128) { const unsigned k = fkey(sc[e]);
                    if (k >= kmin && k <= kmax) { const unsigned bin = (k - kmin) >> sh;
                        if (bin > B || (all_b && bin == B)) { __hip_atomic_fetch_or(&bmp[e >> 5], 1u << (e & 31), __ATOMIC_RELAXED, __HIP_MEMORY_SCOPE_WORKGROUP); } } }
                if (ties) { if (par == 0) { int left = need - (int)cgt; const unsigned kk = kmin + B;
                        for (int e0 = 0; e0 < n && left > 0; e0 += 64) { const int e = e0 + lane; const bool eq = e < n && fkey(sc[e]) == kk;
                            const unsigned long long bq = __ballot(eq); const int before = __popcll(bq & ((1ull << lane) - 1ull));
                            if (eq && before < left) { __hip_atomic_fetch_or(&bmp[e >> 5], 1u << (e & 31), __ATOMIC_RELAXED, __HIP_MEMORY_SCOPE_WORKGROUP); }
                            left -= __popcll(bq); } }
                    done = true; }
                else if (all_b) done = true;
                else { need -= (int)cgt; const unsigned long long lo2 = (unsigned long long)kmin + ((unsigned long long)B << sh), hi2 = lo2 + ((1ull << sh) - 1ull);
                    kmin = (unsigned)lo2; kmax = hi2 < (unsigned long long)kmax ? (unsigned)hi2 : kmax; }
            }
            if (lane == 0 && par == 0) cnt[1] = done ? 1u : 0u;
            for (int e = tid; e < G * NB1; e += NWAVES * 64) ((LAS unsigned*)(L + OFF_HIST))[e] = 0u;
            __syncthreads();
            if (cnt_all[1] + cnt_all[CNT_W + 1] + cnt_all[2 * CNT_W + 1] + cnt_all[3 * CNT_W + 1] == (unsigned)G) break;
        }
        }
        __syncthreads();
        if (par == 0) {
            unsigned w0 = bmp[2 * lane], w1 = bmp[2 * lane + 1]; const int c = __popc(w0) + __popc(w1); int pre = c;
#pragma unroll
            for (int o = 1; o < 64; o <<= 1) { const int v = __shfl_up(pre, o); if (lane >= o) pre += v; }
            int pos = pre - c; unsigned short* so = SEL + row * 256;
            while (w0) { const int bb = __builtin_ctz(w0); w0 &= w0 - 1u; if (pos < 256) so[pos] = (unsigned short)(lane * 64 + bb); ++pos; }
            while (w1) { const int bb = __builtin_ctz(w1); w1 &= w1 - 1u; if (pos < 256) so[pos] = (unsigned short)(lane * 64 + 32 + bb); ++pos; }
        }
        }
    }
}
#ifndef DA_GRP
#define DA_GRP 2
#endif
#ifndef REP_GATHER
#define REP_GATHER 1
#endif
constexpr int DA_XOFF = 131072, DA_SOFF = DA_XOFF + 8192;
constexpr int DA_BOFF = DA_SOFF + 2048;
static_assert(DA_BOFF + 8192 <= RING_BYTES, "dsa attention LDS map");
__device__ __forceinline__ void dsa_attn_phase(Frame& F, int hot = 0) {
    const int lane = lane_now(), w = WAVE(F), tid = w * 64 + lane, g = w >> 1, half = w & 1, fr = lane & 15, fq = lane >> 4;
    LAS unsigned char* cbuf = F.lds + RING_OFF + g * 32768; LAS unsigned char* xb = F.lds + RING_OFF + DA_XOFF + g * 2048;
    const bf16* CKVN = (const bf16*)(WSL(F) + WS_CKVN); const bf16* QLAT = (const bf16*)(WSL(F) + WS_QLAT); const unsigned short* SEL = (const unsigned short*)(WSL(F) + WS_SEL);
    bf16* OLAT = (bf16*)(WSL(F) + WS_OLAT); const float* tab = karg(3);
    const int hh = fr < DSA_H ? fr : DSA_H - 1;
    constexpr float LOG2E = 1.4426950408889634f;
    const int q4 = (lane >> 2) & 3, p4 = lane & 3, keyl = 4 * fq + q4;
    LAS float* btab = (LAS float*)(F.lds + RING_OFF + DA_BOFF);
    for (int e = tid; e < 128 * 16; e += NWAVES * 64) { const int d = e >> 4, h_ = e & 15; btab[e] = tab[bucket(d) * 32 + 22 + (h_ < DSA_H ? h_ : DSA_H - 1)] * LOG2E; }
    const int vcu_ = VCU(F), per_x = F.G >= 8 ? F.G / 8 : 1, xcd = vcu_ / per_x, jx = vcu_ % per_x, nxb = F.G >= 8 ? 4 : F.G;
    for (int r8 = 0;; ++r8) {
        int b, t0;
        if (F.G >= 8 && F.G % 8 == 0) { const int gi = r8 * (nxb * per_x) + (xcd >> 1) * per_x + jx; if (gi >= T / 4) break; b = xcd & 1; t0 = T - 4 - 4 * gi; }
        else { const int gi = r8 * F.G + vcu_; if (gi >= M / 4) break; b = gi & 1; t0 = T - 4 - 4 * (gi >> 1); }
        const int t = t0 + g, q = b * T + t, nsel = t + 1 < 256 ? t + 1 : 256;
        const int nmax = ((t0 + 4 < 256 ? t0 + 4 : 256) + 15) >> 4;
        bf16x8 ql[8];
#pragma unroll
        for (int ks = 0; ks < 8; ++ks) ql[ks] = __builtin_nontemporal_load((const GAS bf16x8*)(QLAT + (size_t)q * (DSA_H * KVL) + hh * KVL + half * 256 + 32 * ks + 8 * fq));
        f32x4 O[16];
#pragma unroll
        for (int ct = 0; ct < 16; ++ct) O[ct] = (f32x4){0.f, 0.f, 0.f, 0.f};
        float m_run = -1e30f, l_run = 0.f;
        const bf16* cb = CKVN + (size_t)b * T * KVL;
        const LAS unsigned short* srow = (const LAS unsigned short*)(F.lds + RING_OFF + DA_SOFF + g * 512);
        v2u selw; if (half == 0) selw = *(const GAS v2u*)(SEL + (size_t)q * 256 + lane * 4);
#define DA_RD128(dst, addr, off) asm volatile("ds_read_b128 %0, %1 offset:%2" : "=v"(dst) : "v"(addr), "i"(off) : "memory")
#define DA_RDTR(dst, addr, off) asm volatile("ds_read_b64_tr_b16 %0, %1 offset:%2" : "=v"(dst) : "v"(addr), "i"(off) : "memory")
#define DA_ISSUE_K(sv_, bf_, k0_, k1_) do { _Pragma("unroll") for (int k = (k0_); k < (k1_); ++k) { const int slot_ = half * 8 + k; const int idx_ = __builtin_amdgcn_readlane(sv_, slot_); \
        _Pragma("unroll") for (int rg_ = 0; rg_ < REP_GATHER; ++rg_) __builtin_amdgcn_global_load_lds((const GAS unsigned*)(cb + (size_t)idx_ * KVL + ((lane ^ slot_) & 63) * 8), (LAS unsigned*)(cbuf + (bf_) * 16384 + slot_ * 1024), 16, 0, 0); } } while (0)
#define DA_ISSUE(sv_, bf_) DA_ISSUE_K(sv_, bf_, 0, 8)
#define DA_NEXT(k0_) do { __builtin_amdgcn_sched_barrier(0); if (more) DA_ISSUE_K(selv, cur ^ 1, k0_, (k0_) + DA_GRP); __builtin_amdgcn_sched_barrier(0); } while (0)
        __syncthreads();
        if (half == 0) *(LAS v2u*)(F.lds + RING_OFF + DA_SOFF + g * 512 + lane * 8) = selw;
        __syncthreads();
        int selv = fr < nsel ? (int)srow[fr] : 0; if (hot) selv &= 255;
        DA_ISSUE(selv, 0);
        for (int c = 0; c < nmax; ++c) {
            const int cur = c & 1;
            asm volatile("s_waitcnt vmcnt(0)" ::: "memory");
            __builtin_amdgcn_s_barrier();
            asm volatile("" ::: "memory"); __builtin_amdgcn_sched_barrier(0);
            const bool more = c + 1 < nmax;
            if (more) { const int slot = (c + 1) * 16 + fr; selv = slot < nsel ? (int)srow[slot] : 0; if (hot) selv &= 255; }
            DA_NEXT(0);
            const LAS unsigned char* buf = cbuf + cur * 16384;
            f32x4 s4 = (f32x4){0.f, 0.f, 0.f, 0.f};
            { bf16x8 af[8];
#pragma unroll
              for (int i4 = 0; i4 < 4; ++i4) { const unsigned sa = (unsigned)(size_t)(buf + fr * 1024 + half * 512 + (((4 * i4 + fq) ^ fr) << 4));
                  DA_RD128(af[i4], sa, 0); DA_RD128(af[4 + i4], sa, 256); }
              asm volatile("s_waitcnt lgkmcnt(0)" ::: "memory"); __builtin_amdgcn_sched_barrier(0);
#pragma unroll
              for (int ks = 0; ks < 8; ++ks) s4 = __builtin_amdgcn_mfma_f32_16x16x32_bf16(af[ks], ql[ks], s4, 0, 0, 0); }
            DA_NEXT(DA_GRP);
            *(LAS f32x4*)(xb + half * 1024 + lane * 16) = s4;
            asm volatile("s_waitcnt lgkmcnt(0)" ::: "memory");
            __builtin_amdgcn_s_barrier();
            asm volatile("" ::: "memory"); __builtin_amdgcn_sched_barrier(0);
            DA_NEXT(2 * DA_GRP);
            s4 = s4 + *(const LAS f32x4*)(xb + (half ^ 1) * 1024 + lane * 16);
            float sv[4]; float cmax = -__builtin_inff();
#pragma unroll
            for (int r = 0; r < 4; ++r) { const int ks_ = 4 * fq + r; const bool valid = c * 16 + ks_ < nsel; const int idx = valid ? (int)srow[c * 16 + ks_] : 0;
                int dist = t - idx; dist = dist > 127 ? 127 : dist; const float bias = btab[dist * 16 + fr];
                sv[r] = valid ? s4[r] * (SCALE * LOG2E) + bias : -__builtin_inff(); cmax = fmaxf(cmax, sv[r]); }
            { auto r1 = __builtin_amdgcn_permlane16_swap(__float_as_uint(cmax), __float_as_uint(cmax), false, false); cmax = fmaxf(__uint_as_float(r1[0]), __uint_as_float(r1[1]));
              auto r2 = __builtin_amdgcn_permlane32_swap(__float_as_uint(cmax), __float_as_uint(cmax), false, false); cmax = fmaxf(__uint_as_float(r2[0]), __uint_as_float(r2[1])); }
            const bool grow = __any(cmax - m_run > 10.f);
            const float m_new = grow ? fmaxf(m_run, cmax) : m_run, alpha = grow ? __builtin_amdgcn_exp2f(m_run - m_new) : 1.f;
            float p[4], ps = 0.f;
#pragma unroll
            for (int r = 0; r < 4; ++r) { p[r] = __builtin_amdgcn_exp2f(sv[r] - m_new); ps += p[r]; }
            { auto r1 = __builtin_amdgcn_permlane16_swap(__float_as_uint(ps), __float_as_uint(ps), false, false); ps = __uint_as_float(r1[0]) + __uint_as_float(r1[1]);
              auto r2 = __builtin_amdgcn_permlane32_swap(__float_as_uint(ps), __float_as_uint(ps), false, false); ps = __uint_as_float(r2[0]) + __uint_as_float(r2[1]); }
            l_run = l_run * alpha + ps; m_run = m_new;
            if (grow) { float ar[4];
#pragma unroll
                for (int r = 0; r < 4; ++r) ar[r] = __shfl(alpha, 4 * fq + r);
#pragma unroll
                for (int ct = 0; ct < 16; ++ct)
#pragma unroll
                    for (int r = 0; r < 4; ++r) O[ct][r] *= ar[r]; }
            DA_NEXT(3 * DA_GRP);
            v2u pw; pw.x = pk2(p[0], p[1]); pw.y = pk2(p[2], p[3]);
            const s16x4 pa = __builtin_bit_cast(s16x4, pw);
            { const unsigned rb = (unsigned)(size_t)(buf + keyl * 1024 + half * 512 + (p4 & 1) * 8); s16x4 bvv[16];
#pragma unroll
              for (int i8 = 0; i8 < 8; ++i8) { const unsigned ad = rb + (((2 * i8 + (p4 >> 1)) ^ keyl) << 4);
                  DA_RDTR(bvv[i8], ad, 0); DA_RDTR(bvv[8 + i8], ad, 256); }
              asm volatile("s_waitcnt lgkmcnt(0)" ::: "memory"); __builtin_amdgcn_sched_barrier(0);
#pragma unroll
              for (int ct = 0; ct < 16; ++ct) O[ct] = __builtin_amdgcn_mfma_f32_16x16x16bf16_1k(pa, bvv[ct], O[ct], 0, 0, 0); }
        }
#undef DA_ISSUE
#undef DA_ISSUE_K
#undef DA_NEXT
#undef DA_RD128
#undef DA_RDTR
        float rl[4];
#pragma unroll
        for (int r = 0; r < 4; ++r) rl[r] = 1.f / __shfl(l_run, 4 * fq + r);
        { LAS unsigned char* stg = cbuf + (nmax & 1) * 16384 + half * 8192;
          LAS unsigned char* wb = stg + (4 * fq * 256 + fr) * 2;
#pragma unroll
          for (int r = 0; r < 4; ++r) if (4 * fq + r < DSA_H) {
#pragma unroll
              for (int ct = 0; ct < 16; ++ct) *(LAS unsigned short*)(wb + r * 512 + ct * 32) = (unsigned short)f2bf(O[ct][r] * rl[r]); }
          asm volatile("s_waitcnt lgkmcnt(0)" ::: "memory");
#pragma unroll
          for (int i5 = 0; i5 < 5; ++i5) { const int e = i5 * 512 + lane * 8, hd = e >> 8, col = e & 255;
              __builtin_nontemporal_store(*(const LAS v4u*)(stg + i5 * 1024 + lane * 16), (GAS v4u*)(OLAT + (size_t)q * (DSA_H * KVL) + hd * KVL + half * 256 + col)); } }
    }
}


template <class P> __device__ __forceinline__ P* lnd(P* p) { asm volatile("" : "+s"(p)); return p; }
#ifndef DA_HOT
#define DA_HOT 0
#endif
#ifndef QLAT_GEMM
#define QLAT_GEMM 1
#endif
struct QlatOrder : pg8::StaticOrder { __device__ __forceinline__ int acol(const pg8::Unit& u) const { return (u.pn >> 1) * HD; } };
#ifndef REP_QLAT
#define REP_QLAT 1
#endif
#ifndef REP_FA
#define REP_FA 1
#endif
#ifndef REP_DA
#define REP_DA 1
#endif
#ifndef REP_MS
#define REP_MS 1
#endif
#ifndef REP_TAIL
#define REP_TAIL 1
#endif
#ifndef REP_P0
#define REP_P0 1
#endif
#ifndef REP_PROJ
#define REP_PROJ 1
#endif
#ifndef REP_PREP
#define REP_PREP 1
#endif
#ifndef REP_SEL
#define REP_SEL 1
#endif
#ifndef REP_ATTN
#define REP_ATTN 1
#endif
#ifndef REP_POST
#define REP_POST 1
#endif
#ifndef REP_WO
#define REP_WO 1
#endif
#ifndef REP_LN
#define REP_LN 1
#endif
#ifndef REP_UP
#define REP_UP 1
#endif
#ifndef REP_DN
#define REP_DN 1
#endif
constexpr int PH_PER_LAYER = 10, N_PHASES = 1 + DEPTH * PH_PER_LAYER;
struct Args { const float* in[17]; float* out; unsigned char* ws; int ph_lo, ph_hi, li, pad; };
__global__ void __launch_bounds__(NWAVES * 64, 2) mk_fwd(Args args) {
    extern __shared__ __attribute__((aligned(16))) unsigned char lds[];
    Frame F;
    F.lds = (LAS unsigned char*)lds;
    F.MISC = (volatile LAS unsigned*)(F.lds + MISC_OFF);
    F.wave = __builtin_amdgcn_readfirstlane((int)threadIdx.x >> 6);
    F.G = gridDim.x; { const int bx = blockIdx.x; F.vcu = (F.G % 8 == 0) ? (bx % 8) * (F.G / 8) + bx / 8 : bx; }
    F.ws = args.ws; F.ctl = (gu32*)(args.ws + WS_CTL);
    { for (int u = F.wave * 64 + lane_now(); u < (LDS_BYTES - LDSCTL_OFF) / 4; u += NWAVES * 64) ((LAS unsigned*)(F.lds + LDSCTL_OFF))[u] = 0u; }
    __syncthreads();
    XcdBarrier bar = xcd_barrier_post((unsigned*)(F.ctl + CW_BAR) + args.li * XCD_BAR_WORDS, F.MISC + 8, F.wave);
    const int lo = args.ph_lo, hi = args.ph_hi;
#define IN(k) (lo <= (k) && (k) < hi)
#ifndef REP_BAR
#define REP_BAR 1
#endif
#define SEAM(k) do { if (IN(k) && IN((k) + 1)) { for (int rb_ = 0; rb_ < REP_BAR; ++rb_) xcd_barrier(bar); } } while (0)

#define XN ((bf16*)(WSL(F) + WS_XN))
#define PROJ ((bf16*)(WSL(F) + WS_PROJ))
#define TAIL ((float*)(WSL(F) + WS_TAIL))
#define Y ((bf16*)(WSL(F) + WS_Y))
#define Z ((bf16*)(WSL(F) + WS_Z))
#define HID ((bf16*)(WSL(F) + WS_HID))

    for (int rep_ = 0; rep_ < REP_P0; ++rep_) { if (IN(0)) { p0_prologue(F); }
    SEAM(0); }
    for (int l = 0; l < DEPTH; ++l) {
        const int pb = 1 + l * PH_PER_LAYER;
        for (int rep_ = 0; rep_ < REP_PROJ; ++rep_) { if (IN(pb + 0)) {
            pg8::Gemm g{lnd(XN), lnd(w_layer(F, l, 0)), M, DINM, DM}; pg8::StaticOrder S; S.init(M, DINM, F.G, (int)blockIdx.x);
            pg8::EpiBf16<0> E{lnd(PROJ), DINM};
            pg8::gemm_phase<pg8::EpiBf16<0>, pg8::StaticOrder, PG8_ALIGN, PG8_SP2>(F.lds + RING_OFF, g, S, E, WAVE(F));
            for (int rt_ = 0; rt_ < REP_TAIL; ++rt_) tail_phase(F, lnd(XN), lnd(w_layer(F, l, 0) + (size_t)DINM * DM), lnd(TAIL));
        }
        SEAM(pb + 0); }
        for (int rep_ = 0; rep_ < REP_PREP; ++rep_) { if (IN(pb + 1)) { prep_phase(F, l);
            for (int r2_ = 0; r2_ < REP_QLAT; ++r2_) {
#if QLAT_GEMM
                __syncthreads();
                pg8::Gemm g{lnd((const bf16*)(WSL(F) + WS_PROJ) + O_CQ), lnd((const bf16*)(WSL(F) + WS_WUK) + (size_t)l * DSA_H * KVL * HD), M, DSA_H * KVL, HD, DINM};
                QlatOrder S; S.init(M, DSA_H * KVL, F.G, (int)blockIdx.x);
                pg8::EpiBf16Late E{lnd((bf16*)(WSL(F) + WS_QLAT)), DSA_H * KVL};
                pg8::gemm_phase<pg8::EpiBf16Late, QlatOrder, PG8_ALIGN, PG8_SP2, true>(F.lds + RING_OFF, g, S, E, WAVE(F));
#else
                qlat_phase(F, l);
#endif
            } }
        SEAM(pb + 1); }
        for (int rep_ = 0; rep_ < REP_SEL; ++rep_) { if (IN(pb + 2)) { for (int r2_ = 0; r2_ < REP_MS; ++r2_) moba_select_phase(F); dsa_select_phase(F); }
        SEAM(pb + 2); }
        for (int rep_ = 0; rep_ < REP_ATTN; ++rep_) { if (IN(pb + 3)) { for (int r2_ = 0; r2_ < REP_FA; ++r2_) { attn_phase(F); __syncthreads(); } for (int r2_ = 0; r2_ < REP_DA; ++r2_) { dsa_attn_phase(F, DA_HOT && (r2_ + 1 < REP_DA)); __syncthreads(); } }
        SEAM(pb + 3); }
        for (int rep_ = 0; rep_ < REP_POST; ++rep_) { if (IN(pb + 4)) { post_phase(F, l); dsa_out_phase(F, l); }
        SEAM(pb + 4); }
        for (int rep_ = 0; rep_ < REP_WO; ++rep_) { if (IN(pb + 5)) {
            pg8::Gemm g{lnd(Y), lnd(w_layer(F, l, 1)), M, DM, DM}; pg8::StaticOrder S; S.init(M, DM, F.G, (int)blockIdx.x);
            pg8::EpiResBf16 E{lnd(Z), lnd(XN), DM, ALPHA};
            pg8::gemm_phase<pg8::EpiResBf16, pg8::StaticOrder, PG8_ALIGN, PG8_SP2>(F.lds + RING_OFF, g, S, E, WAVE(F));
        }
        SEAM(pb + 5); }
        for (int rep_ = 0; rep_ < REP_LN; ++rep_) { if (IN(pb + 6)) ln_phase(F, lnd(Z), lnd(karg(11) + (size_t)l * DM), lnd(karg(12) + (size_t)l * DM), nullptr, lnd(XN));
        SEAM(pb + 6); }
        for (int rep_ = 0; rep_ < REP_UP; ++rep_) { if (IN(pb + 7)) {
            pg8::Gemm g{lnd(XN), lnd(w_layer(F, l, 2)), M, DFF, DM}; pg8::StaticOrder S; S.init(M, DFF, F.G, (int)blockIdx.x);
            pg8::EpiBf16<1> E{lnd(HID), DFF};
            pg8::gemm_phase<pg8::EpiBf16<1>, pg8::StaticOrder, PG8_ALIGN, PG8_SP2>(F.lds + RING_OFF, g, S, E, WAVE(F));
        }
        SEAM(pb + 7); }
        for (int rep_ = 0; rep_ < REP_DN; ++rep_) { if (IN(pb + 8)) {
            pg8::Gemm g{lnd(HID), lnd(w_layer(F, l, 3)), M, DM, DFF}; pg8::StaticOrder S; S.init(M, DM, F.G, (int)blockIdx.x);
            pg8::EpiResBf16 E{lnd(Z), lnd(XN), DM, ALPHA};
            pg8::gemm_phase<pg8::EpiResBf16, pg8::StaticOrder, PG8_ALIGN, PG8_SP2>(F.lds + RING_OFF, g, S, E, WAVE(F));
        }
        SEAM(pb + 8); }
        for (int rep_ = 0; rep_ < REP_LN; ++rep_) { if (IN(pb + 9)) { const bool fin = (l == DEPTH - 1); ln_phase(F, lnd(Z), lnd(karg(15) + (size_t)l * DM), lnd(karg(16) + (size_t)l * DM), fin ? lnd((float*)karg(17)) : nullptr, fin ? nullptr : lnd(XN)); }
        SEAM(pb + 9); }
    }
#undef IN
#undef SEAM
#undef XN
#undef PROJ
#undef TAIL
#undef Y
#undef Z
#undef HID
}


extern "C" void kernel_launch(void* const* d_in, const int* in_sizes, int n_in, void* d_out, int out_size, void* d_ws, size_t ws_size, hipStream_t stream) {
    static int grid = 0;
    if (grid == 0) {
        if (n_in != 17 || in_sizes[0] != M * DM || out_size != M * DM || ws_size < WS_END) { fprintf(stderr, "kernel_launch: unexpected shapes / workspace (n_in %d, ws %zu need %zu); nothing launched\n", n_in, ws_size, (size_t)WS_END); grid = -1; return; }
        int dev = 0, cus = 0, per_cu = 0;
        if (hipGetDevice(&dev) != hipSuccess || hipDeviceGetAttribute(&cus, hipDeviceAttributeMultiprocessorCount, dev) != hipSuccess) { grid = -1; return; }
        if (hipFuncSetAttribute((const void*)mk_fwd, hipFuncAttributeMaxDynamicSharedMemorySize, LDS_BYTES) != hipSuccess) { fprintf(stderr, "kernel_launch: hipFuncSetAttribute failed\n"); grid = -1; return; }
        if (hipOccupancyMaxActiveBlocksPerMultiprocessor(&per_cu, (const void*)mk_fwd, NWAVES * 64, LDS_BYTES) != hipSuccess || per_cu < 1)
            fprintf(stderr, "kernel_launch: note: occupancy query reports %d workgroups per CU\n", per_cu);
        (void)hipGetLastError();
        grid = cus;
    }
    if (grid < 0) return;
    (void)hipMemsetAsync((char*)d_ws + WS_CTL, 0, CTL_ZERO_BYTES, stream);
    Args a{};
    for (int i = 0; i < 17; ++i) a.in[i] = (const float*)d_in[i];
    a.out = (float*)d_out; a.ws = (unsigned char*)d_ws; a.ph_lo = 0; a.ph_hi = N_PHASES; a.li = 0; a.pad = 0;
    hipLaunchKernelGGL(mk_fwd, dim3(grid), dim3(NWAVES * 64), LDS_BYTES, stream, a);
    const hipError_t le = hipPeekAtLastError();
    if (le != hipSuccess) fprintf(stderr, "kernel_launch: launch failed: %s\n", hipGetErrorName(le));
}
```

```cpp
#include <hip/hip_runtime.h>
#include <cstdio>
#include <cstdint>
#include <cmath>
namespace pg8 {
#define PG8_LAS __attribute__((address_space(3)))
typedef unsigned short bf16_t;
typedef short bf16x8 __attribute__((ext_vector_type(8)));
typedef float f32x4 __attribute__((ext_vector_type(4)));
typedef unsigned u32x4 __attribute__((ext_vector_type(4)));
constexpr int BM = 256, BK = 64, HALF = 128, HTB = HALF * BK * 2  , STAGE_BYTES = 8 * HTB, NXCD = 8, WGM = 8;

__host__ __device__ __forceinline__ int lds_byte(int r, int c) { const int st = (r >> 4) * 2 + (c >> 5), rr = r & 15, cc = c & 31, ob = rr * 64 + cc * 2; return st * 1024 + (ob ^ (((ob >> 9) & 1) << 5)); }
__host__ __device__ __forceinline__ void stage_rc(int b, int& R, int& C) { const int st = b / 1024, sb = b % 1024, swz = sb ^ (((sb >> 9) & 1) << 5); R = (st >> 1) * 16 + swz / 64; C = (st & 1) * 32 + (swz % 64) / 2; }
__host__ __device__ __forceinline__ int perm32(int rho) { const int n = rho >> 4, i = rho & 15; return 8 * (i >> 2) + 4 * n + (i & 3); }

struct Unit { int pm, pn; };
struct Gemm { const bf16_t* A; const bf16_t* Bt; int M, N, K; int lda; };

struct StaticOrder {
    int nM, nN, nwg, G, c;
    __host__ __device__ void init(int M, int N, int G_, int c_) { nM = M / BM; nN = N / BM; nwg = nM * nN; G = G_; c = c_; }
    __host__ __device__ bool next(int i, Unit& u) const {
        const long L = (long)i * G + c; if (L >= nwg) return false;
        int wgid = (int)L; { const int q = nwg / NXCD, r = nwg % NXCD, xcd = wgid % NXCD, off = wgid / NXCD; wgid = (xcd < r ? xcd * (q + 1) : r * (q + 1) + (xcd - r) * q) + off; }
        const int nig = WGM * nN, gid = wgid / nig, fm = gid * WGM, gsz = (nM - fm) < WGM ? (nM - fm) : WGM;
        u.pm = fm + ((wgid % nig) % gsz); u.pn = (wgid % nig) / gsz; return true;
    }
    __device__ __forceinline__ int acol(const Unit&) const { return 0; }
    __device__ __forceinline__ void a_ready(const Unit&) const {}
    __device__ __forceinline__ void done(const Unit&) const {}
};


__device__ __forceinline__ unsigned cvt_pk_bf16(float lo, float hi) { unsigned r; asm volatile("v_cvt_pk_bf16_f32 %0, %1, %2" : "=v"(r) : "v"(lo), "v"(hi)); return r; }
template <int ACT> struct EpiBf16 {
    static constexpr bool PERM = true, AFTER_DRAIN = false;
    bf16_t* O; int ldc;
    __device__ __forceinline__ void operator()(const f32x4 (&acc)[2][2][4][2], const Unit& u, int wr, int wc, int fr, int fq) const {
        const int row0 = u.pm * BM + wr * 64 + fr, col0 = u.pn * BM + wc * 32 + 8 * fq;
#pragma unroll
        for (int ai = 0; ai < 2; ++ai)
#pragma unroll
            for (int m = 0; m < 4; ++m) { bf16_t* rowp = O + (size_t)(row0 + ai * HALF + m * 16) * ldc + col0;
#pragma unroll
                for (int bj = 0; bj < 2; ++bj) { f32x4 v0 = acc[ai][bj][m][0], v1 = acc[ai][bj][m][1];
                    if (ACT == 1) {
#pragma unroll
                        for (int j = 0; j < 4; ++j) { const float a = fmaxf(v0[j], 0.f), b = fmaxf(v1[j], 0.f); v0[j] = a * a; v1[j] = b * b; } }
                    u32x4 w; w.x = cvt_pk_bf16(v0[0], v0[1]); w.y = cvt_pk_bf16(v0[2], v0[3]); w.z = cvt_pk_bf16(v1[0], v1[1]); w.w = cvt_pk_bf16(v1[2], v1[3]);
                    *(u32x4*)(rowp + bj * HALF) = w; } }
    }
};
struct EpiBf16Late {
    static constexpr bool PERM = true, AFTER_DRAIN = false;
    bf16_t* O; int ldc;
    __device__ __forceinline__ void operator()(const f32x4 (&acc)[2][2][4][2], const Unit& u, int wr, int wc, int, int) const {
        int l_; asm volatile("v_mbcnt_lo_u32_b32 %0, -1, 0\n\tv_mbcnt_hi_u32_b32 %0, -1, %0" : "=v"(l_));
        const int fr = l_ & 15, fq = l_ >> 4;
        const int row0 = u.pm * BM + wr * 64 + fr, col0 = u.pn * BM + wc * 32 + 8 * fq;
#pragma unroll
        for (int ai = 0; ai < 2; ++ai)
#pragma unroll
            for (int m = 0; m < 4; ++m) { bf16_t* rowp = O + (size_t)(row0 + ai * HALF + m * 16) * ldc + col0;
#pragma unroll
                for (int bj = 0; bj < 2; ++bj) { const f32x4 v0 = acc[ai][bj][m][0], v1 = acc[ai][bj][m][1];
                    u32x4 w; w.x = cvt_pk_bf16(v0[0], v0[1]); w.y = cvt_pk_bf16(v0[2], v0[3]); w.z = cvt_pk_bf16(v1[0], v1[1]); w.w = cvt_pk_bf16(v1[2], v1[3]);
                    *(u32x4*)(rowp + bj * HALF) = w; } }
    }
};
struct EpiResBf16 {
    static constexpr bool PERM = true, AFTER_DRAIN = false;
    bf16_t* C; const bf16_t* R; int ldc; float alpha;
    __device__ __forceinline__ void operator()(const f32x4 (&acc)[2][2][4][2], const Unit& u, int wr, int wc, int fr, int fq) const {
        const int row0 = u.pm * BM + wr * 64 + fr, col0 = u.pn * BM + wc * 32 + 8 * fq;
#pragma unroll
        for (int ai = 0; ai < 2; ++ai)
#pragma unroll
            for (int m = 0; m < 4; ++m) { const size_t off = (size_t)(row0 + ai * HALF + m * 16) * ldc + col0;
#pragma unroll
                for (int bj = 0; bj < 2; ++bj) { const u32x4 rv = *(const u32x4*)(R + off + bj * HALF); const f32x4 v0 = acc[ai][bj][m][0], v1 = acc[ai][bj][m][1];
#define PG8_BL(w) __builtin_bit_cast(float, (w) << 16)
#define PG8_BH(w) __builtin_bit_cast(float, (w) & 0xffff0000u)
                    u32x4 w; w.x = cvt_pk_bf16(PG8_BL(rv.x) * alpha + v0[0], PG8_BH(rv.x) * alpha + v0[1]); w.y = cvt_pk_bf16(PG8_BL(rv.y) * alpha + v0[2], PG8_BH(rv.y) * alpha + v0[3]);
                    w.z = cvt_pk_bf16(PG8_BL(rv.z) * alpha + v1[0], PG8_BH(rv.z) * alpha + v1[1]); w.w = cvt_pk_bf16(PG8_BL(rv.w) * alpha + v1[2], PG8_BH(rv.w) * alpha + v1[3]);
#undef PG8_BL
#undef PG8_BH
                    *(u32x4*)(C + off + bj * HALF) = w; } }
    }
};

template <class Epi, class Sched, bool ALIGN_EPI = false, bool SP2 = false, bool GEN = false>
__device__ __forceinline__ void gemm_phase(PG8_LAS unsigned char* lds, const Gemm g, const Sched& S, const Epi& E, int wave_) {
    int lane_; asm volatile("v_mbcnt_lo_u32_b32 %0, -1, 0\n\tv_mbcnt_hi_u32_b32 %0, -1, %0" : "=v"(lane_));
    const int wid = wave_, lane = lane_, tid = wid * 64 + lane, wr = wid >> 2, wc = wid & 3, fr = lane & 15, fq = lane >> 4;
    const int K = g.K, nt = K / BK, lda = GEN ? g.lda : K;
    unsigned voffA[2], voffB[2];
#pragma unroll
    for (int i = 0; i < 2; ++i) { int R, C; stage_rc(tid * 16 + i * 8192, R, C); const int Rb = Epi::PERM ? ((R & ~31) + perm32(R & 31)) : R;
        voffA[i] = (unsigned)(R * lda + C) * 2u; voffB[i] = (unsigned)(Rb * K + C) * 2u; }
    const size_t kstep = (size_t)(BK * 2);
    const size_t hstepB = (size_t)HALF * K * 2, hstepA = (size_t)HALF * lda * 2;
    const size_t tstepB = 2 * hstepB, tstepA = 2 * hstepA;
    const unsigned ldsw = (unsigned)wid * 1024u;
    const int aoff = lds_byte(wr * 64 + fr, fq * 8), boff = lds_byte(wc * 32 + fr, fq * 8);
#define PG8_SA(b, h) (((b) * 2 + (h)) * HTB)
#define PG8_SB(b, h) ((4 + (b) * 2 + (h)) * HTB)
#define PG8_STAGE(bufoff, gbase, voff) do { _Pragma("unroll") for (int _i = 0; _i < 2; ++_i) \
        __builtin_amdgcn_global_load_lds((const unsigned*)((const char*)(gbase) + (voff)[_i]), (PG8_LAS unsigned*)(lds + (bufoff) + ldsw + _i * 8192), 16, 0, 0); } while (0)
#define PG8_LDA(dst, b, h) do { _Pragma("unroll") for (int m = 0; m < 4; ++m) _Pragma("unroll") for (int k = 0; k < 2; ++k) dst[m][k] = *(const PG8_LAS bf16x8*)(lds + PG8_SA(b, h) + aoff + m * 2048 + k * 1024); } while (0)
#define PG8_LDB(dst, b, h) do { _Pragma("unroll") for (int n = 0; n < 2; ++n) _Pragma("unroll") for (int k = 0; k < 2; ++k) dst[n][k] = *(const PG8_LAS bf16x8*)(lds + PG8_SB(b, h) + boff + n * 2048 + k * 1024); } while (0)
#define PG8_MMA(ai, bj, At, Bt) do { __builtin_amdgcn_s_setprio(1); _Pragma("unroll") for (int m = 0; m < 4; ++m) _Pragma("unroll") for (int n = 0; n < 2; ++n) _Pragma("unroll") for (int k = 0; k < 2; ++k) \
        acc[ai][bj][m][n] = __builtin_amdgcn_mfma_f32_16x16x32_bf16(Bt[n][k], At[m][k], acc[ai][bj][m][n], 0, 0, 0); __builtin_amdgcn_s_setprio(0); } while (0)
#define PG8_WAIT_V(n) asm volatile("s_waitcnt vmcnt(" #n ")" ::: "memory")
#define PG8_WAIT_L(n) asm volatile("s_waitcnt lgkmcnt(" #n ")" ::: "memory")
#define PG8_BAR __builtin_amdgcn_s_barrier()
#define PG8_SCHED __builtin_amdgcn_sched_barrier(0)
    Unit cur, nxt; int ui = 0;
    if (!S.next(0, cur)) return;
    f32x4 acc[2][2][4][2];
#pragma unroll
    for (int a = 0; a < 2; ++a)
#pragma unroll
        for (int b = 0; b < 2; ++b)
#pragma unroll
            for (int m = 0; m < 4; ++m)
#pragma unroll
                for (int n = 0; n < 2; ++n) acc[a][b][m][n] = (f32x4){0.f, 0.f, 0.f, 0.f};
    bf16x8 At[4][2], B0[2][2], B1[2][2];
    const char* cA = (const char*)g.A + (size_t)cur.pm * tstepA + (GEN ? S.acol(cur) * 2 : 0); const char* cB = (const char*)g.Bt + (size_t)cur.pn * tstepB;
    S.a_ready(cur);
    if constexpr (SP2) {
        PG8_STAGE(PG8_SB(0, 0), cB, voffB); PG8_STAGE(PG8_SB(0, 1), cB + hstepB, voffB); PG8_STAGE(PG8_SA(0, 0), cA, voffA); PG8_STAGE(PG8_SA(0, 1), cA + hstepA, voffA);
        if (wr == 1) PG8_BAR;
        PG8_WAIT_V(2); PG8_BAR;
        PG8_STAGE(PG8_SB(1, 0), cB + kstep, voffB); PG8_STAGE(PG8_SA(1, 0), cA + kstep, voffA); PG8_STAGE(PG8_SB(1, 1), cB + hstepB + kstep, voffB);
        PG8_WAIT_V(6); PG8_BAR;
    } else {
        PG8_STAGE(PG8_SB(0, 0), cB, voffB); PG8_STAGE(PG8_SA(0, 0), cA, voffA); PG8_STAGE(PG8_SB(0, 1), cB + hstepB, voffB); PG8_STAGE(PG8_SA(0, 1), cA + hstepA, voffA);
        if (wr == 1) PG8_BAR;
        PG8_WAIT_V(4); PG8_BAR;
        PG8_STAGE(PG8_SB(1, 0), cB + kstep, voffB); PG8_STAGE(PG8_SA(1, 0), cA + kstep, voffA); PG8_STAGE(PG8_SB(1, 1), cB + hstepB + kstep, voffB);
        PG8_WAIT_V(6); PG8_BAR;
    }
    for (;;) {
        const bool has_next = S.next(ui + 1, nxt);
        const char* nA = has_next ? (const char*)g.A + (size_t)nxt.pm * tstepA + (GEN ? S.acol(nxt) * 2 : 0) : cA; const char* nB = has_next ? (const char*)g.Bt + (size_t)nxt.pn * tstepB : cB;
        for (int t = 0; t < nt; t += 2) {
            const bool last = (t == nt - 2);
            const char* a1 = cA + (size_t)(t + 1) * kstep;
            const char* a2 = last ? nA : cA + (size_t)(t + 2) * kstep; const char* b2 = last ? nB : cB + (size_t)(t + 2) * kstep;
            const char* a3 = a2 + kstep; const char* b3 = b2 + kstep;
            if (last && has_next) S.a_ready(nxt);
            if constexpr (SP2) {
            PG8_LDB(B0, 0, 0); PG8_LDB(B1, 0, 1); PG8_SCHED; PG8_LDA(At, 0, 0); PG8_STAGE(PG8_SA(1, 1), a1 + hstepA, voffA);
            PG8_WAIT_V(8); PG8_WAIT_L(0); PG8_BAR; PG8_MMA(0, 0, At, B0); PG8_MMA(0, 1, At, B1); PG8_BAR; PG8_SCHED;
            PG8_LDA(At, 0, 1); PG8_STAGE(PG8_SB(0, 0), b2, voffB); PG8_STAGE(PG8_SB(0, 1), b2 + hstepB, voffB); PG8_STAGE(PG8_SA(0, 0), a2, voffA);
            PG8_WAIT_V(8); PG8_WAIT_L(0); PG8_BAR; PG8_MMA(1, 0, At, B0); PG8_MMA(1, 1, At, B1); PG8_BAR; PG8_SCHED;
            PG8_LDB(B0, 1, 0); PG8_LDB(B1, 1, 1); PG8_SCHED; PG8_LDA(At, 1, 0); PG8_STAGE(PG8_SA(0, 1), a2 + hstepA, voffA);
            PG8_WAIT_V(8); PG8_WAIT_L(0); PG8_BAR; PG8_MMA(0, 0, At, B0); PG8_MMA(0, 1, At, B1); PG8_BAR; PG8_SCHED;
            PG8_LDA(At, 1, 1); PG8_STAGE(PG8_SB(1, 0), b3, voffB); PG8_STAGE(PG8_SB(1, 1), b3 + hstepB, voffB); PG8_STAGE(PG8_SA(1, 0), a3, voffA);
            PG8_WAIT_V(8); PG8_WAIT_L(0); PG8_BAR; PG8_MMA(1, 0, At, B0); PG8_MMA(1, 1, At, B1); PG8_BAR; PG8_SCHED;
            } else {
            PG8_LDB(B0, 0, 0); PG8_SCHED; PG8_LDA(At, 0, 0); PG8_STAGE(PG8_SA(1, 1), a1 + hstepA, voffA);
            PG8_WAIT_L(8); PG8_BAR; PG8_WAIT_L(0); PG8_MMA(0, 0, At, B0); PG8_BAR; PG8_SCHED;
            PG8_LDB(B1, 0, 1); PG8_STAGE(PG8_SB(0, 0), b2, voffB);
            PG8_BAR; PG8_WAIT_L(0); PG8_MMA(0, 1, At, B1); PG8_BAR;
            PG8_LDA(At, 0, 1); PG8_STAGE(PG8_SA(0, 0), a2, voffA);
            PG8_BAR; PG8_WAIT_L(0); PG8_MMA(1, 0, At, B0); PG8_BAR; PG8_SCHED;
            PG8_STAGE(PG8_SB(0, 1), b2 + hstepB, voffB);
            PG8_WAIT_V(6); PG8_BAR; PG8_MMA(1, 1, At, B1); PG8_BAR;
            PG8_LDB(B0, 1, 0); PG8_SCHED; PG8_LDA(At, 1, 0); PG8_STAGE(PG8_SA(0, 1), a2 + hstepA, voffA);
            PG8_WAIT_L(8); PG8_BAR; PG8_WAIT_L(0); PG8_MMA(0, 0, At, B0); PG8_BAR; PG8_SCHED;
            PG8_LDB(B1, 1, 1); PG8_STAGE(PG8_SB(1, 0), b3, voffB);
            PG8_BAR; PG8_WAIT_L(0); PG8_MMA(0, 1, At, B1); PG8_BAR;
            PG8_LDA(At, 1, 1); PG8_STAGE(PG8_SA(1, 0), a3, voffA);
            PG8_BAR; PG8_WAIT_L(0); PG8_MMA(1, 0, At, B0); PG8_BAR; PG8_SCHED;
            PG8_STAGE(PG8_SB(1, 1), b3 + hstepB, voffB);
            PG8_WAIT_V(6); PG8_BAR; PG8_MMA(1, 1, At, B1); PG8_BAR;
            }
        }
        if constexpr (ALIGN_EPI) { if (wr == 0) PG8_BAR; }
        if constexpr (!Epi::AFTER_DRAIN) { E(acc, cur, wr, wc, fr, fq); S.done(cur); }
        if (!has_next) break;
#pragma unroll
        for (int a = 0; a < 2; ++a)
#pragma unroll
            for (int b = 0; b < 2; ++b)
#pragma unroll
                for (int m = 0; m < 4; ++m)
#pragma unroll
                    for (int n = 0; n < 2; ++n) acc[a][b][m][n] = (f32x4){0.f, 0.f, 0.f, 0.f};
        cur = nxt; cA = nA; cB = nB; ++ui;
        if constexpr (ALIGN_EPI) { if (wr == 1) PG8_BAR; }
    }
    PG8_WAIT_V(0);
    if constexpr (!ALIGN_EPI) { if (wr == 0) PG8_BAR; }
    PG8_BAR;
    if constexpr (Epi::AFTER_DRAIN) { E.fused(acc, cur, wr, wc, fr, fq, lds, wid, lane); S.done(cur); }
#undef PG8_SA
#undef PG8_SB
#undef PG8_STAGE
#undef PG8_LDA
#undef PG8_LDB
#undef PG8_MMA
#undef PG8_WAIT_V
#undef PG8_WAIT_L
#undef PG8_BAR
#undef PG8_SCHED
}
}


#ifndef PG8_SP2
#define PG8_SP2 true
#endif
#ifndef PG8_ALIGN
#define PG8_ALIGN true
#endif
constexpr int NB = 2, T = 4096, DM = 4096, M = NB * T, DEPTH = 2, HD = 128;
constexpr int DIFF_H = 6, MOBA_H = 10, DSA_H = 10, KVL = 512, IDX_H = 32, IDX_D = 64, DFF = 16384, DIN = 12384, DINM = 12288, NTAIL = 96;
constexpr int O_DQ = 0, O_DK = 1536, O_DV = 3072, O_MQ = 4608, O_MK = 5888, O_MV = 7168, O_CQ = 8448, O_CKV = 9728, O_IQ = 10240, O_IK = 12288, O_IW = 12352;
constexpr float ALPHA = 1.4142135623730951f;
constexpr float LN_EPS = 1e-5f, RMS_EPS = 1e-5f, NEG_INF = -1e30f;
constexpr float SCALE = 0.08838834764831845f;
constexpr int NWAVES = 8;

constexpr size_t MiB = 1u << 20;
constexpr size_t WS_CTL = 0, CTL_ZERO_BYTES = 1 * MiB;
constexpr size_t SZ_WIN = 97 * MiB, SZ_WO = 32 * MiB, SZ_WUP = 128 * MiB, SZ_WDN = 128 * MiB, SZ_WL = SZ_WIN + SZ_WO + SZ_WUP + SZ_WDN;
constexpr size_t WS_W = 1 * MiB;
constexpr size_t WS_WUK = WS_W + 2 * SZ_WL;
constexpr size_t WS_WUVT = WS_WUK + 3 * MiB;
constexpr size_t WS_H = WS_WUVT + 3 * MiB;
constexpr size_t WS_WUVB = WS_H;
constexpr size_t WS_XN = WS_H + 128 * MiB;
constexpr size_t WS_PROJ = WS_XN + 64 * MiB;
constexpr size_t WS_TAIL = WS_PROJ + 192 * MiB;
constexpr size_t WS_Y = WS_TAIL + 3 * MiB;
constexpr size_t WS_Z = WS_Y + 64 * MiB;
constexpr size_t WS_HID = WS_Z + 128 * MiB;
constexpr size_t WS_QLAT = WS_HID + 256 * MiB;
constexpr size_t WS_OLAT = WS_QLAT + 80 * MiB;
constexpr size_t WS_DIFFO = WS_OLAT + 80 * MiB;
constexpr size_t WS_CKVN = WS_DIFFO + 48 * MiB;
constexpr size_t WS_KI = WS_CKVN + 8 * MiB;
constexpr size_t WS_WI = WS_KI + 1 * MiB;
constexpr size_t WS_KMEAN = WS_WI + 1 * MiB;
constexpr size_t WS_MMASK = WS_KMEAN + 1 * MiB;
constexpr size_t WS_SEL = WS_MMASK + 1 * MiB;
constexpr size_t WS_END = WS_SEL + 4 * MiB;
static_assert(WS_END <= (size_t)2047 * MiB, "d_ws map must fit 4x the largest tensor (2048 MiB)");
constexpr int CW_TMO = 0, CW_CODE = 1;
constexpr int CW_BAR = 4096;
constexpr int MAX_LAUNCHES = 40;

constexpr int RING_OFF = 0, RING_BYTES = 159744;
constexpr int LDSCTL_OFF = RING_BYTES, MISC_OFF = LDSCTL_OFF + 320;
constexpr int LDS_BYTES = 163840;
static_assert(MISC_OFF + 128 <= LDS_BYTES, "LDS map");

#define GAS __attribute__((address_space(1)))
#define LAS __attribute__((address_space(3)))
typedef unsigned short bf16;
typedef unsigned v4u __attribute__((ext_vector_type(4)));
typedef unsigned v2u __attribute__((ext_vector_type(2)));
typedef float f32x4 __attribute__((ext_vector_type(4)));
typedef float f32x16 __attribute__((ext_vector_type(16)));
typedef short bf16x8 __attribute__((ext_vector_type(8)));
typedef short s16x4 __attribute__((ext_vector_type(4)));
typedef GAS unsigned gu32;
typedef GAS unsigned long long gu64;
#define RLX_AGENT __ATOMIC_RELAXED, __HIP_MEMORY_SCOPE_AGENT
#define LDS_WAIT() asm volatile("s_waitcnt lgkmcnt(0)" ::: "memory")
#define VM_WAIT() asm volatile("s_waitcnt vmcnt(0)" ::: "memory")
__device__ __forceinline__ unsigned f2bf(float f) { unsigned u = __builtin_bit_cast(unsigned, f); return (u + 0x7fffu + ((u >> 16) & 1u)) >> 16; }
__device__ __forceinline__ unsigned pk2(float lo, float hi) { return f2bf(lo) | (f2bf(hi) << 16); }
__device__ __forceinline__ float bf2f(unsigned short b) { return __builtin_bit_cast(float, (unsigned)b << 16); }
__device__ __forceinline__ float bflo(unsigned w) { return __builtin_bit_cast(float, w << 16); }
__device__ __forceinline__ float bfhi(unsigned w) { return __builtin_bit_cast(float, w & 0xffff0000u); }

__device__ __forceinline__ int lane_now() { int l; asm volatile("v_mbcnt_lo_u32_b32 %0, -1, 0\n\tv_mbcnt_hi_u32_b32 %0, -1, %0" : "=v"(l)); return l; }
__constant__ unsigned char c_bucket[128] = {0, 1, 2, 3, 4, 5, 6, 7, 8, 9, 10, 11, 12, 13, 14, 15, 16, 16, 16, 17, 17, 18, 18, 18, 19, 19, 19, 20, 20, 20, 20, 21, 21, 21, 21, 22, 22, 22, 22, 22, 23, 23, 23, 23, 23, 23, 24, 24, 24, 24, 24, 24, 25, 25, 25, 25, 25, 25, 25, 26, 26, 26, 26, 26, 26, 26, 26, 27, 27, 27, 27, 27, 27, 27, 27, 27, 27, 28, 28, 28, 28, 28, 28, 28, 28, 28, 28, 29, 29, 29, 29, 29, 29, 29, 29, 29, 29, 29, 29, 30, 30, 30, 30, 30, 30, 30, 30, 30, 30, 30, 30, 30, 30, 31, 31, 31, 31, 31, 31, 31, 31, 31, 31, 31, 31, 31, 31, 31};
__device__ __forceinline__ int bucket(int dist) { return dist < 0 ? 0 : (dist > 127 ? 31 : (int)c_bucket[dist]); }


#define XB_TMO      128
#define XB_XCNT(j)  (256  + 64 * (j))
#define XB_XSUB(j)  (1280 + 64 * (j))
#define XB_XGEN(j)  (2304 + 64 * (j))
#define XB_TOP      3328
#define XB_TOPGEN   3392
#define XCD_BAR_WORDS 3456
#define XB_SPIN_CAP (1u << 18)

__device__ __forceinline__ unsigned xb_ld(unsigned* p)              { return __hip_atomic_load(p, __ATOMIC_RELAXED, __HIP_MEMORY_SCOPE_AGENT); }
__device__ __forceinline__ unsigned xb_add(unsigned* p, unsigned v) { return __hip_atomic_fetch_add(p, v, __ATOMIC_RELAXED, __HIP_MEMORY_SCOPE_AGENT); }
__device__ __forceinline__ unsigned xb_xcc_id() { return (unsigned)__builtin_amdgcn_s_getreg((3 << 11) | 20) & 0xFu; }
#define XB_SPIN(cond, bar) do { unsigned _sp = 0; while (cond) { __builtin_amdgcn_s_sleep(1); \
    if ((++_sp & 255u) == 0u) { if (xb_ld(&(bar)[XB_TMO])) break; if (_sp > XB_SPIN_CAP) { atomicAdd(&(bar)[XB_TMO], 1u); break; } } } } while (0)

struct XcdBarrier {
    unsigned* bar; unsigned x;
    int wave;
    volatile LAS unsigned* st;
};

__device__ __forceinline__ XcdBarrier xcd_barrier_post(unsigned* bar, volatile LAS unsigned* st, int wave) {
    XcdBarrier b; b.bar = bar; b.x = xb_xcc_id(); b.st = st; b.wave = wave;
    if (wave == 0 && lane_now() == 0) (void)xb_add(&bar[XB_XCNT(b.x)], 1u);
    return b;
}
__device__ __forceinline__ void xcd_barrier_complete(unsigned* bar, unsigned x, unsigned& nloc, unsigned& nx) {
    const unsigned G = gridDim.x * gridDim.y * gridDim.z;
    unsigned sum, cnt, mine, sp = 0u;
    for (;;) {
        sum = 0u; cnt = 0u; mine = 0u;
#pragma unroll
        for (unsigned j = 0; j < 16; ++j) { const unsigned c = xb_ld(&bar[XB_XCNT(j)]); sum += c; cnt += (c > 0u) ? 1u : 0u; mine = (j == x) ? c : mine; }
        if (sum == G) break;
        __builtin_amdgcn_s_sleep(1);
        if ((++sp & 255u) == 0u) { if (xb_ld(&bar[XB_TMO])) break; if (sp > XB_SPIN_CAP) { atomicAdd(&bar[XB_TMO], 1u); break; } }
    }
    nloc = mine > 0u ? mine : 1u; nx = cnt > 0u ? cnt : 1u;
}

__device__ __forceinline__ void xcd_barrier(const XcdBarrier& b) {
    asm volatile("s_waitcnt vmcnt(0)" ::: "memory");
    __syncthreads();
    if (b.wave == 0 && lane_now() == 0) {
        unsigned* bar = b.bar;
        __builtin_amdgcn_s_waitcnt(0);
        unsigned nloc = b.st[0], nx = b.st[1];
        if (nloc == 0u) { xcd_barrier_complete(bar, b.x, nloc, nx); b.st[0] = nloc; b.st[1] = nx; }
        const unsigned old = xb_add(&bar[XB_XSUB(b.x)], 1u);
        const unsigned gen = old / nloc;
        if (old + 1u == (gen + 1u) * nloc) {
            __builtin_amdgcn_fence(__ATOMIC_RELEASE, "agent");
            asm volatile("s_waitcnt vmcnt(0)" ::: "memory");
            const unsigned og = xb_add(&bar[XB_TOP], 1u);
            const unsigned tg = og / nx;
            if (og + 1u == (tg + 1u) * nx) xb_add(&bar[XB_TOPGEN], 1u);
            else XB_SPIN(xb_ld(&bar[XB_TOPGEN]) == tg, bar);
            __builtin_amdgcn_fence(__ATOMIC_ACQUIRE, "agent");
            xb_add(&bar[XB_XGEN(b.x)], 1u);
            asm volatile("s_waitcnt vmcnt(0)" ::: "memory");
        } else {
            XB_SPIN(xb_ld(&bar[XB_XGEN(b.x)]) == gen, bar);
            __builtin_amdgcn_fence(__ATOMIC_ACQUIRE, "agent");
            asm volatile("s_waitcnt vmcnt(0)" ::: "memory");
        }
    }
    __syncthreads();
}


struct Frame {
    LAS unsigned char* lds;
    volatile LAS unsigned* MISC;
    gu32* ctl;
    int wave;
    int vcu, G;
    unsigned char* ws;
};
#define WSL(F) ws_opaque((F).ws)
#define WAVE(F) int_opaque((F).wave)
#define VCU(F) int_opaque((F).vcu)
__device__ __forceinline__ int int_opaque(int v) { asm volatile("" : "+s"(v)); return v; }
__device__ __forceinline__ unsigned char* ws_opaque(unsigned char* p) { asm volatile("" : "+s"(p)); return p; }
typedef const __attribute__((address_space(4))) char* kseg_t;
__device__ __forceinline__ const float* karg(int i) { kseg_t ka = (kseg_t)__builtin_amdgcn_kernarg_segment_ptr(); asm volatile("" : "+s"(ka)); return *(const float* const __attribute__((address_space(4)))*)(ka + 8 * i); }
__device__ __forceinline__ float wave_sum(float v) {
    v += __builtin_bit_cast(float, __builtin_amdgcn_mov_dpp(__builtin_bit_cast(int, v), 0xB1, 0xF, 0xF, true));
    v += __builtin_bit_cast(float, __builtin_amdgcn_mov_dpp(__builtin_bit_cast(int, v), 0x4E, 0xF, 0xF, true));
    v += __builtin_bit_cast(float, __builtin_amdgcn_mov_dpp(__builtin_bit_cast(int, v), 0x141, 0xF, 0xF, true));
    v += __builtin_bit_cast(float, __builtin_amdgcn_mov_dpp(__builtin_bit_cast(int, v), 0x140, 0xF, 0xF, true));
    { auto r = __builtin_amdgcn_permlane16_swap(__float_as_uint(v), __float_as_uint(v), false, false); v = __uint_as_float(r[0]) + __uint_as_float(r[1]); }
    { auto r = __builtin_amdgcn_permlane32_swap(__float_as_uint(v), __float_as_uint(v), false, false); v = __uint_as_float(r[0]) + __uint_as_float(r[1]); }
    return v;
}
#ifndef P0_KFAST
#define P0_KFAST 1
#endif
#ifndef P0_GS8
#define P0_GS8 8
#define P0_GS9 9
#endif
__device__ __forceinline__ void p0_transpose_item(const float* W, int K, int N, bf16* WT, int ldt, LAS float* scr, int item, int lane) {
#if P0_KFAST
    const int nblk = N / 32, KB = K / 64, GS = (nblk % 8 == 0) ? P0_GS8 : (nblk % 9 == 0) ? P0_GS9 : nblk, grp = item / GS, kb = grp % KB, nb = (grp / KB) * GS + item % GS, k0 = 64 * kb, n0 = 32 * nb;
#else
    const int nblk = N / 32, kb = item / nblk, nb = item % nblk, k0 = 64 * kb, n0 = 32 * nb;
#endif
    float wv[32];
#pragma unroll
    for (int i = 0; i < 32; ++i) wv[i] = __builtin_nontemporal_load(W + (size_t)(k0 + 2 * i + (lane >> 5)) * N + n0 + (lane & 31));
#pragma unroll
    for (int i = 0; i < 32; ++i) scr[(2 * i + (lane >> 5)) * 33 + (lane & 31)] = wv[i];
    LDS_WAIT(); asm volatile("" ::: "memory");
    const int c = lane & 7;
#pragma unroll
    for (int j = 0; j < 4; ++j) { const int n = (lane >> 3) + 8 * j; const LAS float* s = scr + (8 * c) * 33 + n;
        v4u o; o.x = pk2(s[0 * 33], s[1 * 33]); o.y = pk2(s[2 * 33], s[3 * 33]); o.z = pk2(s[4 * 33], s[5 * 33]); o.w = pk2(s[6 * 33], s[7 * 33]);
        __builtin_nontemporal_store(o, (GAS v4u*)(WT + (size_t)(n0 + n) * ldt + k0 + 8 * c)); }
    LDS_WAIT(); asm volatile("" ::: "memory");
}
template <bool IN_BF16>
__device__ __forceinline__ void ln_row(int lane, const void* zrow, const float* g, const float* b, float* hrow, bf16* xrow) {
    f32x4 v[16]; float s = 0.f;
    if (IN_BF16) { const GAS v2u* zr = (const GAS v2u*)zrow + lane;
#pragma unroll
        for (int j = 0; j < 16; ++j) { const v2u w = zr[64 * j]; v[j] = (f32x4){bflo(w.x), bfhi(w.x), bflo(w.y), bfhi(w.y)}; s += (v[j].x + v[j].y) + (v[j].z + v[j].w); } }
    else { const GAS f32x4* zr = (const GAS f32x4*)zrow + lane;
#pragma unroll
        for (int j = 0; j < 16; ++j) { v[j] = zr[64 * j]; s += (v[j].x + v[j].y) + (v[j].z + v[j].w); } }
    const float mean = wave_sum(s) * (1.f / DM); float s2 = 0.f;
#pragma unroll
    for (int j = 0; j < 16; ++j) { v[j] = v[j] - mean; s2 += (v[j].x * v[j].x + v[j].y * v[j].y) + (v[j].z * v[j].z + v[j].w * v[j].w); }
    const float rstd = 1.f / sqrtf(wave_sum(s2) * (1.f / DM) + LN_EPS);
    const GAS f32x4* gr = (const GAS f32x4*)g + lane; const GAS f32x4* br = (const GAS f32x4*)b + lane;
#pragma unroll
    for (int j = 0; j < 16; ++j) { const f32x4 o = v[j] * rstd * gr[64 * j] + br[64 * j];
        if (hrow) ((GAS f32x4*)hrow + lane)[64 * j] = o;
        if (xrow) ((GAS unsigned long long*)xrow + lane)[64 * j] = (unsigned long long)pk2(o.x, o.y) | ((unsigned long long)pk2(o.z, o.w) << 32); }
}
#ifndef LN_NR
#define LN_NR 4
#endif
template <int NR>
__device__ __forceinline__ void ln_rows(int lane, const bf16* Z, size_t rstride, const float* g, const float* b, float* Fout, bf16* Xout) {
    v2u w[NR][16];
#pragma unroll
    for (int r = 0; r < NR; ++r) { const GAS v2u* zr = (const GAS v2u*)(Z + r * rstride) + lane;
#pragma unroll
        for (int j = 0; j < 16; ++j) w[r][j] = zr[64 * j]; }
    float mean[NR], rstd[NR];
#pragma unroll
    for (int r = 0; r < NR; ++r) { float s = 0.f;
#pragma unroll
        for (int j = 0; j < 16; ++j) s += (bflo(w[r][j].x) + bfhi(w[r][j].x)) + (bflo(w[r][j].y) + bfhi(w[r][j].y));
        mean[r] = s; }
#define LN_OPAQUE() do { _Pragma("unroll") for (int r = 0; r < NR; ++r) _Pragma("unroll") for (int j = 0; j < 16; ++j) asm volatile("" : "+v"(w[r][j].x), "+v"(w[r][j].y)); } while (0)
    LN_OPAQUE();
#pragma unroll
    for (int r = 0; r < NR; ++r) mean[r] = wave_sum(mean[r]) * (1.f / DM);
#pragma unroll
    for (int r = 0; r < NR; ++r) { float q = 0.f; const float mu = mean[r];
#pragma unroll
        for (int j = 0; j < 16; ++j) { const float d0 = bflo(w[r][j].x) - mu, d1 = bfhi(w[r][j].x) - mu, d2 = bflo(w[r][j].y) - mu, d3 = bfhi(w[r][j].y) - mu; q += (d0 * d0 + d1 * d1) + (d2 * d2 + d3 * d3); }
        rstd[r] = q; }
    LN_OPAQUE();
#pragma unroll
    for (int r = 0; r < NR; ++r) rstd[r] = 1.f / sqrtf(wave_sum(rstd[r]) * (1.f / DM) + LN_EPS);
    const GAS f32x4* gr = (const GAS f32x4*)g + lane; const GAS f32x4* br = (const GAS f32x4*)b + lane;
#pragma unroll
    for (int j = 0; j < 16; ++j) { const f32x4 gg = gr[64 * j], bb = br[64 * j];
#pragma unroll
        for (int r = 0; r < NR; ++r) { const float mu = mean[r], rs = rstd[r];
            const f32x4 o = (f32x4){(bflo(w[r][j].x) - mu) * rs, (bfhi(w[r][j].x) - mu) * rs, (bflo(w[r][j].y) - mu) * rs, (bfhi(w[r][j].y) - mu) * rs} * gg + bb;
            if (Fout) ((GAS f32x4*)(Fout + r * rstride) + lane)[64 * j] = o;
            if (Xout) ((GAS unsigned long long*)(Xout + r * rstride) + lane)[64 * j] = (unsigned long long)pk2(o.x, o.y) | ((unsigned long long)pk2(o.z, o.w) << 32); } }
#undef LN_OPAQUE
}
__device__ __forceinline__ bf16* w_layer(Frame& F, int l, int which) {
    const size_t o = WS_W + (size_t)l * SZ_WL + (which == 0 ? 0 : which == 1 ? SZ_WIN : which == 2 ? SZ_WIN + SZ_WO : SZ_WIN + SZ_WO + SZ_WUP);
    return (bf16*)(WSL(F) + o);
}
__device__ __forceinline__ void p0_prologue(Frame& F) {
    const int lane = lane_now();
    const int w_ = WAVE(F); LAS float* scr = (LAS float*)(F.lds + RING_OFF + w_ * 16384);
    const int gw = VCU(F) * NWAVES + w_, NGW = F.G * NWAVES;
    constexpr int I_IN = (DM / 64) * (DIN / 32), I_O = (DM / 64) * (DM / 32), I_UP = (DM / 64) * (DFF / 32), I_DN = (DFF / 64) * (DM / 32), I_UV = (KVL / 64) * (HD / 32) * DSA_H;
    constexpr int PER_L = I_IN + I_O + I_UP + I_DN + I_UV, NITEMS = DEPTH * PER_L;
    for (int it = gw; it < NITEMS; it += NGW) {
        const int l = it / PER_L; int r = it - l * PER_L;
        if (r < I_IN) { p0_transpose_item(karg(4) + (size_t)l * DM * DIN, DM, DIN, w_layer(F, l, 0), DM, scr, r, lane); continue; } r -= I_IN;
        if (r < I_O) { p0_transpose_item(karg(10) + (size_t)l * DM * DM, DM, DM, w_layer(F, l, 1), DM, scr, r, lane); continue; } r -= I_O;
        if (r < I_UP) { p0_transpose_item(karg(13) + (size_t)l * DM * DFF, DM, DFF, w_layer(F, l, 2), DM, scr, r, lane); continue; } r -= I_UP;
        if (r < I_DN) { p0_transpose_item(karg(14) + (size_t)l * DFF * DM, DFF, DM, w_layer(F, l, 3), DFF, scr, r, lane); continue; } r -= I_DN;
        { const int h = r / ((KVL / 64) * (HD / 32)), rr = r % ((KVL / 64) * (HD / 32));
          p0_transpose_item(karg(9) + ((size_t)l * DSA_H + h) * KVL * HD, KVL, HD, (bf16*)(WSL(F) + WS_WUVB) + ((size_t)(l * 5 + (h >> 1)) * 256 + (h & 1) * 128) * 1024 + (h & 1) * 512, 1024, scr, rr, lane); }
    }
    { const v4u z = {0u, 0u, 0u, 0u};
      for (int i = gw * 64 + lane; i < DEPTH * 5 * 2 * HD * (KVL / 8); i += NGW * 64) { const int c8 = i & 63, d = (i >> 6) & 127, e = (i >> 13) & 1, lp = i >> 14;
          *(GAS v4u*)((bf16*)(WSL(F) + WS_WUVB) + ((size_t)lp * 256 + e * 128 + d) * 1024 + (1 - e) * 512 + c8 * 8) = z; } }
    { const GAS f32x4* src = (const GAS f32x4*)karg(8); GAS v2u* dst = (GAS v2u*)(WSL(F) + WS_WUK); const int n4 = DEPTH * DSA_H * KVL * HD / 4;
      for (int i = gw * 64 + lane; i < n4; i += NGW * 64) { const f32x4 v = src[i]; v2u o; o.x = pk2(v.x, v.y); o.y = pk2(v.z, v.w); dst[i] = o; } }
    for (int m = gw; m < M; m += NGW) ln_row<false>(lane, karg(0) + (size_t)m * DM, karg(1), karg(2), nullptr, (bf16*)(WSL(F) + WS_XN) + (size_t)m * DM);
}
__device__ __forceinline__ void tail_phase(Frame& F, const bf16* XN, const bf16* WT, float* TAIL) {
    LAS float* part = (LAS float*)(F.lds + RING_OFF);
    const int lane = lane_now();
    const int w = WAVE(F), fr = lane & 15, fq = lane >> 4;
    for (int unit = VCU(F); unit < M / 32; unit += F.G) {
        const int m0 = unit * 32;
        f32x4 acc[2][6];
#pragma unroll
        for (int i = 0; i < 2; ++i)
#pragma unroll
            for (int j = 0; j < 6; ++j) acc[i][j] = (f32x4){0.f, 0.f, 0.f, 0.f};
        const bf16* ap = XN + (size_t)(m0 + fr) * DM + w * 512 + 8 * fq; const bf16* bp = WT + (size_t)fr * DM + w * 512 + 8 * fq;
#pragma unroll 4
        for (int ks = 0; ks < 16; ++ks) {
            bf16x8 a[2], b[6];
#pragma unroll
            for (int i = 0; i < 2; ++i) a[i] = *(const GAS bf16x8*)(ap + (size_t)i * 16 * DM + ks * 32);
#pragma unroll
            for (int j = 0; j < 6; ++j) b[j] = *(const GAS bf16x8*)(bp + (size_t)j * 16 * DM + ks * 32);
#pragma unroll
            for (int i = 0; i < 2; ++i)
#pragma unroll
                for (int j = 0; j < 6; ++j) acc[i][j] = __builtin_amdgcn_mfma_f32_16x16x32_bf16(a[i], b[j], acc[i][j], 0, 0, 0);
        }
#pragma unroll
        for (int i = 0; i < 2; ++i)
#pragma unroll
            for (int j = 0; j < 6; ++j)
#pragma unroll
                for (int r = 0; r < 4; ++r) part[(w * 32 + i * 16 + fq * 4 + r) * 96 + j * 16 + fr] = acc[i][j][r];
        __syncthreads();
        for (int o = w * 64 + lane; o < 32 * 96; o += NWAVES * 64) { float s = 0.f;
#pragma unroll
            for (int ww = 0; ww < 8; ++ww) s += part[ww * 32 * 96 + o];
            TAIL[(size_t)m0 * 96 + o] = s; }
        __syncthreads();
    }
}
__device__ __forceinline__ void ln_phase(Frame& F, const bf16* Z, const float* g, const float* b, float* Fout, bf16* Xout) {
    const int lane = lane_now();
    const int gw = VCU(F) * NWAVES + WAVE(F), NGW = F.G * NWAVES;
    int m = gw; const size_t rs_ = (size_t)NGW * DM;
    for (; m + (LN_NR - 1) * NGW < M; m += LN_NR * NGW) { const size_t o = (size_t)m * DM; ln_rows<LN_NR>(lane, Z + o, rs_, g, b, Fout ? Fout + o : nullptr, Xout ? Xout + o : nullptr); }
    for (; m < M; m += NGW) ln_row<true>(lane, Z + (size_t)m * DM, g, b, Fout ? Fout + (size_t)m * DM : nullptr, Xout ? Xout + (size_t)m * DM : nullptr);
}

__constant__ unsigned short c_attn_sched[256][4] = {{660,132,65535,65535},{661,133,65535,65535},{662,134,65535,65535},{663,135,65535,65535},{664,136,65535,65535},{665,137,65535,65535},{666,138,65535,65535},{667,139,65535,65535},{668,140,65535,65535},{669,141,65535,65535},{670,142,65535,65535},{671,143,65535,65535},{672,144,65535,65535},{673,145,65535,65535},{674,146,65535,65535},{675,147,65535,65535},{676,148,65535,65535},{677,149,65535,65535},{678,150,65535,65535},{679,151,65535,65535},{680,152,65535,65535},{681,153,65535,65535},{682,154,65535,65535},{683,155,65535,65535},{616,196,65535,65535},{617,197,65535,65535},{618,198,65535,65535},{619,199,65535,65535},{620,288,65535,65535},{621,289,65535,65535},{622,290,65535,65535},{623,291,65535,65535},{624,292,65535,65535},{625,293,65535,65535},{626,294,65535,65535},{627,295,65535,65535},{628,296,65535,65535},{629,297,65535,65535},{630,298,65535,65535},{631,299,65535,65535},{632,300,65535,65535},{633,301,65535,65535},{634,302,65535,65535},{635,303,65535,65535},{636,304,65535,65535},{637,305,65535,65535},{638,306,65535,65535},{639,307,65535,65535},{572,348,65535,65535},{573,349,65535,65535},{574,350,65535,65535},{575,351,65535,65535},{576,176,28,65535},{577,177,29,65535},{578,178,30,65535},{579,179,31,65535},{580,180,32,65535},{581,181,33,65535},{582,182,34,65535},{583,183,35,65535},{584,184,36,65535},{585,185,37,65535},{586,186,38,65535},{587,187,39,65535},{588,188,40,65535},{589,189,41,65535},{590,190,42,65535},{591,191,43,65535},{592,192,65535,65535},{593,193,65535,65535},{594,194,65535,65535},{595,195,65535,65535},{528,388,65535,65535},{529,389,65535,65535},{530,390,65535,65535},{531,391,65535,65535},{532,392,65535,65535},{533,393,65535,65535},{534,394,65535,65535},{535,395,65535,65535},{536,332,12,65535},{537,333,13,65535},{538,334,14,65535},{539,335,15,65535},{540,336,16,65535},{541,337,17,65535},{542,338,18,65535},{543,339,19,65535},{544,340,20,65535},{545,341,21,65535},{546,342,22,65535},{547,343,23,65535},{548,344,24,65535},{549,345,25,65535},{550,346,26,65535},{551,347,27,65535},{484,232,128,65535},{485,233,129,65535},{486,234,130,65535},{487,235,131,65535},{488,236,68,65535},{489,237,69,65535},{490,238,70,65535},{491,239,71,65535},{492,240,72,65535},{493,241,73,65535},{494,242,74,65535},{495,243,75,65535},{496,376,76,65535},{497,377,77,65535},{498,378,78,65535},{499,379,79,65535},{500,380,80,65535},{501,381,81,65535},{502,382,82,65535},{503,383,83,65535},{504,384,84,65535},{505,385,85,65535},{506,386,86,65535},{507,387,87,65535},{440,428,48,65535},{441,429,49,65535},{442,430,50,65535},{443,431,51,65535},{444,432,52,65535},{445,433,53,65535},{446,434,54,65535},{447,435,55,65535},{448,436,56,65535},{449,437,57,65535},{450,438,58,65535},{451,439,59,65535},{452,220,244,65535},{453,221,245,65535},{454,222,246,65535},{455,223,247,65535},{456,224,248,65535},{457,225,249,65535},{458,226,250,65535},{459,227,251,65535},{460,228,252,65535},{461,229,253,65535},{462,230,254,65535},{463,231,255,65535},{684,276,60,65535},{685,277,61,65535},{686,278,62,65535},{687,279,63,65535},{688,280,64,65535},{689,281,65,65535},{690,282,66,65535},{691,283,67,65535},{692,284,112,65535},{693,285,113,65535},{694,286,114,65535},{695,287,115,65535},{696,420,216,65535},{697,421,217,65535},{698,422,218,65535},{699,423,219,65535},{700,424,88,65535},{701,425,89,65535},{702,426,90,65535},{703,427,91,65535},{396,516,0,65535},{397,517,1,65535},{398,518,2,65535},{399,519,3,65535},{400,520,4,65535},{401,521,5,65535},{402,522,6,65535},{403,523,7,65535},{404,524,8,65535},{405,525,9,65535},{406,526,10,65535},{407,527,11,65535},{408,464,92,65535},{409,465,93,65535},{410,466,94,65535},{411,467,95,65535},{412,468,96,65535},{413,469,97,65535},{414,470,98,65535},{415,471,99,65535},{416,472,100,65535},{417,473,101,65535},{418,474,102,65535},{419,475,103,65535},{640,476,104,65535},{641,477,105,65535},{642,478,106,65535},{643,479,107,65535},{644,480,108,65535},{645,481,109,65535},{646,482,110,65535},{647,483,111,65535},{648,264,256,65535},{649,265,257,65535},{650,266,258,65535},{651,267,259,65535},{652,268,260,65535},{653,269,261,65535},{654,270,262,65535},{655,271,263,65535},{656,272,200,65535},{657,273,201,65535},{658,274,202,65535},{659,275,203,65535},{596,320,156,65535},{597,321,157,65535},{598,322,158,65535},{599,323,159,65535},{600,324,160,65535},{601,325,161,65535},{602,326,162,65535},{603,327,163,65535},{604,328,164,65535},{605,329,165,65535},{606,330,166,65535},{607,331,167,65535},{608,508,168,65535},{609,509,169,65535},{610,510,170,65535},{611,511,171,65535},{612,512,172,65535},{613,513,173,65535},{614,514,174,65535},{615,515,175,65535},{352,560,116,65535},{353,561,117,65535},{354,562,118,65535},{355,563,119,65535},{356,564,120,65535},{357,565,121,65535},{358,566,122,65535},{359,567,123,65535},{360,568,124,65535},{361,569,125,65535},{362,570,126,65535},{363,571,127,65535},{364,308,204,65535},{365,309,205,65535},{366,310,206,65535},{367,311,207,65535},{368,312,208,65535},{369,313,209,65535},{370,314,210,65535},{371,315,211,65535},{372,316,212,65535},{373,317,213,65535},{374,318,214,65535},{375,319,215,65535},{552,556,44,65535},{553,557,45,65535},{554,558,46,65535},{555,559,47,65535}};


namespace fa {
constexpr int NW = 8, QBLK = 32, KVBLK = 64, QB = NW * QBLK, D = 128;
constexpr int SHM_V = KVBLK * D * 2, SHM_K = KVBLK * D * 2;
constexpr int NSLOT = 3, SLOT = SHM_K + 2 * SHM_V;
constexpr int OFF_RING = 0, OFF_WS = OFF_RING + NSLOT * SLOT, OFF_BT = OFF_WS + NW * 64 * 4, BT_PAD = 96, BT_N = BT_PAD + 256, LDS_BYTES = OFF_BT + BT_N * 4;
constexpr float THR = 8.f;
#define KSWZ(row, colB) ((row) * 256 + ((colB) ^ (((row) & 7) << 4)))
#define SBAR() __builtin_amdgcn_sched_barrier(0)
__device__ __forceinline__ int v_st(int k, int c) { const int kk = (k & ~0xC) | ((k & 4) << 1) | ((k & 8) >> 1); return ((kk >> 3) * 4 + (c >> 5)) * 512 + ((kk & 7) * 32 + (c & 31)) * 2; }
__device__ __forceinline__ int v_rd_base(int lane) { return ((lane & 3) << 3) | (((lane >> 2) & 3) << 6) | (((lane >> 4) & 1) << 5) | (((lane >> 5) & 1) << 8); }
constexpr int v_rd_off(int d0, int ks, int half) { return d0 * 512 + ks * 4096 + half * 2048; }
__device__ __forceinline__ int crow(int r, int hi) { return (r & 3) + 8 * (r >> 2) + 4 * hi; }
__device__ __forceinline__ unsigned cvtpk(float lo, float hi) { unsigned r; asm volatile("v_cvt_pk_bf16_f32 %0, %1, %2" : "=v"(r) : "v"(lo), "v"(hi)); return r; }

__device__ __forceinline__ void bias_mask_tile(f32x16& p0, f32x16& p1, int dq, const LAS float* bt) {
    const float NEG = -__builtin_inff();
    const LAS float* b = bt + BT_PAD + dq - 59;
#pragma unroll
    for (int r = 0; r < 16; ++r) {
        const int c = (r & 3) + 8 * (r >> 2);
        const float v0 = b[59 - c], v1 = b[59 - c - 32];
        p0[r] = (dq - c) >= 0 ? p0[r] + v0 : NEG;
        p1[r] = (dq - c - 32) >= 0 ? p1[r] + v1 : NEG;
    }
}
__device__ __forceinline__ void partialSM(f32x16& p0, f32x16& p1, float& m_reg, float& alpha, float bc) {
    float pmax = p0[0];
#pragma unroll
    for (int r = 1; r < 16; ++r) pmax = fmaxf(pmax, p0[r]);
#pragma unroll
    for (int r = 0; r < 16; ++r) pmax = fmaxf(pmax, p1[r]);
    { auto rr = __builtin_amdgcn_permlane32_swap(__float_as_uint(pmax), __float_as_uint(pmax), false, false);
      pmax = fmaxf(__uint_as_float(rr[0]), __uint_as_float(rr[1])); }
    pmax += bc;
    constexpr float C2 = 1.4426950408889634f * SCALE;
    float mn;
    if (__builtin_expect(__all((pmax - m_reg) * SCALE <= THR), 1)) { mn = m_reg; alpha = 1.f; }
    else { mn = fmaxf(m_reg, pmax); alpha = __builtin_amdgcn_exp2f((m_reg - mn) * C2); m_reg = mn; }
    const float mnL = (bc - mn) * C2;
#pragma unroll
    for (int r = 0; r < 16; ++r) p0[r] = __builtin_amdgcn_exp2f(fmaf(p0[r], C2, mnL));
#pragma unroll
    for (int r = 0; r < 16; ++r) p1[r] = __builtin_amdgcn_exp2f(fmaf(p1[r], C2, mnL));
}
__device__ __forceinline__ void finishSM(f32x16& p0, f32x16& p1, float alpha, float& l_reg, bf16x8& pa0, bf16x8& pa1, bf16x8& pa2, bf16x8& pa3) {
    float ps = 0;
#pragma unroll
    for (int r = 0; r < 16; ++r) ps += p0[r];
#pragma unroll
    for (int r = 0; r < 16; ++r) ps += p1[r];
    { auto rr = __builtin_amdgcn_permlane32_swap(__float_as_uint(ps), __float_as_uint(ps), false, false);
      ps = __uint_as_float(rr[0]) + __uint_as_float(rr[1]); }
    l_reg = l_reg * alpha + ps;
#define PK4(P, B_, OUT) do { unsigned a0 = cvtpk(P[B_+0], P[B_+1]), a1 = cvtpk(P[B_+2], P[B_+3]);                          \
        unsigned b0 = cvtpk(P[B_+4], P[B_+5]), b1 = cvtpk(P[B_+6], P[B_+7]);                                             \
        auto r0 = __builtin_amdgcn_permlane32_swap(a0, b0, false, false); auto r1 = __builtin_amdgcn_permlane32_swap(a1, b1, false, false); \
        v4u w = {r0[0], r1[0], r0[1], r1[1]}; OUT = __builtin_bit_cast(bf16x8, w); } while (0)
    PK4(p0, 0, pa0); PK4(p0, 8, pa1); PK4(p1, 0, pa2); PK4(p1, 8, pa3);
#undef PK4
}
__device__ __forceinline__ void qkt(f32x16& p0, f32x16& p1, const LAS char* Kb, int r32, int hi, const bf16x8* qr) {
    p0 = f32x16{}; p1 = f32x16{};
    const LAS char* kb[4];
#pragma unroll
    for (int dd = 0; dd < 4; ++dd) kb[dd] = Kb + KSWZ(r32, (dd * 16 + hi * 8) * 2);
#pragma unroll
    for (int d0 = 0; d0 < 8; ++d0) { const LAS char* a = kb[d0 & 3] + (d0 >> 2) * 128;
        const bf16x8 b0 = *(const LAS bf16x8*)a;
        const bf16x8 b1 = *(const LAS bf16x8*)(a + 32 * 256);
        p0 = __builtin_amdgcn_mfma_f32_32x32x16_bf16(b0, qr[d0], p0, 0, 0, 0);
        p1 = __builtin_amdgcn_mfma_f32_32x32x16_bf16(b1, qr[d0], p1, 0, 0, 0); }
}
__device__ __forceinline__ void pv_tile(f32x16* o, int vb0, bf16x8 pa0, bf16x8 pa1, bf16x8 pa2, bf16x8 pa3) {
#define TRRD(dst, off) asm volatile("ds_read_b64_tr_b16 %0, %1 offset:%2" : "=&v"(dst) : "v"(vb0), "i"(off) : "memory")
#define PV_D0(d0) do { s16x4 l0, l1, l2, l3, h0, h1, h2, h3; constexpr int b_ = v_rd_off(d0, 0, 0);   \
        TRRD(l0, b_); TRRD(h0, b_ + 2048); TRRD(l1, b_ + 4096); TRRD(h1, b_ + 6144); TRRD(l2, b_ + 8192); TRRD(h2, b_ + 10240); TRRD(l3, b_ + 12288); TRRD(h3, b_ + 14336); \
        asm volatile("s_waitcnt lgkmcnt(0)" ::: "memory"); SBAR();   \
        o[d0] = __builtin_amdgcn_mfma_f32_32x32x16_bf16(pa0, (bf16x8){l0[0], l0[1], l0[2], l0[3], h0[0], h0[1], h0[2], h0[3]}, o[d0], 0, 0, 0);   \
        o[d0] = __builtin_amdgcn_mfma_f32_32x32x16_bf16(pa1, (bf16x8){l1[0], l1[1], l1[2], l1[3], h1[0], h1[1], h1[2], h1[3]}, o[d0], 0, 0, 0);   \
        o[d0] = __builtin_amdgcn_mfma_f32_32x32x16_bf16(pa2, (bf16x8){l2[0], l2[1], l2[2], l2[3], h2[0], h2[1], h2[2], h2[3]}, o[d0], 0, 0, 0);   \
        o[d0] = __builtin_amdgcn_mfma_f32_32x32x16_bf16(pa3, (bf16x8){l3[0], l3[1], l3[2], l3[3], h3[0], h3[1], h3[2], h3[3]}, o[d0], 0, 0, 0); } while (0)
    PV_D0(0); PV_D0(1); PV_D0(2); PV_D0(3);
#undef PV_D0
#undef TRRD
}

template <bool MOBA, int VW>
__device__ __forceinline__ void unit(LAS unsigned char* lds, const bf16* Q, const bf16* K, const bf16* V, bf16* O, int ldq, int ldk, int ldv, int ldo, int P0,
                                     const float* biascol, const unsigned* mmask, int mstride, int wave) {
    const int wid = wave, lane = lane_now(), tid = wid * 64 + lane, r32 = lane & 31, hi = lane >> 5;
    LAS float* wsf = (LAS float*)(lds + OFF_WS) + wid * 64; LAS float* li_l = wsf; LAS float* al_l = wsf + 32;
    LAS float* bt = (LAS float*)(lds + OFF_BT);
    const float bfar = biascol[31 * 32] * (1.f / SCALE);
    const int NT = (P0 + QB) / KVBLK;
    const int qlo = P0 + wid * QBLK, qm = qlo + r32 - 4 * hi;
    const int own = P0 >> 8;
    unsigned mw = 0u; if (MOBA) mw = mmask[(size_t)(qlo + r32) * mstride];
    float m_reg = -1e30f, l_reg = 0.f; f32x16 o[4 * VW] = {};
    const int vrb = v_rd_base(lane);
    bf16x8 qr[8];
#pragma unroll
    for (int d0 = 0; d0 < 8; ++d0) qr[d0] = *(const GAS bf16x8*)(Q + (size_t)(qlo + r32) * ldq + d0 * 16 + hi * 8);
#define FA_ISSUE(t_) do { const int sl_ = (t_) % NSLOT; const bf16* kt_ = K + (size_t)((t_) * KVBLK) * ldk; const bf16* vt_ = V + (size_t)((t_) * KVBLK) * ldv; \
        int ln_ = lane; asm volatile("" : "+v"(ln_));     \
        _Pragma("unroll") for (int jj = 0; jj < 2; ++jj) { const int j_ = 2 * wid + jj, row_ = 4 * j_ + (ln_ >> 4), ks_ = row_ * ldk + (((ln_ & 15) ^ (row_ & 7)) << 3); \
            const int s_ = 2 * j_ + (ln_ >> 5), kk_ = (s_ >> 2) * 8 + ((ln_ & 31) >> 2), c_ = (s_ & 3) * 32 + (ln_ & 3) * 8, key_ = (kk_ & ~0xC) | ((kk_ & 4) << 1) | ((kk_ & 8) >> 1), vs_ = key_ * ldv + c_; \
            __builtin_amdgcn_global_load_lds((const GAS unsigned*)(kt_ + ks_), (LAS unsigned*)(lds + OFF_RING + sl_ * SLOT + (2 * wid + jj) * 1024), 16, 0, 0); \
            _Pragma("unroll") for (int vh_ = 0; vh_ < VW; ++vh_) __builtin_amdgcn_global_load_lds((const GAS unsigned*)(vt_ + vs_ + vh_ * 128), (LAS unsigned*)(lds + OFF_RING + sl_ * SLOT + SHM_K + vh_ * SHM_V + (2 * wid + jj) * 1024), 16, 0, 0); } } while (0)
    __syncthreads();
    for (int i = tid; i < BT_N; i += NW * 64) { const int d = i - BT_PAD; bt[i] = biascol[bucket(d < 0 ? 0 : d) * 32] * (1.f / SCALE); }
    asm volatile("s_waitcnt vmcnt(0) lgkmcnt(0)" ::: "memory");
    FA_ISSUE(0); if (NT > 1) FA_ISSUE(1);
    for (int t = 0; t < NT; ++t) {
        const int kb = t * KVBLK; const LAS unsigned char* slot = lds + OFF_RING + (t % NSLOT) * SLOT;
        if (t + 1 < NT) { if (VW == 2) asm volatile("s_waitcnt vmcnt(6)" ::: "memory"); else asm volatile("s_waitcnt vmcnt(4)" ::: "memory"); } else asm volatile("s_waitcnt vmcnt(0)" ::: "memory");
        __builtin_amdgcn_s_barrier();
        asm volatile("" ::: "memory"); SBAR();
        if (t + 2 < NT) FA_ISSUE(t + 2);
        if (kb <= qlo + QBLK - 1) {
        f32x16 p0, p1; float alpha; bf16x8 pa0, pa1, pa2, pa3;
        qkt(p0, p1, (const LAS char*)slot, r32, hi, qr);
        const bool near = kb + KVBLK - 1 > qlo - 113;
        float bc = near ? 0.f : bfar;
        if (MOBA) { const int n = kb >> 8; if (n < own && !((mw >> n) & 1u)) bc = -__builtin_inff(); }
        if (near) bias_mask_tile(p0, p1, qm - kb, bt);
        partialSM(p0, p1, m_reg, alpha, bc);
        finishSM(p0, p1, alpha, l_reg, pa0, pa1, pa2, pa3);
        if (__any(alpha < 1.f)) { if (hi == 0) al_l[r32] = alpha; asm volatile("s_waitcnt lgkmcnt(0)" ::: "memory");
#pragma unroll
            for (int d_ = 0; d_ < 4 * VW; ++d_)
#pragma unroll
                for (int r = 0; r < 16; ++r) o[d_][r] *= al_l[crow(r, hi)]; }
        SBAR();
        pv_tile(o, (int)(unsigned)(size_t)(slot + SHM_K) + vrb, pa0, pa1, pa2, pa3);
        if (VW == 2) pv_tile(o + 4, (int)(unsigned)(size_t)(slot + SHM_K + SHM_V) + vrb, pa0, pa1, pa2, pa3);
        }
    }
#undef FA_ISSUE
    if (hi == 0) li_l[r32] = l_reg; asm volatile("s_waitcnt lgkmcnt(0)" ::: "memory");
    bf16* Ow = O + (size_t)qlo * ldo;
#ifndef REP_FAEPI
#define REP_FAEPI 1
#endif
    for (int rep_ = 0; rep_ < REP_FAEPI; ++rep_)
#pragma unroll
    for (int r = 0; r < 16; ++r) { const int orow = crow(r, hi); const float rl = __builtin_amdgcn_rcpf(li_l[orow]);
#pragma unroll
        for (int d0 = 0; d0 < 4 * VW; ++d0) { const float v = o[d0][r] * rl; const float vn = __shfl_xor(v, 1);
            if ((r32 & 1) == 0) *(GAS unsigned*)(Ow + (size_t)orow * ldo + d0 * 32 + r32) = cvtpk(v, vn); } }
}
#undef KSWZ
#undef SBAR
}


__device__ __forceinline__ float lambda_init_of(int l) { return l == 0 ? 0.2f : 0.35550906759096925f; }

__device__ __forceinline__ void prep_phase(Frame& F, int l) {
    const int lane = lane_now();
    const int wv_ = WAVE(F), gw = VCU(F) * NWAVES + wv_, NGW = F.G * NWAVES;
    const bf16* PROJ = (const bf16*)(WSL(F) + WS_PROJ); const float* TAIL = (const float*)(WSL(F) + WS_TAIL);
    bf16* CKVN = (bf16*)(WSL(F) + WS_CKVN); bf16* KI = (bf16*)(WSL(F) + WS_KI); float* WI = (float*)(WSL(F) + WS_WI); float* KMEAN = (float*)(WSL(F) + WS_KMEAN);
    const float* kvg = karg(7) + (size_t)l * KVL;
    const f32x4 g0 = *(const GAS f32x4*)(kvg + lane * 8), g1 = *(const GAS f32x4*)(kvg + lane * 8 + 4);
    for (int m = gw; m < M; m += NGW) {
        const v4u cw = *(const GAS v4u*)(PROJ + (size_t)m * DINM + O_CKV + lane * 8);
        float c[8] = {bflo(cw.x), bfhi(cw.x), bflo(cw.y), bfhi(cw.y), bflo(cw.z), bfhi(cw.z), bflo(cw.w), bfhi(cw.w)};
        float ss = 0.f;
#pragma unroll
        for (int j = 0; j < 8; ++j) ss += c[j] * c[j];
        const float r = 1.f / sqrtf(wave_sum(ss) * (1.f / KVL) + RMS_EPS);
        v4u o; o.x = pk2(c[0] * r * g0.x, c[1] * r * g0.y); o.y = pk2(c[2] * r * g0.z, c[3] * r * g0.w); o.z = pk2(c[4] * r * g1.x, c[5] * r * g1.y); o.w = pk2(c[6] * r * g1.z, c[7] * r * g1.w);
        *(GAS v4u*)(CKVN + (size_t)m * KVL + lane * 8) = o;
        const float kv = TAIL[(size_t)m * NTAIL + lane];
        const float mean = wave_sum(kv) * (1.f / 64.f); const float d = kv - mean;
        const float var = wave_sum(d * d) * (1.f / 64.f);
        KI[(size_t)m * 64 + lane] = (bf16)f2bf(d / sqrtf(var + LN_EPS));
        if (lane < 32) WI[(size_t)m * 32 + lane] = TAIL[(size_t)m * NTAIL + 64 + lane] * (0.17677669529663687f * 0.125f);
    }
    { LAS float* red = (LAS float*)(F.lds + RING_OFF);
      for (int it = VCU(F); it < NB * MOBA_H * 16; it += F.G) {
        const int n = it & 15, bh = it >> 4, b = bh / MOBA_H, h = bh % MOBA_H;
        const bf16* kp = PROJ + (size_t)(b * T + n * 256 + wv_ * 32) * DINM + O_MK + h * HD + 2 * lane; unsigned wq[32];
#pragma unroll
        for (int j = 0; j < 32; ++j) wq[j] = *(const GAS unsigned*)(kp + (size_t)j * DINM);
        float s0 = 0.f, s1 = 0.f;
#pragma unroll
        for (int j = 0; j < 32; ++j) { s0 += bflo(wq[j]); s1 += bfhi(wq[j]); }
        __syncthreads();
        red[wv_ * 128 + 2 * lane] = s0; red[wv_ * 128 + 2 * lane + 1] = s1;
        __syncthreads();
        if (wv_ == 0) { float a0 = 0.f, a1 = 0.f;
#pragma unroll
            for (int ww = 0; ww < 8; ++ww) { a0 += red[ww * 128 + 2 * lane]; a1 += red[ww * 128 + 2 * lane + 1]; }
            KMEAN[(size_t)it * HD + 2 * lane] = a0 * (1.f / 256.f); KMEAN[(size_t)it * HD + 2 * lane + 1] = a1 * (1.f / 256.f); }
      } }
}
__device__ __forceinline__ float quad_sum(float v) {
    v += __builtin_bit_cast(float, __builtin_amdgcn_mov_dpp(__builtin_bit_cast(int, v), 0xB1, 0xF, 0xF, true));
    v += __builtin_bit_cast(float, __builtin_amdgcn_mov_dpp(__builtin_bit_cast(int, v), 0x4E, 0xF, 0xF, true));
    return v;
}
#ifdef MS_CHECK
__device__ __forceinline__ unsigned ms_ref_mask(float g, int own) {
    float v1 = 0.f, v2 = 0.f, v3 = 0.f; int i1 = -1, i2 = -1, i3 = -1;
#pragma unroll
    for (int nn = 0; nn < 15; ++nn) { const float gg = __builtin_bit_cast(float, __builtin_amdgcn_readlane(__builtin_bit_cast(int, g), 4 * nn));
        if (nn < own) {
            if (i1 < 0 || gg > v1) { v3 = v2; i3 = i2; v2 = v1; i2 = i1; v1 = gg; i1 = nn; }
            else if (i2 < 0 || gg > v2) { v3 = v2; i3 = i2; v2 = gg; i2 = nn; }
            else if (i3 < 0 || gg > v3) { v3 = gg; i3 = nn; } } }
    unsigned mask = 0u; if (i1 >= 0) mask |= 1u << i1; if (i2 >= 0) mask |= 1u << i2; if (i3 >= 0) mask |= 1u << i3;
    return mask;
}
#define MS_CHK(g_, mask_, row_) do { if (ms_ref_mask(g_, own) != ((mask_) ^ MS_CHECK_XOR) && lane == 0) ((unsigned short*)(WSL(F) + WS_XN))[(size_t)(row_) * DM] = 0x7FC0; } while (0)
#else
#define MS_CHK(g_, mask_, row_) do { } while (0)
#endif
__device__ __forceinline__ int quads_max(int v) {
    { const int o = __builtin_amdgcn_mov_dpp(v, 0x141, 0xF, 0xF, true); v = v > o ? v : o; }
    { const int o = __builtin_amdgcn_mov_dpp(v, 0x140, 0xF, 0xF, true); v = v > o ? v : o; }
    { auto r = __builtin_amdgcn_permlane16_swap((unsigned)v, (unsigned)v, false, false); const int a = (int)r[0], c = (int)r[1]; v = a > c ? a : c; }
    { auto r = __builtin_amdgcn_permlane32_swap((unsigned)v, (unsigned)v, false, false); const int a = (int)r[0], c = (int)r[1]; v = a > c ? a : c; }
    return v;
}
__device__ __forceinline__ void moba_select_phase(Frame& F) {
    const int lane = lane_now();
    const int wv_ = WAVE(F), gw = VCU(F) * NWAVES + wv_, NGW = F.G * NWAVES, n = lane >> 2, part = lane & 3;
    const bf16* PROJ = (const bf16*)(WSL(F) + WS_PROJ); const float* KMEAN = (const float*)(WSL(F) + WS_KMEAN); unsigned* MMASK = (unsigned*)(WSL(F) + WS_MMASK);
    for (int m4 = gw; m4 < M / 4; m4 += NGW) {
        const int m0 = m4 * 4, b = m0 / T, own = (m0 % T) >> 8;
        f32x4 kmA[8], kmB[8]; v4u qA[4][4], qB[4][4];
#define MS_LOAD(KM, QQ, h_) do { const float* kp_ = KMEAN + ((size_t)((b * MOBA_H + (h_)) * 16 + n)) * HD + part * 32; \
        _Pragma("unroll") for (int i = 0; i < 8; ++i) KM[i] = n < own ? *(const GAS f32x4*)(kp_ + 4 * i) : (f32x4){0.f, 0.f, 0.f, 0.f}; \
        _Pragma("unroll") for (int tk = 0; tk < 4; ++tk) { const bf16* qp_ = PROJ + (size_t)(m0 + tk) * DINM + O_MQ + (h_) * HD + part * 32; \
            _Pragma("unroll") for (int i = 0; i < 4; ++i) QQ[tk][i] = *(const GAS v4u*)(qp_ + 8 * i); } } while (0)
#define MS_HEAD(KM, QQ, h_) do { _Pragma("unroll") for (int tk = 0; tk < 4; ++tk) { float g = 0.f; \
            _Pragma("unroll") for (int i = 0; i < 4; ++i) { const v4u qw = QQ[tk][i]; \
                g += bflo(qw.x) * KM[2 * i].x + bfhi(qw.x) * KM[2 * i].y + bflo(qw.y) * KM[2 * i].z + bfhi(qw.y) * KM[2 * i].w \
                   + bflo(qw.z) * KM[2 * i + 1].x + bfhi(qw.z) * KM[2 * i + 1].y + bflo(qw.w) * KM[2 * i + 1].z + bfhi(qw.w) * KM[2 * i + 1].w; } \
            g = quad_sum(g); \
              \
            int key_ = __builtin_bit_cast(int, g); key_ ^= (key_ >> 31) & 0x7FFFFFFF; bool live_ = n < own; unsigned mask = 0u; \
            _Pragma("unroll") for (int rd_ = 0; rd_ < 3; ++rd_) { const int mx_ = quads_max(live_ ? key_ : (int)0x80000000); \
                const unsigned long long bal_ = __ballot(live_ && key_ == mx_); \
                if (bal_) { const int sel_ = (int)(__builtin_ctzll(bal_) >> 2); mask |= 1u << sel_; live_ = live_ && n != sel_; } } \
            MS_CHK(g, mask, m0 + tk); \
            if (lane == 0) MMASK[(size_t)(m0 + tk) * MOBA_H + (h_)] = mask; } } while (0)
        MS_LOAD(kmA, qA, 0);
        for (int h = 0; h < MOBA_H; h += 2) {
            MS_LOAD(kmB, qB, h + 1);
            MS_HEAD(kmA, qA, h);
            if (h + 2 < MOBA_H) MS_LOAD(kmA, qA, h + 2);
            MS_HEAD(kmB, qB, h + 1);
        }
#undef MS_LOAD
#undef MS_HEAD
#undef MS_CHK
    }
}
__device__ __forceinline__ void attn_phase(Frame& F) {
    const bf16* PROJ = (const bf16*)(WSL(F) + WS_PROJ); bf16* DIFFO = (bf16*)(WSL(F) + WS_DIFFO); bf16* Y = (bf16*)(WSL(F) + WS_Y);
    const unsigned* MMASK = (const unsigned*)(WSL(F) + WS_MMASK); const float* tab = karg(3);
    constexpr int ND = NB * DIFF_H * 2, PER_QB = ND + NB * MOBA_H, NU = 16 * PER_QB;
    const int vcu_ = VCU(F), wave_ = WAVE(F);
    for (int r = 0;; ++r) {
        int i;
        if (F.G == 256) { if (r >= 4) break; const int id = (int)c_attn_sched[vcu_][r]; if (id == 0xFFFF) break; i = (15 - id / PER_QB) * PER_QB + id % PER_QB; }
        else { i = r * F.G + ((r & 1) ? F.G - 1 - vcu_ : vcu_); if (i >= NU) break; }
        const int qb = 15 - i / PER_QB, j = i % PER_QB, P0 = qb * 256;
        if (j < ND) {
            const int b = j / (DIFF_H * 2), vh = j % (DIFF_H * 2), h = vh >> 1, mp = vh & 1;
            const bf16* base = PROJ + (size_t)(b * T) * DINM;
            fa::unit<false, 2>(F.lds + RING_OFF, base + O_DQ + h * 256 + mp * 128, base + O_DK + h * 256 + mp * 128, base + O_DV + h * 256,
                               DIFFO + (size_t)(b * T) * (DIFF_H * 512) + (h * 2 + mp) * 256, DINM, DINM, DINM, DIFF_H * 512, P0, tab + h * 2 + mp, nullptr, 0, wave_);
        } else {
            const int jj = j - ND, b = jj / MOBA_H, h = jj % MOBA_H;
            const bf16* base = PROJ + (size_t)(b * T) * DINM;
            fa::unit<true, 1>(F.lds + RING_OFF, base + O_MQ + h * HD, base + O_MK + h * HD, base + O_MV + h * HD, Y + (size_t)(b * T) * DM + 1536 + h * HD, DINM, DINM, DINM, DM, P0,
                              tab + 12 + h, MMASK + (size_t)(b * T) * MOBA_H + h, MOBA_H, wave_);
        }
    }
}
__device__ __forceinline__ void post_phase(Frame& F, int l) {
    const int lane = lane_now();
    const int wv_ = WAVE(F), gw = VCU(F) * NWAVES + wv_, NGW = F.G * NWAVES;
    const bf16* DIFFO = (const bf16*)(WSL(F) + WS_DIFFO); bf16* Y = (bf16*)(WSL(F) + WS_Y);
    const float* lv = karg(5) + (size_t)l * 512; const float* sg = karg(6) + (size_t)l * 256;
    const float e1 = wave_sum(lv[lane] * lv[128 + lane] + lv[64 + lane] * lv[192 + lane]), e2 = wave_sum(lv[256 + lane] * lv[384 + lane] + lv[320 + lane] * lv[448 + lane]);
    const float li = lambda_init_of(l), lam = expf(e1) - expf(e2) + li;
    const f32x4 g = *(const GAS f32x4*)(sg + lane * 4);
    for (int it0 = gw * 4; it0 < M * DIFF_H; it0 += NGW * 4) {
        v2u a[4], c[4];
#pragma unroll
        for (int u = 0; u < 4; ++u) { const int it = it0 + u, m = it / DIFF_H, h = it % DIFF_H; const bf16* p = DIFFO + (size_t)m * (DIFF_H * 512) + h * 512 + lane * 4;
            a[u] = *(const GAS v2u*)p; c[u] = *(const GAS v2u*)(p + 256); }
#pragma unroll
        for (int u = 0; u < 4; ++u) { const int it = it0 + u, m = it / DIFF_H, h = it % DIFF_H;
            const float o0 = bflo(a[u].x) - lam * bflo(c[u].x), o1 = bfhi(a[u].x) - lam * bfhi(c[u].x), o2 = bflo(a[u].y) - lam * bflo(c[u].y), o3 = bfhi(a[u].y) - lam * bfhi(c[u].y);
            const float r = 1.f / sqrtf(wave_sum(o0 * o0 + o1 * o1 + o2 * o2 + o3 * o3) * (1.f / 256.f) + RMS_EPS) * (1.f - li);
            v2u o; o.x = pk2(o0 * r * g.x, o1 * r * g.y); o.y = pk2(o2 * r * g.z, o3 * r * g.w);
            *(GAS v2u*)(Y + (size_t)m * DM + h * 256 + lane * 4) = o; }
    }
}


template <int KK, int NCT>
__device__ __forceinline__ void sg_unit(const bf16* A, int lda, const bf16* B, bf16* C, int ldc, int lane) {
    const int fr = lane & 15, fq = lane >> 4;
    f32x4 acc[2][NCT];
#pragma unroll
    for (int i = 0; i < 2; ++i)
#pragma unroll
        for (int j = 0; j < NCT; ++j) acc[i][j] = (f32x4){0.f, 0.f, 0.f, 0.f};
    const bf16* ap = A + (size_t)fr * lda + 8 * fq; const bf16* bp = B + (size_t)(8 * (fr >> 2) + (fr & 3)) * KK + 8 * fq;
#pragma unroll 4
    for (int ks = 0; ks < KK / 32; ++ks) {
        bf16x8 a[2], b[NCT];
#pragma unroll
        for (int i = 0; i < 2; ++i) a[i] = *(const GAS bf16x8*)(ap + (size_t)i * 16 * lda + ks * 32);
#pragma unroll
        for (int j = 0; j < NCT; ++j) b[j] = *(const GAS bf16x8*)(bp + (size_t)((j >> 1) * 32 + 4 * (j & 1)) * KK + ks * 32);
#pragma unroll
        for (int i = 0; i < 2; ++i)
#pragma unroll
            for (int j = 0; j < NCT; ++j) acc[i][j] = __builtin_amdgcn_mfma_f32_16x16x32_bf16(b[j], a[i], acc[i][j], 0, 0, 0);
    }
#pragma unroll
    for (int i = 0; i < 2; ++i)
#pragma unroll
        for (int jp = 0; jp < NCT / 2; ++jp) { v4u o; o.x = pk2(acc[i][2 * jp][0], acc[i][2 * jp][1]); o.y = pk2(acc[i][2 * jp][2], acc[i][2 * jp][3]);
            o.z = pk2(acc[i][2 * jp + 1][0], acc[i][2 * jp + 1][1]); o.w = pk2(acc[i][2 * jp + 1][2], acc[i][2 * jp + 1][3]);
            *(GAS v4u*)(C + (size_t)(i * 16 + fr) * ldc + jp * 32 + 8 * fq) = o; }
}
__device__ __forceinline__ void qlat_phase(Frame& F, int l) {
    const int lane = lane_now();
    const int gw = VCU(F) * NWAVES + WAVE(F), NGW = F.G * NWAVES;
    const bf16* PROJ = (const bf16*)(WSL(F) + WS_PROJ); const bf16* WUK = (const bf16*)(WSL(F) + WS_WUK) + (size_t)l * DSA_H * KVL * HD; bf16* QLAT = (bf16*)(WSL(F) + WS_QLAT);
    for (int wu = gw; wu < (M / 32) * DSA_H * 4; wu += NGW) { const int tt = wu / (DSA_H * 4), rem = wu % (DSA_H * 4), h = rem >> 2, cg = rem & 3;
        sg_unit<HD, 8>(PROJ + (size_t)(tt * 32) * DINM + O_CQ + h * HD, DINM, WUK + ((size_t)h * KVL + cg * 128) * HD, QLAT + (size_t)(tt * 32) * (DSA_H * KVL) + h * KVL + cg * 128, DSA_H * KVL, lane); }
}
__device__ __forceinline__ void dsa_out_phase(Frame& F, int l) {
    const int lane = lane_now();
    const int gw = VCU(F) * NWAVES + WAVE(F), NGW = F.G * NWAVES;
    const bf16* OLAT = (const bf16*)(WSL(F) + WS_OLAT); const bf16* WUVT = (const bf16*)(WSL(F) + WS_WUVT) + (size_t)l * DSA_H * HD * KVL; bf16* Y = (bf16*)(WSL(F) + WS_Y);
    for (int wu = gw; wu < (M / 32) * DSA_H * 2; wu += NGW) { const int tt = wu / (DSA_H * 2), rem = wu % (DSA_H * 2), h = rem >> 1, cg = rem & 1;
        sg_unit<KVL, 4>(OLAT + (size_t)(tt * 32) * (DSA_H * KVL) + h * KVL, DSA_H * KVL, WUVT + ((size_t)h * HD + cg * 64) * KVL, Y + (size_t)(tt * 32) * DM + 2816 + h * HD + cg * 64, DM, lane); }
}

typedef short v4i16_t __attribute__((ext_vector_type(4)));
namespace dsa {
constexpr int G = 4;
constexpr int KT = 256, KSTR = 144;
constexpr int NB1 = 1024;
constexpr int SZ_KI = KT * KSTR, OFF_KI = 0, OFF_SC = 2 * SZ_KI, OFF_HIST = OFF_SC + G * 16384, OFF_SEL = OFF_HIST + G * NB1 * 4, OFF_CNT = OFF_SEL + G * 512  , CNT_W = 64  , LDS_END = OFF_CNT + G * CNT_W * 4;
static_assert(LDS_END <= RING_BYTES, "dsa select LDS map");
__device__ __forceinline__ unsigned fkey(float f) { const unsigned u = __float_as_uint(f); return (u & 0x80000000u) ? ~u : (u | 0x80000000u); }
__device__ __forceinline__ int crow(int r, int hi) { return (r & 3) + 8 * (r >> 2) + 4 * hi; }
}
__device__ __forceinline__ void dsa_select_phase(Frame& F) {
    using namespace dsa;
    const int lane = lane_now(), w = WAVE(F), tid = w * 64 + lane, g = w >> 1, par = w & 1, r32 = lane & 31, hi = lane >> 5;
    LAS unsigned char* L = F.lds + RING_OFF;
    LAS float* sc = (LAS float*)(L + OFF_SC) + g * 4096; LAS unsigned* hist = (LAS unsigned*)(L + OFF_HIST) + g * NB1;
    LAS unsigned* bmp = (LAS unsigned*)(L + OFF_SEL) + g * 128; LAS unsigned* cnt = (LAS unsigned*)(L + OFF_CNT) + g * CNT_W;
    LAS unsigned* cnt_all = (LAS unsigned*)(L + OFF_CNT);
    const bf16* PROJ = (const bf16*)(WSL(F) + WS_PROJ); const bf16* KI = (const bf16*)(WSL(F) + WS_KI); const float* WI = (const float*)(WSL(F) + WS_WI); unsigned short* SEL = (unsigned short*)(WSL(F) + WS_SEL);
    constexpr int NGRP = M / G; const int vcu_ = VCU(F);
    for (int rr = 0;; ++rr) {
        const int i = rr * F.G + ((rr & 1) ? F.G - 1 - vcu_ : vcu_); if (i >= NGRP) break;
        const int b = i & 1, t0 = T - G - G * (i >> 1), t = t0 + g; const size_t row = (size_t)b * T + t;
        if (t0 + G - 1 < 256) {
            if (par == 0) { const unsigned e = lane * 4; v2u o; o.x = e | ((e + 1) << 16); o.y = (e + 2) | ((e + 3) << 16); *(GAS v2u*)(SEL + row * 256 + lane * 4) = o; }
            continue; }
        bf16x8 aq[4]; float wv[16];
#pragma unroll
        for (int ks = 0; ks < 4; ++ks) aq[ks] = *(const GAS bf16x8*)(PROJ + row * DINM + O_IQ + r32 * IDX_D + 16 * ks + 8 * hi);
#pragma unroll
        for (int r = 0; r < 16; ++r) wv[r] = WI[row * IDX_H + crow(r, hi)];
        const int ntile = (t0 + G - 1) / KT + 1;
        const bf16* kib = KI + (size_t)b * T * IDX_D;
        v4u sa0, sa1, sa2, sa3, sb0, sb1, sb2, sb3;
        const int p0k = tid >> 3, p0c = tid & 7;
#define DS_LOAD(R, tl) do { const bf16* s_ = kib + (size_t)((tl) * KT + p0k) * IDX_D + p0c * 8; R##0 = *(const GAS v4u*)s_; R##1 = *(const GAS v4u*)(s_ + 64 * IDX_D); R##2 = *(const GAS v4u*)(s_ + 128 * IDX_D); R##3 = *(const GAS v4u*)(s_ + 192 * IDX_D); } while (0)
#define DS_WRITE(R, bf) do { LAS unsigned char* d_ = L + OFF_KI + (bf) * SZ_KI + p0k * KSTR + p0c * 16; *(LAS v4u*)d_ = R##0; *(LAS v4u*)(d_ + 64 * KSTR) = R##1; *(LAS v4u*)(d_ + 128 * KSTR) = R##2; *(LAS v4u*)(d_ + 192 * KSTR) = R##3; } while (0)
        __syncthreads();
        if (tid < G * CNT_W) cnt_all[tid] = 0u;
        ((LAS unsigned*)(L + OFF_SEL))[tid] = 0u;
        DS_LOAD(sa, 0); if (ntile > 1) DS_LOAD(sb, 1);
        DS_WRITE(sa, 0);
        __syncthreads();
        float smin = 3.0e38f, smax = -3.0e38f;
#define DS_MF(ACC, sb_) do { ACC = (f32x16){}; _Pragma("unroll") for (int ks = 0; ks < 4; ++ks) ACC = __builtin_amdgcn_mfma_f32_32x32x16_bf16(aq[ks], kf[sb_][ks], ACC, 0, 0, 0); } while (0)
#define DS_EP(ACC, sb_, tl) do { const int key = (tl) * KT + (par + 2 * (sb_)) * 32 + r32; float s = 0.f; \
            _Pragma("unroll") for (int r = 0; r < 16; ++r) { const int ai_ = __float_as_int(ACC[r]); s += wv[r] * __int_as_float(ai_ > 0 ? ai_ : 0); }   \
            { auto rr = __builtin_amdgcn_permlane32_swap(__float_as_uint(s), __float_as_uint(s), false, false); s = __uint_as_float(rr[0]) + __uint_as_float(rr[1]); } \
            if (hi == 0 && key <= t) { sc[key] = s; smin = fminf(smin, s); smax = fmaxf(smax, s); } } while (0)
#define DS_STEP(tl, RL, RW) do { const int bufi = (tl) & 1; \
            if ((tl) + 2 < ntile) DS_LOAD(RL, (tl) + 2); \
            { const unsigned kbase = (unsigned)(size_t)(L + OFF_KI + bufi * SZ_KI + (par * 32 + r32) * KSTR + 16 * hi); \
              bf16x8 kf[4][4]; \
              _Pragma("unroll") for (int sb_ = 0; sb_ < 4; ++sb_) \
                  _Pragma("unroll") for (int ks = 0; ks < 4; ++ks) asm volatile("ds_read_b128 %0, %1 offset:%2" : "=v"(kf[sb_][ks]) : "v"(kbase), "i"(sb_ * 64 * KSTR + ks * 32) : "memory"); \
                \
              f32x16 accA, accB; \
              asm volatile("s_waitcnt lgkmcnt(12)" ::: "memory"); __builtin_amdgcn_sched_barrier(0); DS_MF(accA, 0); __builtin_amdgcn_sched_barrier(0); \
              asm volatile("s_waitcnt lgkmcnt(8)" ::: "memory"); __builtin_amdgcn_sched_barrier(0); DS_MF(accB, 1); __builtin_amdgcn_sched_barrier(0); \
              DS_EP(accA, 0, tl); __builtin_amdgcn_sched_barrier(0); \
              asm volatile("s_waitcnt lgkmcnt(4)" ::: "memory"); __builtin_amdgcn_sched_barrier(0); DS_MF(accA, 2); __builtin_amdgcn_sched_barrier(0); \
              DS_EP(accB, 1, tl); __builtin_amdgcn_sched_barrier(0); \
              asm volatile("s_waitcnt lgkmcnt(0)" ::: "memory"); __builtin_amdgcn_sched_barrier(0); DS_MF(accB, 3); __builtin_amdgcn_sched_barrier(0); \
              DS_EP(accA, 2, tl); __builtin_amdgcn_sched_barrier(0); \
              DS_EP(accB, 3, tl); } \
            if ((tl) + 1 < ntile) DS_WRITE(RW, bufi ^ 1); \
            asm volatile("s_waitcnt lgkmcnt(0)" ::: "memory"); __builtin_amdgcn_s_barrier(); asm volatile("" ::: "memory");   } while (0)
        for (int tl = 0; tl < ntile; tl += 2) { DS_STEP(tl, sa, sb); if (tl + 1 < ntile) DS_STEP(tl + 1, sb, sa); }
#undef DS_STEP
#undef DS_MF
#undef DS_EP
#undef DS_LOAD
#undef DS_WRITE
#ifndef REP_SELSTAGE
#define REP_SELSTAGE 1
#endif
        for (int rep_ = 0; rep_ < REP_SELSTAGE; ++rep_) {
        if (rep_) { __syncthreads(); if (tid < G * CNT_W) cnt_all[tid] = 0u; __syncthreads(); }
#pragma unroll
        for (int o = 1; o < 64; o <<= 1) { smin = fminf(smin, __shfl_xor(smin, o)); smax = fmaxf(smax, __shfl_xor(smax, o)); }
        if (lane == 0) { cnt[4 + 2 * par] = __float_as_uint(smin); cnt[5 + 2 * par] = __float_as_uint(smax); }
        for (int e = tid; e < G * NB1; e += NWAVES * 64) ((LAS unsigned*)(L + OFF_HIST))[e] = 0u;
        __syncthreads();
        const float lo = fminf(__uint_as_float(cnt[4]), __uint_as_float(cnt[6])), hi_ = fmaxf(__uint_as_float(cnt[5]), __uint_as_float(cnt[7]));
        const float bscale = hi_ > lo ? ((float)NB1 - 0.5f) / (hi_ - lo) : 0.f;
        const int n = t + 1;
        for (int e0 = par * 64 + lane; e0 < n; e0 += 512) {
            float sv_[4];
#pragma unroll
            for (int u = 0; u < 4; ++u) sv_[u] = sc[(e0 + 128 * u) & 4095];
#pragma unroll
            for (int u = 0; u < 4; ++u) if (e0 + 128 * u < n) { int bin = (int)((sv_[u] - lo) * bscale); bin = bin > NB1 - 1 ? NB1 - 1 : bin;
                __hip_atomic_fetch_add(&hist[bin], 1u, __ATOMIC_RELAXED, __HIP_MEMORY_SCOPE_WORKGROUP); } }
        __syncthreads();
        int B1, need; unsigned hB1;
        { unsigned hh[16]; unsigned tot = 0;
#pragma unroll
          for (int q = 0; q < 4; ++q) { const v4u v = *(const LAS v4u*)&hist[16 * lane + 4 * q]; hh[4 * q] = v.x; hh[4 * q + 1] = v.y; hh[4 * q + 2] = v.z; hh[4 * q + 3] = v.w; tot += v.x + v.y + v.z + v.w; }
          unsigned suf = tot;
#pragma unroll
          for (int o = 1; o < 64; o <<= 1) { const unsigned v = __shfl_down(suf, o); if (lane + o < 64) suf += v; }
          const unsigned long long bal = __ballot(suf >= 256u);
          const int ls = 63 - __builtin_clzll(bal | 1ull);
          unsigned cum = suf - tot; int bb = 0; unsigned cg = 0, hb = 0; bool found = false;
#pragma unroll
          for (int q = 15; q >= 0; --q) { if (!found) { if (cum + hh[q] >= 256u) { bb = q; cg = cum; hb = hh[q]; found = true; } else cum += hh[q]; } }
          B1 = 16 * ls + __shfl(bb, ls); need = 256 - (int)__shfl(cg, ls); hB1 = __shfl(hb, ls); }
        if (lane == 0 && par == 0) { unsigned z_ = 0u; asm volatile("" : "+v"(z_)); cnt[2] = ~z_; cnt[3] = z_; }
        __syncthreads();
        LAS unsigned short* cand = (LAS unsigned short*)(cnt + 8);
        { unsigned kmn = 0xFFFFFFFFu, kmx = 0u;
          for (int e0 = par * 64 + lane; e0 < n; e0 += 512) { float sv_[4];
#pragma unroll
            for (int u = 0; u < 4; ++u) sv_[u] = sc[(e0 + 128 * u) & 4095];
#pragma unroll
            for (int u = 0; u < 4; ++u) { const int e = e0 + 128 * u; if (e < n) { const float s = sv_[u]; int bin = (int)((s - lo) * bscale); bin = bin > NB1 - 1 ? NB1 - 1 : bin;
              if (bin > B1) __hip_atomic_fetch_or(&bmp[e >> 5], 1u << (e & 31), __ATOMIC_RELAXED, __HIP_MEMORY_SCOPE_WORKGROUP);
              else if (bin == B1) { const unsigned pos = __hip_atomic_fetch_add(&cnt[0], 1u, __ATOMIC_RELAXED, __HIP_MEMORY_SCOPE_WORKGROUP); if (pos < 64u) cand[pos] = (unsigned short)e;
                  const unsigned k = fkey(s); kmn = k < kmn ? k : kmn; kmx = k > kmx ? k : kmx; } } } }
          if (hB1 > 64u) {
#pragma unroll
              for (int o = 1; o < 64; o <<= 1) { const unsigned a = __shfl_xor(kmn, o), c2 = __shfl_xor(kmx, o); kmn = a < kmn ? a : kmn; kmx = c2 > kmx ? c2 : kmx; }
              if (lane == 0) { __hip_atomic_fetch_min(&cnt[2], kmn, __ATOMIC_RELAXED, __HIP_MEMORY_SCOPE_WORKGROUP); __hip_atomic_fetch_max(&cnt[3], kmx, __ATOMIC_RELAXED, __HIP_MEMORY_SCOPE_WORKGROUP); } } }
        if (lane == 0 && par == 0) cnt[1] = hB1 > 64u ? 0u : 1u;
        for (int e = tid; e < G * NB1; e += NWAVES * 64) ((LAS unsigned*)(L + OFF_HIST))[e] = 0u;
        __syncthreads();
        if (hB1 <= 64u) {
            if (par == 0) { const int nc = (int)hB1; const int me = lane < nc ? (int)cand[lane] : 0; const unsigned mk = lane < nc ? fkey(sc[me]) : 0u; int rank = 0;
                for (int jn = 0; jn < nc; ++jn) { const int oe = __builtin_amdgcn_readlane(me, jn); const unsigned ok = (unsigned)__builtin_amdgcn_readlane((int)mk, jn); rank += (ok > mk || (ok == mk && oe < me)) ? 1 : 0; }
                if (lane < nc && rank < need) __hip_atomic_fetch_or(&bmp[me >> 5], 1u << (me & 31), __ATOMIC_RELAXED, __HIP_MEMORY_SCOPE_WORKGROUP); } }
        const bool any_fb = (cnt_all[1] + cnt_all[CNT_W + 1] + cnt_all[2 * CNT_W + 1] + cnt_all[3 * CNT_W + 1]) != (unsigned)G;
        if (any_fb) {
        unsigned kmin = cnt[2], kmax = cnt[3];
        bool done = hB1 <= 64u;
        for (int lev = 0; lev < 4; ++lev) {
            const unsigned width = kmax - kmin; const int bits = 32 - __builtin_clz(width | 1u);
            int sh = bits - 8; if (sh < 0) sh = 0;
            if (!done) for (int e = par * 64 + lane; e < n; e += 128) { const unsigned k = fkey(sc[e]); if (k >= kmin && k <= kmax) __hip_atomic_fetch_add(&hist[(k - kmin) >> sh], 1u, __ATOMIC_RELAXED, __HIP_MEMORY_SCOPE_WORKGROUP); }
            __syncthreads();
            unsigned B = 0, cgt = 0, hB = 0;
            if (!done) {
                const unsigned h0 = hist[4 * lane], h1 = hist[4 * lane + 1], h2 = hist[4 * lane + 2], h3 = hist[4 * lane + 3];
                unsigned suf = h0 + h1 + h2 + h3;
#pragma unroll
                for (int o = 1; o < 64; o <<= 1) { const unsigned v = __shfl_down(suf, o); if (lane + o < 64) suf += v; }
                const unsigned long long bal = __ballot(suf >= (unsigned)need);
                const int ls = 63 - __builtin_clzll(bal | 1ull);
                unsigned cum = suf - (h0 + h1 + h2 + h3), bb = 0, cg = 0, hb = 0;
                if (cum + h3 >= (unsigned)need) { bb = 3; cg = cum; hb = h3; }
                else if (cum + h3 + h2 >= (unsigned)need) { bb = 2; cg = cum + h3; hb = h2; }
                else if (cum + h3 + h2 + h1 >= (unsigned)need) { bb = 1; cg = cum + h3 + h2; hb = h1; }
                else { bb = 0; cg = cum + h3 + h2 + h1; hb = h0; }
                B = 4 * ls + __shfl(bb, ls); cgt = __shfl(cg, ls); hB = __shfl(hb, ls);
            }
            __syncthreads();
            if (!done) {
                const bool all_b = (cgt + hB == (unsigned)need);
                const bool ties = !all_b && sh == 0;
                for (int e = par * 64 + lane; e < n; e += 128) { const unsigned k = fkey(sc[e]);
                    if (k >= kmin && k <= kmax) { const unsigned bin = (k - kmin) >> sh;
                        if (bin > B || (all_b && bin == B)) { __hip_atomic_fetch_or(&bmp[e >> 5], 1u << (e & 31), __ATOMIC_RELAXED, __HIP_MEMORY_SCOPE_WORKGROUP); } } }
                if (ties) { if (par == 0) { int left = need - (int)cgt; const unsigned kk = kmin + B;
                        for (int e0 = 0; e0 < n && left > 0; e0 += 64) { const int e = e0 + lane; const bool eq = e < n && fkey(sc[e]) == kk;
                            const unsigned long long bq = __ballot(eq); const int before = __popcll(bq & ((1ull << lane) - 1ull));
                            if (eq && before < left) { __hip_atomic_fetch_or(&bmp[e >> 5], 1u << (e & 31), __ATOMIC_RELAXED, __HIP_MEMORY_SCOPE_WORKGROUP); }
                            left -= __popcll(bq); } }
                    done = true; }
                else if (all_b) done = true;
                else { need -= (int)cgt; const unsigned long long lo2 = (unsigned long long)kmin + ((unsigned long long)B << sh), hi2 = lo2 + ((1ull << sh) - 1ull);
                    kmin = (unsigned)lo2; kmax = hi2 < (unsigned long long)kmax ? (unsigned)hi2 : kmax; }
            }
            if (lane == 0 && par == 0) cnt[1] = done ? 1u : 0u;
            for (int e = tid; e < G * NB1; e += NWAVES * 64) ((LAS unsigned*)(L + OFF_HIST))[e] = 0u;
            __syncthreads();
            if (cnt_all[1] + cnt_all[CNT_W + 1] + cnt_all[2 * CNT_W + 1] + cnt_all[3 * CNT_W + 1] == (unsigned)G) break;
        }
        }
        __syncthreads();
        if (par == 0) {
            unsigned w0 = bmp[2 * lane], w1 = bmp[2 * lane + 1]; const int c = __popc(w0) + __popc(w1); int pre = c;
#pragma unroll
            for (int o = 1; o < 64; o <<= 1) { const int v = __shfl_up(pre, o); if (lane >= o) pre += v; }
            int pos = pre - c; unsigned short* so = SEL + row * 256;
            while (w0) { const int bb = __builtin_ctz(w0); w0 &= w0 - 1u; if (pos < 256) so[pos] = (unsigned short)(lane * 64 + bb); ++pos; }
            while (w1) { const int bb = __builtin_ctz(w1); w1 &= w1 - 1u; if (pos < 256) so[pos] = (unsigned short)(lane * 64 + 32 + bb); ++pos; }
        }
        }
    }
}
#ifndef DA_GRP
#define DA_GRP 2
#endif
#ifndef REP_GATHER
#define REP_GATHER 1
#endif
constexpr int DA_XOFF = 131072, DA_SOFF = DA_XOFF + 8192;
constexpr int DA_BOFF = DA_SOFF + 2048;
static_assert(DA_BOFF + 8192 <= RING_BYTES, "dsa attention LDS map");
__device__ __forceinline__ void dsa_attn_phase(Frame& F, int hot = 0) {
    const int lane = lane_now(), w = WAVE(F), tid = w * 64 + lane, g = w >> 1, half = w & 1, fr = lane & 15, fq = lane >> 4;
    LAS unsigned char* cbuf = F.lds + RING_OFF + g * 32768; LAS unsigned char* xb = F.lds + RING_OFF + DA_XOFF + g * 2048;
    const bf16* CKVN = (const bf16*)(WSL(F) + WS_CKVN); const bf16* QLAT = (const bf16*)(WSL(F) + WS_QLAT); const unsigned short* SEL = (const unsigned short*)(WSL(F) + WS_SEL);
    bf16* OLAT = (bf16*)(WSL(F) + WS_OLAT); const float* tab = karg(3);
    const int hh = fr < DSA_H ? fr : DSA_H - 1;
    constexpr float LOG2E = 1.4426950408889634f;
    const int q4 = (lane >> 2) & 3, p4 = lane & 3, keyl = 4 * fq + q4;
    LAS float* btab = (LAS float*)(F.lds + RING_OFF + DA_BOFF);
    for (int e = tid; e < 128 * 16; e += NWAVES * 64) { const int d = e >> 4, h_ = e & 15; btab[e] = tab[bucket(d) * 32 + 22 + (h_ < DSA_H ? h_ : DSA_H - 1)] * LOG2E; }
    const int vcu_ = VCU(F), per_x = F.G >= 8 ? F.G / 8 : 1, xcd = vcu_ / per_x, jx = vcu_ % per_x, nxb = F.G >= 8 ? 4 : F.G;
    for (int r8 = 0;; ++r8) {
        int b, t0;
        if (F.G >= 8 && F.G % 8 == 0) { const int gi = r8 * (nxb * per_x) + (xcd >> 1) * per_x + jx; if (gi >= T / 4) break; b = xcd & 1; t0 = T - 4 - 4 * gi; }
        else { const int gi = r8 * F.G + vcu_; if (gi >= M / 4) break; b = gi & 1; t0 = T - 4 - 4 * (gi >> 1); }
        const int t = t0 + g, q = b * T + t, nsel = t + 1 < 256 ? t + 1 : 256;
        const int nmax = ((t0 + 4 < 256 ? t0 + 4 : 256) + 15) >> 4;
        bf16x8 ql[8];
#pragma unroll
        for (int ks = 0; ks < 8; ++ks) ql[ks] = __builtin_nontemporal_load((const GAS bf16x8*)(QLAT + (size_t)q * (DSA_H * KVL) + hh * KVL + half * 256 + 32 * ks + 8 * fq));
        f32x4 O[16];
#pragma unroll
        for (int ct = 0; ct < 16; ++ct) O[ct] = (f32x4){0.f, 0.f, 0.f, 0.f};
        float m_run = -1e30f, l_run = 0.f;
        const bf16* cb = CKVN + (size_t)b * T * KVL;
        const LAS unsigned short* srow = (const LAS unsigned short*)(F.lds + RING_OFF + DA_SOFF + g * 512);
        v2u selw; if (half == 0) selw = *(const GAS v2u*)(SEL + (size_t)q * 256 + lane * 4);
#define DA_RD128(dst, addr, off) asm volatile("ds_read_b128 %0, %1 offset:%2" : "=v"(dst) : "v"(addr), "i"(off) : "memory")
#define DA_RDTR(dst, addr, off) asm volatile("ds_read_b64_tr_b16 %0, %1 offset:%2" : "=v"(dst) : "v"(addr), "i"(off) : "memory")
#define DA_ISSUE_K(sv_, bf_, k0_, k1_) do { _Pragma("unroll") for (int k = (k0_); k < (k1_); ++k) { const int slot_ = half * 8 + k; const int idx_ = __builtin_amdgcn_readlane(sv_, slot_); \
        _Pragma("unroll") for (int rg_ = 0; rg_ < REP_GATHER; ++rg_) __builtin_amdgcn_global_load_lds((const GAS unsigned*)(cb + (size_t)idx_ * KVL + ((lane ^ slot_) & 63) * 8), (LAS unsigned*)(cbuf + (bf_) * 16384 + slot_ * 1024), 16, 0, 0); } } while (0)
#define DA_ISSUE(sv_, bf_) DA_ISSUE_K(sv_, bf_, 0, 8)
#define DA_NEXT(k0_) do { __builtin_amdgcn_sched_barrier(0); if (more) DA_ISSUE_K(selv, cur ^ 1, k0_, (k0_) + DA_GRP); __builtin_amdgcn_sched_barrier(0); } while (0)
        __syncthreads();
        if (half == 0) *(LAS v2u*)(F.lds + RING_OFF + DA_SOFF + g * 512 + lane * 8) = selw;
        __syncthreads();
        int selv = fr < nsel ? (int)srow[fr] : 0; if (hot) selv &= 255;
        DA_ISSUE(selv, 0);
        for (int c = 0; c < nmax; ++c) {
            const int cur = c & 1;
            asm volatile("s_waitcnt vmcnt(0)" ::: "memory");
            __builtin_amdgcn_s_barrier();
            asm volatile("" ::: "memory"); __builtin_amdgcn_sched_barrier(0);
            const bool more = c + 1 < nmax;
            if (more) { const int slot = (c + 1) * 16 + fr; selv = slot < nsel ? (int)srow[slot] : 0; if (hot) selv &= 255; }
            DA_NEXT(0);
            const LAS unsigned char* buf = cbuf + cur * 16384;
            f32x4 s4 = (f32x4){0.f, 0.f, 0.f, 0.f};
            { bf16x8 af[8];
#pragma unroll
              for (int i4 = 0; i4 < 4; ++i4) { const unsigned sa = (unsigned)(size_t)(buf + fr * 1024 + half * 512 + (((4 * i4 + fq) ^ fr) << 4));
                  DA_RD128(af[i4], sa, 0); DA_RD128(af[4 + i4], sa, 256); }
              asm volatile("s_waitcnt lgkmcnt(0)" ::: "memory"); __builtin_amdgcn_sched_barrier(0);
#pragma unroll
              for (int ks = 0; ks < 8; ++ks) s4 = __builtin_amdgcn_mfma_f32_16x16x32_bf16(af[ks], ql[ks], s4, 0, 0, 0); }
            DA_NEXT(DA_GRP);
            *(LAS f32x4*)(xb + half * 1024 + lane * 16) = s4;
            asm volatile("s_waitcnt lgkmcnt(0)" ::: "memory");
            __builtin_amdgcn_s_barrier();
            asm volatile("" ::: "memory"); __builtin_amdgcn_sched_barrier(0);
            DA_NEXT(2 * DA_GRP);
            s4 = s4 + *(const LAS f32x4*)(xb + (half ^ 1) * 1024 + lane * 16);
            float sv[4]; float cmax = -__builtin_inff();
#pragma unroll
            for (int r = 0; r < 4; ++r) { const int ks_ = 4 * fq + r; const bool valid = c * 16 + ks_ < nsel; const int idx = valid ? (int)srow[c * 16 + ks_] : 0;
                int dist = t - idx; dist = dist > 127 ? 127 : dist; const float bias = btab[dist * 16 + fr];
                sv[r] = valid ? s4[r] * (SCALE * LOG2E) + bias : -__builtin_inff(); cmax = fmaxf(cmax, sv[r]); }
            { auto r1 = __builtin_amdgcn_permlane16_swap(__float_as_uint(cmax), __float_as_uint(cmax), false, false); cmax = fmaxf(__uint_as_float(r1[0]), __uint_as_float(r1[1]));
              auto r2 = __builtin_amdgcn_permlane32_swap(__float_as_uint(cmax), __float_as_uint(cmax), false, false); cmax = fmaxf(__uint_as_float(r2[0]), __uint_as_float(r2[1])); }
            const bool grow = __any(cmax - m_run > 10.f);
            const float m_new = grow ? fmaxf(m_run, cmax) : m_run, alpha = grow ? __builtin_amdgcn_exp2f(m_run - m_new) : 1.f;
            float p[4], ps = 0.f;
#pragma unroll
            for (int r = 0; r < 4; ++r) { p[r] = __builtin_amdgcn_exp2f(sv[r] - m_new); ps += p[r]; }
            { auto r1 = __builtin_amdgcn_permlane16_swap(__float_as_uint(ps), __float_as_uint(ps), false, false); ps = __uint_as_float(r1[0]) + __uint_as_float(r1[1]);
              auto r2 = __builtin_amdgcn_permlane32_swap(__float_as_uint(ps), __float_as_uint(ps), false, false); ps = __uint_as_float(r2[0]) + __uint_as_float(r2[1]); }
            l_run = l_run * alpha + ps; m_run = m_new;
            if (grow) { float ar[4];
#pragma unroll
                for (int r = 0; r < 4; ++r) ar[r] = __shfl(alpha, 4 * fq + r);
#pragma unroll
                for (int ct = 0; ct < 16; ++ct)
#pragma unroll
                    for (int r = 0; r < 4; ++r) O[ct][r] *= ar[r]; }
            DA_NEXT(3 * DA_GRP);
            v2u pw; pw.x = pk2(p[0], p[1]); pw.y = pk2(p[2], p[3]);
            const s16x4 pa = __builtin_bit_cast(s16x4, pw);
            { const unsigned rb = (unsigned)(size_t)(buf + keyl * 1024 + half * 512 + (p4 & 1) * 8); s16x4 bvv[16];
#pragma unroll
              for (int i8 = 0; i8 < 8; ++i8) { const unsigned ad = rb + (((2 * i8 + (p4 >> 1)) ^ keyl) << 4);
                  DA_RDTR(bvv[i8], ad, 0); DA_RDTR(bvv[8 + i8], ad, 256); }
              asm volatile("s_waitcnt lgkmcnt(0)" ::: "memory"); __builtin_amdgcn_sched_barrier(0);
#pragma unroll
              for (int ct = 0; ct < 16; ++ct) O[ct] = __builtin_amdgcn_mfma_f32_16x16x16bf16_1k(pa, bvv[ct], O[ct], 0, 0, 0); }
        }
#undef DA_ISSUE
#undef DA_ISSUE_K
#undef DA_NEXT
#undef DA_RD128
#undef DA_RDTR
        float rl[4];
#pragma unroll
        for (int r = 0; r < 4; ++r) rl[r] = 1.f / __shfl(l_run, 4 * fq + r);
        { LAS unsigned char* stg = cbuf + (nmax & 1) * 16384 + half * 8192;
          LAS unsigned char* wb = stg + (4 * fq * 256 + fr) * 2;
#pragma unroll
          for (int r = 0; r < 4; ++r) if (4 * fq + r < DSA_H) {
#pragma unroll
              for (int ct = 0; ct < 16; ++ct) *(LAS unsigned short*)(wb + r * 512 + ct * 32) = (unsigned short)f2bf(O[ct][r] * rl[r]); }
          asm volatile("s_waitcnt lgkmcnt(0)" ::: "memory");
#pragma unroll
          for (int i5 = 0; i5 < 5; ++i5) { const int e = i5 * 512 + lane * 8, hd = e >> 8, col = e & 255;
              __builtin_nontemporal_store(*(const LAS v4u*)(stg + i5 * 1024 + lane * 16), (GAS v4u*)(OLAT + (size_t)q * (DSA_H * KVL) + hd * KVL + half * 256 + col)); } }
    }
}


template <class P> __device__ __forceinline__ P* lnd(P* p) { asm volatile("" : "+s"(p)); return p; }
#ifndef DA_HOT
#define DA_HOT 0
#endif
#ifndef QLAT_GEMM
#define QLAT_GEMM 1
#endif
struct QlatOrder : pg8::StaticOrder { __device__ __forceinline__ int acol(const pg8::Unit& u) const { return (u.pn >> 1) * HD; } };
#ifndef REP_DSAOUT
#define REP_DSAOUT 1
#endif
#ifndef REP_POSTP
#define REP_POSTP 1
#endif
#ifndef DSAOUT_GEMM
#define DSAOUT_GEMM 1
#endif
struct DsaOutOrder : pg8::StaticOrder { __device__ __forceinline__ int acol(const pg8::Unit& u) const { return u.pn * 2 * KVL; } };
#ifndef REP_QLAT
#define REP_QLAT 1
#endif
#ifndef REP_FA
#define REP_FA 1
#endif
#ifndef REP_DA
#define REP_DA 1
#endif
#ifndef REP_MS
#define REP_MS 1
#endif
#ifndef REP_TAIL
#define REP_TAIL 1
#endif
#ifndef REP_P0
#define REP_P0 1
#endif
#ifndef REP_PROJ
#define REP_PROJ 1
#endif
#ifndef REP_PREP
#define REP_PREP 1
#endif
#ifndef REP_SEL
#define REP_SEL 1
#endif
#ifndef REP_ATTN
#define REP_ATTN 1
#endif
#ifndef REP_POST
#define REP_POST 1
#endif
#ifndef REP_WO
#define REP_WO 1
#endif
#ifndef REP_LN
#define REP_LN 1
#endif
#ifndef REP_UP
#define REP_UP 1
#endif
#ifndef REP_DN
#define REP_DN 1
#endif
constexpr int PH_PER_LAYER = 10, N_PHASES = 1 + DEPTH * PH_PER_LAYER;
struct Args { const float* in[17]; float* out; unsigned char* ws; int ph_lo, ph_hi, li, pad; };
__global__ void __launch_bounds__(NWAVES * 64, 2) mk_fwd(Args args) {
    extern __shared__ __attribute__((aligned(16))) unsigned char lds[];
    Frame F;
    F.lds = (LAS unsigned char*)lds;
    F.MISC = (volatile LAS unsigned*)(F.lds + MISC_OFF);
    F.wave = __builtin_amdgcn_readfirstlane((int)threadIdx.x >> 6);
    F.G = gridDim.x; { const int bx = blockIdx.x; F.vcu = (F.G % 8 == 0) ? (bx % 8) * (F.G / 8) + bx / 8 : bx; }
    F.ws = args.ws; F.ctl = (gu32*)(args.ws + WS_CTL);
    { for (int u = F.wave * 64 + lane_now(); u < (LDS_BYTES - LDSCTL_OFF) / 4; u += NWAVES * 64) ((LAS unsigned*)(F.lds + LDSCTL_OFF))[u] = 0u; }
    __syncthreads();
    XcdBarrier bar = xcd_barrier_post((unsigned*)(F.ctl + CW_BAR) + args.li * XCD_BAR_WORDS, F.MISC + 8, F.wave);
    const int lo = args.ph_lo, hi = args.ph_hi;
#define IN(k) (lo <= (k) && (k) < hi)
#ifndef REP_BAR
#define REP_BAR 1
#endif
#define SEAM(k) do { if (IN(k) && IN((k) + 1)) { for (int rb_ = 0; rb_ < REP_BAR; ++rb_) xcd_barrier(bar); } } while (0)

#define XN ((bf16*)(WSL(F) + WS_XN))
#define PROJ ((bf16*)(WSL(F) + WS_PROJ))
#define TAIL ((float*)(WSL(F) + WS_TAIL))
#define Y ((bf16*)(WSL(F) + WS_Y))
#define Z ((bf16*)(WSL(F) + WS_Z))
#define HID ((bf16*)(WSL(F) + WS_HID))

    for (int rep_ = 0; rep_ < REP_P0; ++rep_) { if (IN(0)) { p0_prologue(F); }
    SEAM(0); }
    for (int l = 0; l < DEPTH; ++l) {
        const int pb = 1 + l * PH_PER_LAYER;
        for (int rep_ = 0; rep_ < REP_PROJ; ++rep_) { if (IN(pb + 0)) {
            pg8::Gemm g{lnd(XN), lnd(w_layer(F, l, 0)), M, DINM, DM}; pg8::StaticOrder S; S.init(M, DINM, F.G, (int)blockIdx.x);
            pg8::EpiBf16<0> E{lnd(PROJ), DINM};
            pg8::gemm_phase<pg8::EpiBf16<0>, pg8::StaticOrder, PG8_ALIGN, PG8_SP2>(F.lds + RING_OFF, g, S, E, WAVE(F));
            for (int rt_ = 0; rt_ < REP_TAIL; ++rt_) tail_phase(F, lnd(XN), lnd(w_layer(F, l, 0) + (size_t)DINM * DM), lnd(TAIL));
        }
        SEAM(pb + 0); }
        for (int rep_ = 0; rep_ < REP_PREP; ++rep_) { if (IN(pb + 1)) { prep_phase(F, l);
            for (int r2_ = 0; r2_ < REP_QLAT; ++r2_) {
#if QLAT_GEMM
                __syncthreads();
                pg8::Gemm g{lnd((const bf16*)(WSL(F) + WS_PROJ) + O_CQ), lnd((const bf16*)(WSL(F) + WS_WUK) + (size_t)l * DSA_H * KVL * HD), M, DSA_H * KVL, HD, DINM};
                QlatOrder S; S.init(M, DSA_H * KVL, F.G, (int)blockIdx.x);
                pg8::EpiBf16Late E{lnd((bf16*)(WSL(F) + WS_QLAT)), DSA_H * KVL};
                pg8::gemm_phase<pg8::EpiBf16Late, QlatOrder, PG8_ALIGN, PG8_SP2, true>(F.lds + RING_OFF, g, S, E, WAVE(F));
#else
                qlat_phase(F, l);
#endif
            } }
        SEAM(pb + 1); }
        for (int rep_ = 0; rep_ < REP_SEL; ++rep_) { if (IN(pb + 2)) { for (int r2_ = 0; r2_ < REP_MS; ++r2_) moba_select_phase(F); dsa_select_phase(F); }
        SEAM(pb + 2); }
        for (int rep_ = 0; rep_ < REP_ATTN; ++rep_) { if (IN(pb + 3)) { for (int r2_ = 0; r2_ < REP_FA; ++r2_) { attn_phase(F); __syncthreads(); } for (int r2_ = 0; r2_ < REP_DA; ++r2_) { dsa_attn_phase(F, DA_HOT && (r2_ + 1 < REP_DA)); __syncthreads(); } }
        SEAM(pb + 3); }
        for (int rep_ = 0; rep_ < REP_POST; ++rep_) { if (IN(pb + 4)) { for (int r2_ = 0; r2_ < REP_POSTP; ++r2_) post_phase(F, l); for (int r2_ = 0; r2_ < REP_DSAOUT; ++r2_) {
#if DSAOUT_GEMM
                pg8::Gemm g{lnd((const bf16*)(WSL(F) + WS_OLAT)), lnd((const bf16*)(WSL(F) + WS_WUVB) + (size_t)l * 5 * 256 * 1024), M, DSA_H * HD, 2 * KVL, DSA_H * KVL};
                DsaOutOrder S; S.init(M, DSA_H * HD, F.G, (int)blockIdx.x);
                pg8::EpiBf16Late E{lnd((bf16*)(WSL(F) + WS_Y) + 2816), DM};
                pg8::gemm_phase<pg8::EpiBf16Late, DsaOutOrder, PG8_ALIGN, PG8_SP2, true>(F.lds + RING_OFF, g, S, E, WAVE(F));
#else
#error "the prologue only builds the pair-matrix layout"
#endif
            } }
        SEAM(pb + 4); }
        for (int rep_ = 0; rep_ < REP_WO; ++rep_) { if (IN(pb + 5)) {
            pg8::Gemm g{lnd(Y), lnd(w_layer(F, l, 1)), M, DM, DM}; pg8::StaticOrder S; S.init(M, DM, F.G, (int)blockIdx.x);
            pg8::EpiResBf16 E{lnd(Z), lnd(XN), DM, ALPHA};
            pg8::gemm_phase<pg8::EpiResBf16, pg8::StaticOrder, PG8_ALIGN, PG8_SP2>(F.lds + RING_OFF, g, S, E, WAVE(F));
        }
        SEAM(pb + 5); }
        for (int rep_ = 0; rep_ < REP_LN; ++rep_) { if (IN(pb + 6)) ln_phase(F, lnd(Z), lnd(karg(11) + (size_t)l * DM), lnd(karg(12) + (size_t)l * DM), nullptr, lnd(XN));
        SEAM(pb + 6); }
        for (int rep_ = 0; rep_ < REP_UP; ++rep_) { if (IN(pb + 7)) {
            pg8::Gemm g{lnd(XN), lnd(w_layer(F, l, 2)), M, DFF, DM}; pg8::StaticOrder S; S.init(M, DFF, F.G, (int)blockIdx.x);
            pg8::EpiBf16<1> E{lnd(HID), DFF};
            pg8::gemm_phase<pg8::EpiBf16<1>, pg8::StaticOrder, PG8_ALIGN, PG8_SP2>(F.lds + RING_OFF, g, S, E, WAVE(F));
        }
        SEAM(pb + 7); }
        for (int rep_ = 0; rep_ < REP_DN; ++rep_) { if (IN(pb + 8)) {
            pg8::Gemm g{lnd(HID), lnd(w_layer(F, l, 3)), M, DM, DFF}; pg8::StaticOrder S; S.init(M, DM, F.G, (int)blockIdx.x);
            pg8::EpiResBf16 E{lnd(Z), lnd(XN), DM, ALPHA};
            pg8::gemm_phase<pg8::EpiResBf16, pg8::StaticOrder, PG8_ALIGN, PG8_SP2>(F.lds + RING_OFF, g, S, E, WAVE(F));
        }
        SEAM(pb + 8); }
        for (int rep_ = 0; rep_ < REP_LN; ++rep_) { if (IN(pb + 9)) { const bool fin = (l == DEPTH - 1); ln_phase(F, lnd(Z), lnd(karg(15) + (size_t)l * DM), lnd(karg(16) + (size_t)l * DM), fin ? lnd((float*)karg(17)) : nullptr, fin ? nullptr : lnd(XN)); }
        SEAM(pb + 9); }
    }
#undef IN
#undef SEAM
#undef XN
#undef PROJ
#undef TAIL
#undef Y
#undef Z
#undef HID
}


extern "C" void kernel_launch(void* const* d_in, const int* in_sizes, int n_in, void* d_out, int out_size, void* d_ws, size_t ws_size, hipStream_t stream) {
    static int grid = 0;
    if (grid == 0) {
        if (n_in != 17 || in_sizes[0] != M * DM || out_size != M * DM || ws_size < WS_END) { fprintf(stderr, "kernel_launch: unexpected shapes / workspace (n_in %d, ws %zu need %zu); nothing launched\n", n_in, ws_size, (size_t)WS_END); grid = -1; return; }
        int dev = 0, cus = 0, per_cu = 0;
        if (hipGetDevice(&dev) != hipSuccess || hipDeviceGetAttribute(&cus, hipDeviceAttributeMultiprocessorCount, dev) != hipSuccess) { grid = -1; return; }
        if (hipFuncSetAttribute((const void*)mk_fwd, hipFuncAttributeMaxDynamicSharedMemorySize, LDS_BYTES) != hipSuccess) { fprintf(stderr, "kernel_launch: hipFuncSetAttribute failed\n"); grid = -1; return; }
        if (hipOccupancyMaxActiveBlocksPerMultiprocessor(&per_cu, (const void*)mk_fwd, NWAVES * 64, LDS_BYTES) != hipSuccess || per_cu < 1)
            fprintf(stderr, "kernel_launch: note: occupancy query reports %d workgroups per CU\n", per_cu);
        (void)hipGetLastError();
        grid = cus;
    }
    if (grid < 0) return;
    (void)hipMemsetAsync((char*)d_ws + WS_CTL, 0, CTL_ZERO_BYTES, stream);
    Args a{};
    for (int i = 0; i < 17; ++i) a.in[i] = (const float*)d_in[i];
    a.out = (float*)d_out; a.ws = (unsigned char*)d_ws; a.ph_lo = 0; a.ph_hi = N_PHASES; a.li = 0; a.pad = 0;
    hipLaunchKernelGGL(mk_fwd, dim3(grid), dim3(NWAVES * 64), LDS_BYTES, stream, a);
    const hipError_t le = hipPeekAtLastError();
    if (le != hipSuccess) fprintf(stderr, "kernel_launch: launch failed: %s\n", hipGetErrorName(le));
}
```

```cpp
#include <hip/hip_runtime.h>
#include <cstdio>
#include <cstdint>
#include <cmath>
namespace pg8 {
#define PG8_LAS __attribute__((address_space(3)))
typedef unsigned short bf16_t;
typedef short bf16x8 __attribute__((ext_vector_type(8)));
typedef float f32x4 __attribute__((ext_vector_type(4)));
typedef unsigned u32x4 __attribute__((ext_vector_type(4)));
constexpr int BM = 256, BK = 64, HALF = 128, HTB = HALF * BK * 2  , STAGE_BYTES = 8 * HTB, NXCD = 8, WGM = 8;

__host__ __device__ __forceinline__ int lds_byte(int r, int c) { const int st = (r >> 4) * 2 + (c >> 5), rr = r & 15, cc = c & 31, ob = rr * 64 + cc * 2; return st * 1024 + (ob ^ (((ob >> 9) & 1) << 5)); }
__host__ __device__ __forceinline__ void stage_rc(int b, int& R, int& C) { const int st = b / 1024, sb = b % 1024, swz = sb ^ (((sb >> 9) & 1) << 5); R = (st >> 1) * 16 + swz / 64; C = (st & 1) * 32 + (swz % 64) / 2; }
__host__ __device__ __forceinline__ int perm32(int rho) { const int n = rho >> 4, i = rho & 15; return 8 * (i >> 2) + 4 * n + (i & 3); }

struct Unit { int pm, pn; };
struct Gemm { const bf16_t* A; const bf16_t* Bt; int M, N, K; int lda; };

struct StaticOrder {
    int nM, nN, nwg, G, c;
    __host__ __device__ void init(int M, int N, int G_, int c_) { nM = M / BM; nN = N / BM; nwg = nM * nN; G = G_; c = c_; }
    __host__ __device__ bool next(int i, Unit& u) const {
        const long L = (long)i * G + c; if (L >= nwg) return false;
        int wgid = (int)L; { const int q = nwg / NXCD, r = nwg % NXCD, xcd = wgid % NXCD, off = wgid / NXCD; wgid = (xcd < r ? xcd * (q + 1) : r * (q + 1) + (xcd - r) * q) + off; }
        const int nig = WGM * nN, gid = wgid / nig, fm = gid * WGM, gsz = (nM - fm) < WGM ? (nM - fm) : WGM;
        u.pm = fm + ((wgid % nig) % gsz); u.pn = (wgid % nig) / gsz; return true;
    }
    __device__ __forceinline__ int acol(const Unit&) const { return 0; }
    __device__ __forceinline__ void a_ready(const Unit&) const {}
    __device__ __forceinline__ void done(const Unit&) const {}
};


__device__ __forceinline__ unsigned cvt_pk_bf16(float lo, float hi) { unsigned r; asm volatile("v_cvt_pk_bf16_f32 %0, %1, %2" : "=v"(r) : "v"(lo), "v"(hi)); return r; }
template <int ACT> struct EpiBf16 {
    static constexpr bool PERM = true, AFTER_DRAIN = false;
    bf16_t* O; int ldc;
    __device__ __forceinline__ void operator()(const f32x4 (&acc)[2][2][4][2], const Unit& u, int wr, int wc, int fr, int fq) const {
        const int row0 = u.pm * BM + wr * 64 + fr, col0 = u.pn * BM + wc * 32 + 8 * fq;
#pragma unroll
        for (int ai = 0; ai < 2; ++ai)
#pragma unroll
            for (int m = 0; m < 4; ++m) { bf16_t* rowp = O + (size_t)(row0 + ai * HALF + m * 16) * ldc + col0;
#pragma unroll
                for (int bj = 0; bj < 2; ++bj) { f32x4 v0 = acc[ai][bj][m][0], v1 = acc[ai][bj][m][1];
                    if (ACT == 1) {
#pragma unroll
                        for (int j = 0; j < 4; ++j) { const float a = fmaxf(v0[j], 0.f), b = fmaxf(v1[j], 0.f); v0[j] = a * a; v1[j] = b * b; } }
                    u32x4 w; w.x = cvt_pk_bf16(v0[0], v0[1]); w.y = cvt_pk_bf16(v0[2], v0[3]); w.z = cvt_pk_bf16(v1[0], v1[1]); w.w = cvt_pk_bf16(v1[2], v1[3]);
                    *(u32x4*)(rowp + bj * HALF) = w; } }
    }
};
struct EpiBf16Late {
    static constexpr bool PERM = true, AFTER_DRAIN = false;
    bf16_t* O; int ldc;
    __device__ __forceinline__ void operator()(const f32x4 (&acc)[2][2][4][2], const Unit& u, int wr, int wc, int, int) const {
        int l_; asm volatile("v_mbcnt_lo_u32_b32 %0, -1, 0\n\tv_mbcnt_hi_u32_b32 %0, -1, %0" : "=v"(l_));
        const int fr = l_ & 15, fq = l_ >> 4;
        const int row0 = u.pm * BM + wr * 64 + fr, col0 = u.pn * BM + wc * 32 + 8 * fq;
#pragma unroll
        for (int ai = 0; ai < 2; ++ai)
#pragma unroll
            for (int m = 0; m < 4; ++m) { bf16_t* rowp = O + (size_t)(row0 + ai * HALF + m * 16) * ldc + col0;
#pragma unroll
                for (int bj = 0; bj < 2; ++bj) { const f32x4 v0 = acc[ai][bj][m][0], v1 = acc[ai][bj][m][1];
                    u32x4 w; w.x = cvt_pk_bf16(v0[0], v0[1]); w.y = cvt_pk_bf16(v0[2], v0[3]); w.z = cvt_pk_bf16(v1[0], v1[1]); w.w = cvt_pk_bf16(v1[2], v1[3]);
                    *(u32x4*)(rowp + bj * HALF) = w; } }
    }
};
struct EpiResBf16 {
    static constexpr bool PERM = true, AFTER_DRAIN = false;
    bf16_t* C; const bf16_t* R; int ldc; float alpha;
    __device__ __forceinline__ void operator()(const f32x4 (&acc)[2][2][4][2], const Unit& u, int wr, int wc, int fr, int fq) const {
        const int row0 = u.pm * BM + wr * 64 + fr, col0 = u.pn * BM + wc * 32 + 8 * fq;
#pragma unroll
        for (int ai = 0; ai < 2; ++ai)
#pragma unroll
            for (int m = 0; m < 4; ++m) { const size_t off = (size_t)(row0 + ai * HALF + m * 16) * ldc + col0;
#pragma unroll
                for (int bj = 0; bj < 2; ++bj) { const u32x4 rv = *(const u32x4*)(R + off + bj * HALF); const f32x4 v0 = acc[ai][bj][m][0], v1 = acc[ai][bj][m][1];
#define PG8_BL(w) __builtin_bit_cast(float, (w) << 16)
#define PG8_BH(w) __builtin_bit_cast(float, (w) & 0xffff0000u)
                    u32x4 w; w.x = cvt_pk_bf16(PG8_BL(rv.x) * alpha + v0[0], PG8_BH(rv.x) * alpha + v0[1]); w.y = cvt_pk_bf16(PG8_BL(rv.y) * alpha + v0[2], PG8_BH(rv.y) * alpha + v0[3]);
                    w.z = cvt_pk_bf16(PG8_BL(rv.z) * alpha + v1[0], PG8_BH(rv.z) * alpha + v1[1]); w.w = cvt_pk_bf16(PG8_BL(rv.w) * alpha + v1[2], PG8_BH(rv.w) * alpha + v1[3]);
#undef PG8_BL
#undef PG8_BH
                    *(u32x4*)(C + off + bj * HALF) = w; } }
    }
};

template <class Epi, class Sched, bool ALIGN_EPI = false, bool SP2 = false, bool GEN = false>
__device__ __forceinline__ void gemm_phase(PG8_LAS unsigned char* lds, const Gemm g, const Sched& S, const Epi& E, int wave_) {
    int lane_; asm volatile("v_mbcnt_lo_u32_b32 %0, -1, 0\n\tv_mbcnt_hi_u32_b32 %0, -1, %0" : "=v"(lane_));
    const int wid = wave_, lane = lane_, tid = wid * 64 + lane, wr = wid >> 2, wc = wid & 3, fr = lane & 15, fq = lane >> 4;
    const int K = g.K, nt = K / BK, lda = GEN ? g.lda : K;
    unsigned voffA[2], voffB[2];
#pragma unroll
    for (int i = 0; i < 2; ++i) { int R, C; stage_rc(tid * 16 + i * 8192, R, C); const int Rb = Epi::PERM ? ((R & ~31) + perm32(R & 31)) : R;
        voffA[i] = (unsigned)(R * lda + C) * 2u; voffB[i] = (unsigned)(Rb * K + C) * 2u; }
    const size_t kstep = (size_t)(BK * 2);
    const size_t hstepB = (size_t)HALF * K * 2, hstepA = (size_t)HALF * lda * 2;
    const size_t tstepB = 2 * hstepB, tstepA = 2 * hstepA;
    const unsigned ldsw = (unsigned)wid * 1024u;
    const int aoff = lds_byte(wr * 64 + fr, fq * 8), boff = lds_byte(wc * 32 + fr, fq * 8);
#define PG8_SA(b, h) (((b) * 2 + (h)) * HTB)
#define PG8_SB(b, h) ((4 + (b) * 2 + (h)) * HTB)
#define PG8_STAGE(bufoff, gbase, voff) do { _Pragma("unroll") for (int _i = 0; _i < 2; ++_i) \
        __builtin_amdgcn_global_load_lds((const unsigned*)((const char*)(gbase) + (voff)[_i]), (PG8_LAS unsigned*)(lds + (bufoff) + ldsw + _i * 8192), 16, 0, 0); } while (0)
#define PG8_LDA(dst, b, h) do { _Pragma("unroll") for (int m = 0; m < 4; ++m) _Pragma("unroll") for (int k = 0; k < 2; ++k) dst[m][k] = *(const PG8_LAS bf16x8*)(lds + PG8_SA(b, h) + aoff + m * 2048 + k * 1024); } while (0)
#define PG8_LDB(dst, b, h) do { _Pragma("unroll") for (int n = 0; n < 2; ++n) _Pragma("unroll") for (int k = 0; k < 2; ++k) dst[n][k] = *(const PG8_LAS bf16x8*)(lds + PG8_SB(b, h) + boff + n * 2048 + k * 1024); } while (0)
#define PG8_MMA(ai, bj, At, Bt) do { __builtin_amdgcn_s_setprio(1); _Pragma("unroll") for (int m = 0; m < 4; ++m) _Pragma("unroll") for (int n = 0; n < 2; ++n) _Pragma("unroll") for (int k = 0; k < 2; ++k) \
        acc[ai][bj][m][n] = __builtin_amdgcn_mfma_f32_16x16x32_bf16(Bt[n][k], At[m][k], acc[ai][bj][m][n], 0, 0, 0); __builtin_amdgcn_s_setprio(0); } while (0)
#define PG8_WAIT_V(n) asm volatile("s_waitcnt vmcnt(" #n ")" ::: "memory")
#define PG8_WAIT_L(n) asm volatile("s_waitcnt lgkmcnt(" #n ")" ::: "memory")
#define PG8_BAR __builtin_amdgcn_s_barrier()
#define PG8_SCHED __builtin_amdgcn_sched_barrier(0)
    Unit cur, nxt; int ui = 0;
    if (!S.next(0, cur)) return;
    f32x4 acc[2][2][4][2];
#pragma unroll
    for (int a = 0; a < 2; ++a)
#pragma unroll
        for (int b = 0; b < 2; ++b)
#pragma unroll
            for (int m = 0; m < 4; ++m)
#pragma unroll
                for (int n = 0; n < 2; ++n) acc[a][b][m][n] = (f32x4){0.f, 0.f, 0.f, 0.f};
    bf16x8 At[4][2], B0[2][2], B1[2][2];
    const char* cA = (const char*)g.A + (size_t)cur.pm * tstepA + (GEN ? S.acol(cur) * 2 : 0); const char* cB = (const char*)g.Bt + (size_t)cur.pn * tstepB;
    S.a_ready(cur);
    if constexpr (SP2) {
        PG8_STAGE(PG8_SB(0, 0), cB, voffB); PG8_STAGE(PG8_SB(0, 1), cB + hstepB, voffB); PG8_STAGE(PG8_SA(0, 0), cA, voffA); PG8_STAGE(PG8_SA(0, 1), cA + hstepA, voffA);
        if (wr == 1) PG8_BAR;
        PG8_WAIT_V(2); PG8_BAR;
        PG8_STAGE(PG8_SB(1, 0), cB + kstep, voffB); PG8_STAGE(PG8_SA(1, 0), cA + kstep, voffA); PG8_STAGE(PG8_SB(1, 1), cB + hstepB + kstep, voffB);
        PG8_WAIT_V(6); PG8_BAR;
    } else {
        PG8_STAGE(PG8_SB(0, 0), cB, voffB); PG8_STAGE(PG8_SA(0, 0), cA, voffA); PG8_STAGE(PG8_SB(0, 1), cB + hstepB, voffB); PG8_STAGE(PG8_SA(0, 1), cA + hstepA, voffA);
        if (wr == 1) PG8_BAR;
        PG8_WAIT_V(4); PG8_BAR;
        PG8_STAGE(PG8_SB(1, 0), cB + kstep, voffB); PG8_STAGE(PG8_SA(1, 0), cA + kstep, voffA); PG8_STAGE(PG8_SB(1, 1), cB + hstepB + kstep, voffB);
        PG8_WAIT_V(6); PG8_BAR;
    }
    for (;;) {
        const bool has_next = S.next(ui + 1, nxt);
        const char* nA = has_next ? (const char*)g.A + (size_t)nxt.pm * tstepA + (GEN ? S.acol(nxt) * 2 : 0) : cA; const char* nB = has_next ? (const char*)g.Bt + (size_t)nxt.pn * tstepB : cB;
        for (int t = 0; t < nt; t += 2) {
            const bool last = (t == nt - 2);
            const char* a1 = cA + (size_t)(t + 1) * kstep;
            const char* a2 = last ? nA : cA + (size_t)(t + 2) * kstep; const char* b2 = last ? nB : cB + (size_t)(t + 2) * kstep;
            const char* a3 = a2 + kstep; const char* b3 = b2 + kstep;
            if (last && has_next) S.a_ready(nxt);
            if constexpr (SP2) {
            PG8_LDB(B0, 0, 0); PG8_LDB(B1, 0, 1); PG8_SCHED; PG8_LDA(At, 0, 0); PG8_STAGE(PG8_SA(1, 1), a1 + hstepA, voffA);
            PG8_WAIT_V(8); PG8_WAIT_L(0); PG8_BAR; PG8_MMA(0, 0, At, B0); PG8_MMA(0, 1, At, B1); PG8_BAR; PG8_SCHED;
            PG8_LDA(At, 0, 1); PG8_STAGE(PG8_SB(0, 0), b2, voffB); PG8_STAGE(PG8_SB(0, 1), b2 + hstepB, voffB); PG8_STAGE(PG8_SA(0, 0), a2, voffA);
            PG8_WAIT_V(8); PG8_WAIT_L(0); PG8_BAR; PG8_MMA(1, 0, At, B0); PG8_MMA(1, 1, At, B1); PG8_BAR; PG8_SCHED;
            PG8_LDB(B0, 1, 0); PG8_LDB(B1, 1, 1); PG8_SCHED; PG8_LDA(At, 1, 0); PG8_STAGE(PG8_SA(0, 1), a2 + hstepA, voffA);
            PG8_WAIT_V(8); PG8_WAIT_L(0); PG8_BAR; PG8_MMA(0, 0, At, B0); PG8_MMA(0, 1, At, B1); PG8_BAR; PG8_SCHED;
            PG8_LDA(At, 1, 1); PG8_STAGE(PG8_SB(1, 0), b3, voffB); PG8_STAGE(PG8_SB(1, 1), b3 + hstepB, voffB); PG8_STAGE(PG8_SA(1, 0), a3, voffA);
            PG8_WAIT_V(8); PG8_WAIT_L(0); PG8_BAR; PG8_MMA(1, 0, At, B0); PG8_MMA(1, 1, At, B1); PG8_BAR; PG8_SCHED;
            } else {
            PG8_LDB(B0, 0, 0); PG8_SCHED; PG8_LDA(At, 0, 0); PG8_STAGE(PG8_SA(1, 1), a1 + hstepA, voffA);
            PG8_WAIT_L(8); PG8_BAR; PG8_WAIT_L(0); PG8_MMA(0, 0, At, B0); PG8_BAR; PG8_SCHED;
            PG8_LDB(B1, 0, 1); PG8_STAGE(PG8_SB(0, 0), b2, voffB);
            PG8_BAR; PG8_WAIT_L(0); PG8_MMA(0, 1, At, B1); PG8_BAR;
            PG8_LDA(At, 0, 1); PG8_STAGE(PG8_SA(0, 0), a2, voffA);
            PG8_BAR; PG8_WAIT_L(0); PG8_MMA(1, 0, At, B0); PG8_BAR; PG8_SCHED;
            PG8_STAGE(PG8_SB(0, 1), b2 + hstepB, voffB);
            PG8_WAIT_V(6); PG8_BAR; PG8_MMA(1, 1, At, B1); PG8_BAR;
            PG8_LDB(B0, 1, 0); PG8_SCHED; PG8_LDA(At, 1, 0); PG8_STAGE(PG8_SA(0, 1), a2 + hstepA, voffA);
            PG8_WAIT_L(8); PG8_BAR; PG8_WAIT_L(0); PG8_MMA(0, 0, At, B0); PG8_BAR; PG8_SCHED;
            PG8_LDB(B1, 1, 1); PG8_STAGE(PG8_SB(1, 0), b3, voffB);
            PG8_BAR; PG8_WAIT_L(0); PG8_MMA(0, 1, At, B1); PG8_BAR;
            PG8_LDA(At, 1, 1); PG8_STAGE(PG8_SA(1, 0), a3, voffA);
            PG8_BAR; PG8_WAIT_L(0); PG8_MMA(1, 0, At, B0); PG8_BAR; PG8_SCHED;
            PG8_STAGE(PG8_SB(1, 1), b3 + hstepB, voffB);
            PG8_WAIT_V(6); PG8_BAR; PG8_MMA(1, 1, At, B1); PG8_BAR;
            }
        }
        if constexpr (ALIGN_EPI) { if (wr == 0) PG8_BAR; }
        if constexpr (!Epi::AFTER_DRAIN) { E(acc, cur, wr, wc, fr, fq); S.done(cur); }
        if (!has_next) break;
#pragma unroll
        for (int a = 0; a < 2; ++a)
#pragma unroll
            for (int b = 0; b < 2; ++b)
#pragma unroll
                for (int m = 0; m < 4; ++m)
#pragma unroll
                    for (int n = 0; n < 2; ++n) acc[a][b][m][n] = (f32x4){0.f, 0.f, 0.f, 0.f};
        cur = nxt; cA = nA; cB = nB; ++ui;
        if constexpr (ALIGN_EPI) { if (wr == 1) PG8_BAR; }
    }
    PG8_WAIT_V(0);
    if constexpr (!ALIGN_EPI) { if (wr == 0) PG8_BAR; }
    PG8_BAR;
    if constexpr (Epi::AFTER_DRAIN) { E.fused(acc, cur, wr, wc, fr, fq, lds, wid, lane); S.done(cur); }
#undef PG8_SA
#undef PG8_SB
#undef PG8_STAGE
#undef PG8_LDA
#undef PG8_LDB
#undef PG8_MMA
#undef PG8_WAIT_V
#undef PG8_WAIT_L
#undef PG8_BAR
#undef PG8_SCHED
}
}


#ifndef PG8_SP2
#define PG8_SP2 true
#endif
#ifndef PG8_ALIGN
#define PG8_ALIGN true
#endif
constexpr int NB = 2, T = 4096, DM = 4096, M = NB * T, DEPTH = 2, HD = 128;
constexpr int DIFF_H = 6, MOBA_H = 10, DSA_H = 10, KVL = 512, IDX_H = 32, IDX_D = 64, DFF = 16384, DIN = 12384, DINM = 12288, NTAIL = 96;
constexpr int O_DQ = 0, O_DK = 1536, O_DV = 3072, O_MQ = 4608, O_MK = 5888, O_MV = 7168, O_CQ = 8448, O_CKV = 9728, O_IQ = 10240, O_IK = 12288, O_IW = 12352;
constexpr float ALPHA = 1.4142135623730951f;
constexpr float LN_EPS = 1e-5f, RMS_EPS = 1e-5f, NEG_INF = -1e30f;
constexpr float SCALE = 0.08838834764831845f;
constexpr int NWAVES = 8;

constexpr size_t MiB = 1u << 20;
constexpr size_t WS_CTL = 0, CTL_ZERO_BYTES = 1 * MiB;
constexpr size_t SZ_WIN = 97 * MiB, SZ_WO = 32 * MiB, SZ_WUP = 128 * MiB, SZ_WDN = 128 * MiB, SZ_WL = SZ_WIN + SZ_WO + SZ_WUP + SZ_WDN;
constexpr size_t WS_W = 1 * MiB;
constexpr size_t WS_WUK = WS_W + 2 * SZ_WL;
constexpr size_t WS_WUVT = WS_WUK + 3 * MiB;
constexpr size_t WS_H = WS_WUVT + 3 * MiB;
constexpr size_t WS_WUVB = WS_H;
constexpr size_t WS_XN = WS_H + 128 * MiB;
constexpr size_t WS_PROJ = WS_XN + 64 * MiB;
constexpr size_t WS_TAIL = WS_PROJ + 192 * MiB;
constexpr size_t WS_Y = WS_TAIL + 3 * MiB;
constexpr size_t WS_Z = WS_Y + 64 * MiB;
constexpr size_t WS_HID = WS_Z + 128 * MiB;
constexpr size_t WS_QLAT = WS_HID + 256 * MiB;
constexpr size_t WS_OLAT = WS_QLAT + 80 * MiB;
constexpr size_t WS_DIFFO = WS_OLAT + 80 * MiB;
constexpr size_t WS_CKVN = WS_DIFFO + 48 * MiB;
constexpr size_t WS_KI = WS_CKVN + 8 * MiB;
constexpr size_t WS_WI = WS_KI + 1 * MiB;
constexpr size_t WS_KMEAN = WS_WI + 1 * MiB;
constexpr size_t WS_MMASK = WS_KMEAN + 1 * MiB;
constexpr size_t WS_SEL = WS_MMASK + 1 * MiB;
constexpr size_t WS_END = WS_SEL + 4 * MiB;
static_assert(WS_END <= (size_t)2047 * MiB, "d_ws map must fit 4x the largest tensor (2048 MiB)");
constexpr int CW_TMO = 0, CW_CODE = 1;
constexpr int CW_BAR = 4096;
constexpr int MAX_LAUNCHES = 40;

constexpr int RING_OFF = 0, RING_BYTES = 159744;
constexpr int LDSCTL_OFF = RING_BYTES, MISC_OFF = LDSCTL_OFF + 320;
constexpr int LDS_BYTES = 163840;
static_assert(MISC_OFF + 128 <= LDS_BYTES, "LDS map");

#define GAS __attribute__((address_space(1)))
#define LAS __attribute__((address_space(3)))
typedef unsigned short bf16;
typedef unsigned v4u __attribute__((ext_vector_type(4)));
typedef unsigned v2u __attribute__((ext_vector_type(2)));
typedef float f32x4 __attribute__((ext_vector_type(4)));
typedef float f32x16 __attribute__((ext_vector_type(16)));
typedef short bf16x8 __attribute__((ext_vector_type(8)));
typedef short s16x4 __attribute__((ext_vector_type(4)));
typedef GAS unsigned gu32;
typedef GAS unsigned long long gu64;
#define RLX_AGENT __ATOMIC_RELAXED, __HIP_MEMORY_SCOPE_AGENT
#define LDS_WAIT() asm volatile("s_waitcnt lgkmcnt(0)" ::: "memory")
#define VM_WAIT() asm volatile("s_waitcnt vmcnt(0)" ::: "memory")
__device__ __forceinline__ unsigned f2bf(float f) { unsigned u = __builtin_bit_cast(unsigned, f); return (u + 0x7fffu + ((u >> 16) & 1u)) >> 16; }
__device__ __forceinline__ unsigned pk2(float lo, float hi) { return f2bf(lo) | (f2bf(hi) << 16); }
__device__ __forceinline__ float bf2f(unsigned short b) { return __builtin_bit_cast(float, (unsigned)b << 16); }
__device__ __forceinline__ float bflo(unsigned w) { return __builtin_bit_cast(float, w << 16); }
__device__ __forceinline__ float bfhi(unsigned w) { return __builtin_bit_cast(float, w & 0xffff0000u); }

__device__ __forceinline__ int lane_now() { int l; asm volatile("v_mbcnt_lo_u32_b32 %0, -1, 0\n\tv_mbcnt_hi_u32_b32 %0, -1, %0" : "=v"(l)); return l; }
__constant__ unsigned char c_bucket[128] = {0, 1, 2, 3, 4, 5, 6, 7, 8, 9, 10, 11, 12, 13, 14, 15, 16, 16, 16, 17, 17, 18, 18, 18, 19, 19, 19, 20, 20, 20, 20, 21, 21, 21, 21, 22, 22, 22, 22, 22, 23, 23, 23, 23, 23, 23, 24, 24, 24, 24, 24, 24, 25, 25, 25, 25, 25, 25, 25, 26, 26, 26, 26, 26, 26, 26, 26, 27, 27, 27, 27, 27, 27, 27, 27, 27, 27, 28, 28, 28, 28, 28, 28, 28, 28, 28, 28, 29, 29, 29, 29, 29, 29, 29, 29, 29, 29, 29, 29, 30, 30, 30, 30, 30, 30, 30, 30, 30, 30, 30, 30, 30, 30, 31, 31, 31, 31, 31, 31, 31, 31, 31, 31, 31, 31, 31, 31, 31};
__device__ __forceinline__ int bucket(int dist) { return dist < 0 ? 0 : (dist > 127 ? 31 : (int)c_bucket[dist]); }


#define XB_TMO      128
#define XB_XCNT(j)  (256  + 64 * (j))
#define XB_XSUB(j)  (1280 + 64 * (j))
#define XB_XGEN(j)  (2304 + 64 * (j))
#define XB_TOP      3328
#define XB_TOPGEN   3392
#define XCD_BAR_WORDS 3456
#define XB_SPIN_CAP (1u << 18)

__device__ __forceinline__ unsigned xb_ld(unsigned* p)              { return __hip_atomic_load(p, __ATOMIC_RELAXED, __HIP_MEMORY_SCOPE_AGENT); }
__device__ __forceinline__ unsigned xb_add(unsigned* p, unsigned v) { return __hip_atomic_fetch_add(p, v, __ATOMIC_RELAXED, __HIP_MEMORY_SCOPE_AGENT); }
__device__ __forceinline__ unsigned xb_xcc_id() { return (unsigned)__builtin_amdgcn_s_getreg((3 << 11) | 20) & 0xFu; }
#define XB_SPIN(cond, bar) do { unsigned _sp = 0; while (cond) { __builtin_amdgcn_s_sleep(1); \
    if ((++_sp & 255u) == 0u) { if (xb_ld(&(bar)[XB_TMO])) break; if (_sp > XB_SPIN_CAP) { atomicAdd(&(bar)[XB_TMO], 1u); break; } } } } while (0)

struct XcdBarrier {
    unsigned* bar; unsigned x;
    int wave;
    volatile LAS unsigned* st;
};

__device__ __forceinline__ XcdBarrier xcd_barrier_post(unsigned* bar, volatile LAS unsigned* st, int wave) {
    XcdBarrier b; b.bar = bar; b.x = xb_xcc_id(); b.st = st; b.wave = wave;
    if (wave == 0 && lane_now() == 0) (void)xb_add(&bar[XB_XCNT(b.x)], 1u);
    return b;
}
__device__ __forceinline__ void xcd_barrier_complete(unsigned* bar, unsigned x, unsigned& nloc, unsigned& nx) {
    const unsigned G = gridDim.x * gridDim.y * gridDim.z;
    unsigned sum, cnt, mine, sp = 0u;
    for (;;) {
        sum = 0u; cnt = 0u; mine = 0u;
#pragma unroll
        for (unsigned j = 0; j < 16; ++j) { const unsigned c = xb_ld(&bar[XB_XCNT(j)]); sum += c; cnt += (c > 0u) ? 1u : 0u; mine = (j == x) ? c : mine; }
        if (sum == G) break;
        __builtin_amdgcn_s_sleep(1);
        if ((++sp & 255u) == 0u) { if (xb_ld(&bar[XB_TMO])) break; if (sp > XB_SPIN_CAP) { atomicAdd(&bar[XB_TMO], 1u); break; } }
    }
    nloc = mine > 0u ? mine : 1u; nx = cnt > 0u ? cnt : 1u;
}

__device__ __forceinline__ void xcd_barrier(const XcdBarrier& b) {
    asm volatile("s_waitcnt vmcnt(0)" ::: "memory");
    __syncthreads();
    if (b.wave == 0 && lane_now() == 0) {
        unsigned* bar = b.bar;
        __builtin_amdgcn_s_waitcnt(0);
        unsigned nloc = b.st[0], nx = b.st[1];
        if (nloc == 0u) { xcd_barrier_complete(bar, b.x, nloc, nx); b.st[0] = nloc; b.st[1] = nx; }
        const unsigned old = xb_add(&bar[XB_XSUB(b.x)], 1u);
        const unsigned gen = old / nloc;
        if (old + 1u == (gen + 1u) * nloc) {
            __builtin_amdgcn_fence(__ATOMIC_RELEASE, "agent");
            asm volatile("s_waitcnt vmcnt(0)" ::: "memory");
            const unsigned og = xb_add(&bar[XB_TOP], 1u);
            const unsigned tg = og / nx;
            if (og + 1u == (tg + 1u) * nx) xb_add(&bar[XB_TOPGEN], 1u);
            else XB_SPIN(xb_ld(&bar[XB_TOPGEN]) == tg, bar);
            __builtin_amdgcn_fence(__ATOMIC_ACQUIRE, "agent");
            xb_add(&bar[XB_XGEN(b.x)], 1u);
            asm volatile("s_waitcnt vmcnt(0)" ::: "memory");
        } else {
            XB_SPIN(xb_ld(&bar[XB_XGEN(b.x)]) == gen, bar);
            __builtin_amdgcn_fence(__ATOMIC_ACQUIRE, "agent");
            asm volatile("s_waitcnt vmcnt(0)" ::: "memory");
        }
    }
    __syncthreads();
}


struct Frame {
    LAS unsigned char* lds;
    volatile LAS unsigned* MISC;
    gu32* ctl;
    int wave;
    int vcu, G;
    unsigned char* ws;
};
#define WSL(F) ws_opaque((F).ws)
#define WAVE(F) int_opaque((F).wave)
#define VCU(F) int_opaque((F).vcu)
__device__ __forceinline__ int int_opaque(int v) { asm volatile("" : "+s"(v)); return v; }
__device__ __forceinline__ unsigned char* ws_opaque(unsigned char* p) { asm volatile("" : "+s"(p)); return p; }
typedef const __attribute__((address_space(4))) char* kseg_t;
__device__ __forceinline__ const float* karg(int i) { kseg_t ka = (kseg_t)__builtin_amdgcn_kernarg_segment_ptr(); asm volatile("" : "+s"(ka)); return *(const float* const __attribute__((address_space(4)))*)(ka + 8 * i); }
__device__ __forceinline__ float wave_sum(float v) {
    v += __builtin_bit_cast(float, __builtin_amdgcn_mov_dpp(__builtin_bit_cast(int, v), 0xB1, 0xF, 0xF, true));
    v += __builtin_bit_cast(float, __builtin_amdgcn_mov_dpp(__builtin_bit_cast(int, v), 0x4E, 0xF, 0xF, true));
    v += __builtin_bit_cast(float, __builtin_amdgcn_mov_dpp(__builtin_bit_cast(int, v), 0x141, 0xF, 0xF, true));
    v += __builtin_bit_cast(float, __builtin_amdgcn_mov_dpp(__builtin_bit_cast(int, v), 0x140, 0xF, 0xF, true));
    { auto r = __builtin_amdgcn_permlane16_swap(__float_as_uint(v), __float_as_uint(v), false, false); v = __uint_as_float(r[0]) + __uint_as_float(r[1]); }
    { auto r = __builtin_amdgcn_permlane32_swap(__float_as_uint(v), __float_as_uint(v), false, false); v = __uint_as_float(r[0]) + __uint_as_float(r[1]); }
    return v;
}
__device__ __forceinline__ void p0_transpose_item(const float* W, int K, int N, bf16* WT, int ldt, LAS float* scr, int item, int lane) {
    const int nblk = N / 32, kb = item / nblk, nb = item % nblk, k0 = 64 * kb, n0 = 32 * nb;
    float wv[32];
#pragma unroll
    for (int i = 0; i < 32; ++i) wv[i] = __builtin_nontemporal_load(W + (size_t)(k0 + 2 * i + (lane >> 5)) * N + n0 + (lane & 31));
#pragma unroll
    for (int i = 0; i < 32; ++i) scr[(2 * i + (lane >> 5)) * 33 + (lane & 31)] = wv[i];
    LDS_WAIT(); asm volatile("" ::: "memory");
    const int c = lane & 7;
#pragma unroll
    for (int j = 0; j < 4; ++j) { const int n = (lane >> 3) + 8 * j; const LAS float* s = scr + (8 * c) * 33 + n;
        v4u o; o.x = pk2(s[0 * 33], s[1 * 33]); o.y = pk2(s[2 * 33], s[3 * 33]); o.z = pk2(s[4 * 33], s[5 * 33]); o.w = pk2(s[6 * 33], s[7 * 33]);
        __builtin_nontemporal_store(o, (GAS v4u*)(WT + (size_t)(n0 + n) * ldt + k0 + 8 * c)); }
    LDS_WAIT(); asm volatile("" ::: "memory");
}
template <bool IN_BF16>
__device__ __forceinline__ void ln_row(int lane, const void* zrow, const float* g, const float* b, float* hrow, bf16* xrow) {
    f32x4 v[16]; float s = 0.f;
    if (IN_BF16) { const GAS v2u* zr = (const GAS v2u*)zrow + lane;
#pragma unroll
        for (int j = 0; j < 16; ++j) { const v2u w = zr[64 * j]; v[j] = (f32x4){bflo(w.x), bfhi(w.x), bflo(w.y), bfhi(w.y)}; s += (v[j].x + v[j].y) + (v[j].z + v[j].w); } }
    else { const GAS f32x4* zr = (const GAS f32x4*)zrow + lane;
#pragma unroll
        for (int j = 0; j < 16; ++j) { v[j] = zr[64 * j]; s += (v[j].x + v[j].y) + (v[j].z + v[j].w); } }
    const float mean = wave_sum(s) * (1.f / DM); float s2 = 0.f;
#pragma unroll
    for (int j = 0; j < 16; ++j) { v[j] = v[j] - mean; s2 += (v[j].x * v[j].x + v[j].y * v[j].y) + (v[j].z * v[j].z + v[j].w * v[j].w); }
    const float rstd = 1.f / sqrtf(wave_sum(s2) * (1.f / DM) + LN_EPS);
    const GAS f32x4* gr = (const GAS f32x4*)g + lane; const GAS f32x4* br = (const GAS f32x4*)b + lane;
#pragma unroll
    for (int j = 0; j < 16; ++j) { const f32x4 o = v[j] * rstd * gr[64 * j] + br[64 * j];
        if (hrow) ((GAS f32x4*)hrow + lane)[64 * j] = o;
        if (xrow) ((GAS unsigned long long*)xrow + lane)[64 * j] = (unsigned long long)pk2(o.x, o.y) | ((unsigned long long)pk2(o.z, o.w) << 32); }
}
#ifndef LN_NR
#define LN_NR 4
#endif
template <int NR>
__device__ __forceinline__ void ln_rows(int lane, const bf16* Z, size_t rstride, const float* g, const float* b, float* Fout, bf16* Xout) {
    v4u w[NR][8];
#pragma unroll
    for (int r = 0; r < NR; ++r) { const GAS v4u* zr = (const GAS v4u*)(Z + r * rstride) + lane;
#pragma unroll
        for (int j = 0; j < 8; ++j) w[r][j] = zr[64 * j]; }
    float mean[NR], rstd[NR];
#define LN_X8(W, x) const float x##0 = bflo(W.x), x##1 = bfhi(W.x), x##2 = bflo(W.y), x##3 = bfhi(W.y), x##4 = bflo(W.z), x##5 = bfhi(W.z), x##6 = bflo(W.w), x##7 = bfhi(W.w)
#pragma unroll
    for (int r = 0; r < NR; ++r) { float s = 0.f;
#pragma unroll
        for (int j = 0; j < 8; ++j) { LN_X8(w[r][j], x); s += ((x0 + x1) + (x2 + x3)) + ((x4 + x5) + (x6 + x7)); }
        mean[r] = s; }
#define LN_OPAQUE() do { _Pragma("unroll") for (int r = 0; r < NR; ++r) _Pragma("unroll") for (int j = 0; j < 8; ++j) asm volatile("" : "+v"(w[r][j].x), "+v"(w[r][j].y), "+v"(w[r][j].z), "+v"(w[r][j].w)); } while (0)
    LN_OPAQUE();
#pragma unroll
    for (int r = 0; r < NR; ++r) mean[r] = wave_sum(mean[r]) * (1.f / DM);
#pragma unroll
    for (int r = 0; r < NR; ++r) { float q = 0.f; const float mu = mean[r];
#pragma unroll
        for (int j = 0; j < 8; ++j) { LN_X8(w[r][j], x); const float d0 = x0 - mu, d1 = x1 - mu, d2 = x2 - mu, d3 = x3 - mu, d4 = x4 - mu, d5 = x5 - mu, d6 = x6 - mu, d7 = x7 - mu;
            q += ((d0 * d0 + d1 * d1) + (d2 * d2 + d3 * d3)) + ((d4 * d4 + d5 * d5) + (d6 * d6 + d7 * d7)); }
        rstd[r] = q; }
    LN_OPAQUE();
#pragma unroll
    for (int r = 0; r < NR; ++r) rstd[r] = 1.f / sqrtf(wave_sum(rstd[r]) * (1.f / DM) + LN_EPS);
    const GAS f32x4* gr = (const GAS f32x4*)g + 2 * lane; const GAS f32x4* br = (const GAS f32x4*)b + 2 * lane;
#pragma unroll
    for (int j = 0; j < 8; ++j) { const f32x4 g0 = gr[128 * j], g1 = gr[128 * j + 1], b0 = br[128 * j], b1 = br[128 * j + 1];
#pragma unroll
        for (int r = 0; r < NR; ++r) { const float mu = mean[r], rs = rstd[r]; LN_X8(w[r][j], x);
            const f32x4 o0 = (f32x4){(x0 - mu) * rs, (x1 - mu) * rs, (x2 - mu) * rs, (x3 - mu) * rs} * g0 + b0, o1 = (f32x4){(x4 - mu) * rs, (x5 - mu) * rs, (x6 - mu) * rs, (x7 - mu) * rs} * g1 + b1;
            if (Fout) { GAS f32x4* fo = (GAS f32x4*)(Fout + r * rstride) + 2 * lane + 128 * j; fo[0] = o0; fo[1] = o1; }
            if (Xout) { v4u ow; ow.x = pk2(o0.x, o0.y); ow.y = pk2(o0.z, o0.w); ow.z = pk2(o1.x, o1.y); ow.w = pk2(o1.z, o1.w); ((GAS v4u*)(Xout + r * rstride) + lane)[64 * j] = ow; } } }
#undef LN_OPAQUE
#undef LN_X8
}
__device__ __forceinline__ bf16* w_layer(Frame& F, int l, int which) {
    const size_t o = WS_W + (size_t)l * SZ_WL + (which == 0 ? 0 : which == 1 ? SZ_WIN : which == 2 ? SZ_WIN + SZ_WO : SZ_WIN + SZ_WO + SZ_WUP);
    return (bf16*)(WSL(F) + o);
}
__device__ __forceinline__ void p0_prologue(Frame& F) {
    const int lane = lane_now();
    const int w_ = WAVE(F); LAS float* scr = (LAS float*)(F.lds + RING_OFF + w_ * 16384);
    const int gw = VCU(F) * NWAVES + w_, NGW = F.G * NWAVES;
    constexpr int I_IN = (DM / 64) * (DIN / 32), I_O = (DM / 64) * (DM / 32), I_UP = (DM / 64) * (DFF / 32), I_DN = (DFF / 64) * (DM / 32), I_UV = (KVL / 64) * (HD / 32) * DSA_H;
    constexpr int PER_L = I_IN + I_O + I_UP + I_DN + I_UV, NITEMS = DEPTH * PER_L;
    for (int it = gw; it < NITEMS; it += NGW) {
        const int l = it / PER_L; int r = it - l * PER_L;
        if (r < I_IN) { p0_transpose_item(karg(4) + (size_t)l * DM * DIN, DM, DIN, w_layer(F, l, 0), DM, scr, r, lane); continue; } r -= I_IN;
        if (r < I_O) { p0_transpose_item(karg(10) + (size_t)l * DM * DM, DM, DM, w_layer(F, l, 1), DM, scr, r, lane); continue; } r -= I_O;
        if (r < I_UP) { p0_transpose_item(karg(13) + (size_t)l * DM * DFF, DM, DFF, w_layer(F, l, 2), DM, scr, r, lane); continue; } r -= I_UP;
        if (r < I_DN) { p0_transpose_item(karg(14) + (size_t)l * DFF * DM, DFF, DM, w_layer(F, l, 3), DFF, scr, r, lane); continue; } r -= I_DN;
        { const int h = r / ((KVL / 64) * (HD / 32)), rr = r % ((KVL / 64) * (HD / 32));
          p0_transpose_item(karg(9) + ((size_t)l * DSA_H + h) * KVL * HD, KVL, HD, (bf16*)(WSL(F) + WS_WUVB) + ((size_t)(l * 5 + (h >> 1)) * 256 + (h & 1) * 128) * 1024 + (h & 1) * 512, 1024, scr, rr, lane); }
    }
    { const v4u z = {0u, 0u, 0u, 0u};
      for (int i = gw * 64 + lane; i < DEPTH * 5 * 2 * HD * (KVL / 8); i += NGW * 64) { const int c8 = i & 63, d = (i >> 6) & 127, e = (i >> 13) & 1, lp = i >> 14;
          *(GAS v4u*)((bf16*)(WSL(F) + WS_WUVB) + ((size_t)lp * 256 + e * 128 + d) * 1024 + (1 - e) * 512 + c8 * 8) = z; } }
    { const GAS f32x4* src = (const GAS f32x4*)karg(8); GAS v2u* dst = (GAS v2u*)(WSL(F) + WS_WUK); const int n4 = DEPTH * DSA_H * KVL * HD / 4;
      for (int i = gw * 64 + lane; i < n4; i += NGW * 64) { const f32x4 v = src[i]; v2u o; o.x = pk2(v.x, v.y); o.y = pk2(v.z, v.w); dst[i] = o; } }
    for (int m = gw; m < M; m += NGW) ln_row<false>(lane, karg(0) + (size_t)m * DM, karg(1), karg(2), nullptr, (bf16*)(WSL(F) + WS_XN) + (size_t)m * DM);
}
__device__ __forceinline__ void tail_phase(Frame& F, const bf16* XN, const bf16* WT, float* TAIL) {
    LAS float* part = (LAS float*)(F.lds + RING_OFF);
    const int lane = lane_now();
    const int w = WAVE(F), fr = lane & 15, fq = lane >> 4;
    for (int unit = VCU(F); unit < M / 32; unit += F.G) {
        const int m0 = unit * 32;
        f32x4 acc[2][6];
#pragma unroll
        for (int i = 0; i < 2; ++i)
#pragma unroll
            for (int j = 0; j < 6; ++j) acc[i][j] = (f32x4){0.f, 0.f, 0.f, 0.f};
        const bf16* ap = XN + (size_t)(m0 + fr) * DM + w * 512 + 8 * fq; const bf16* bp = WT + (size_t)fr * DM + w * 512 + 8 * fq;
#pragma unroll 4
        for (int ks = 0; ks < 16; ++ks) {
            bf16x8 a[2], b[6];
#pragma unroll
            for (int i = 0; i < 2; ++i) a[i] = *(const GAS bf16x8*)(ap + (size_t)i * 16 * DM + ks * 32);
#pragma unroll
            for (int j = 0; j < 6; ++j) b[j] = *(const GAS bf16x8*)(bp + (size_t)j * 16 * DM + ks * 32);
#pragma unroll
            for (int i = 0; i < 2; ++i)
#pragma unroll
                for (int j = 0; j < 6; ++j) acc[i][j] = __builtin_amdgcn_mfma_f32_16x16x32_bf16(a[i], b[j], acc[i][j], 0, 0, 0);
        }
#pragma unroll
        for (int i = 0; i < 2; ++i)
#pragma unroll
            for (int j = 0; j < 6; ++j)
#pragma unroll
                for (int r = 0; r < 4; ++r) part[(w * 32 + i * 16 + fq * 4 + r) * 96 + j * 16 + fr] = acc[i][j][r];
        __syncthreads();
        for (int o = w * 64 + lane; o < 32 * 96; o += NWAVES * 64) { float s = 0.f;
#pragma unroll
            for (int ww = 0; ww < 8; ++ww) s += part[ww * 32 * 96 + o];
            TAIL[(size_t)m0 * 96 + o] = s; }
        __syncthreads();
    }
}
__device__ __forceinline__ void ln_phase(Frame& F, const bf16* Z, const float* g, const float* b, float* Fout, bf16* Xout) {
    const int lane = lane_now();
    const int gw = VCU(F) * NWAVES + WAVE(F), NGW = F.G * NWAVES;
    int m = gw; const size_t rs_ = (size_t)NGW * DM;
    for (; m + (LN_NR - 1) * NGW < M; m += LN_NR * NGW) { const size_t o = (size_t)m * DM; ln_rows<LN_NR>(lane, Z + o, rs_, g, b, Fout ? Fout + o : nullptr, Xout ? Xout + o : nullptr); }
    for (; m < M; m += NGW) ln_row<true>(lane, Z + (size_t)m * DM, g, b, Fout ? Fout + (size_t)m * DM : nullptr, Xout ? Xout + (size_t)m * DM : nullptr);
}

__constant__ unsigned short c_attn_sched[256][4] = {{660,132,65535,65535},{661,133,65535,65535},{662,134,65535,65535},{663,135,65535,65535},{664,136,65535,65535},{665,137,65535,65535},{666,138,65535,65535},{667,139,65535,65535},{668,140,65535,65535},{669,141,65535,65535},{670,142,65535,65535},{671,143,65535,65535},{672,144,65535,65535},{673,145,65535,65535},{674,146,65535,65535},{675,147,65535,65535},{676,148,65535,65535},{677,149,65535,65535},{678,150,65535,65535},{679,151,65535,65535},{680,152,65535,65535},{681,153,65535,65535},{682,154,65535,65535},{683,155,65535,65535},{616,196,65535,65535},{617,197,65535,65535},{618,198,65535,65535},{619,199,65535,65535},{620,288,65535,65535},{621,289,65535,65535},{622,290,65535,65535},{623,291,65535,65535},{624,292,65535,65535},{625,293,65535,65535},{626,294,65535,65535},{627,295,65535,65535},{628,296,65535,65535},{629,297,65535,65535},{630,298,65535,65535},{631,299,65535,65535},{632,300,65535,65535},{633,301,65535,65535},{634,302,65535,65535},{635,303,65535,65535},{636,304,65535,65535},{637,305,65535,65535},{638,306,65535,65535},{639,307,65535,65535},{572,348,65535,65535},{573,349,65535,65535},{574,350,65535,65535},{575,351,65535,65535},{576,176,28,65535},{577,177,29,65535},{578,178,30,65535},{579,179,31,65535},{580,180,32,65535},{581,181,33,65535},{582,182,34,65535},{583,183,35,65535},{584,184,36,65535},{585,185,37,65535},{586,186,38,65535},{587,187,39,65535},{588,188,40,65535},{589,189,41,65535},{590,190,42,65535},{591,191,43,65535},{592,192,65535,65535},{593,193,65535,65535},{594,194,65535,65535},{595,195,65535,65535},{528,388,65535,65535},{529,389,65535,65535},{530,390,65535,65535},{531,391,65535,65535},{532,392,65535,65535},{533,393,65535,65535},{534,394,65535,65535},{535,395,65535,65535},{536,332,12,65535},{537,333,13,65535},{538,334,14,65535},{539,335,15,65535},{540,336,16,65535},{541,337,17,65535},{542,338,18,65535},{543,339,19,65535},{544,340,20,65535},{545,341,21,65535},{546,342,22,65535},{547,343,23,65535},{548,344,24,65535},{549,345,25,65535},{550,346,26,65535},{551,347,27,65535},{484,232,128,65535},{485,233,129,65535},{486,234,130,65535},{487,235,131,65535},{488,236,68,65535},{489,237,69,65535},{490,238,70,65535},{491,239,71,65535},{492,240,72,65535},{493,241,73,65535},{494,242,74,65535},{495,243,75,65535},{496,376,76,65535},{497,377,77,65535},{498,378,78,65535},{499,379,79,65535},{500,380,80,65535},{501,381,81,65535},{502,382,82,65535},{503,383,83,65535},{504,384,84,65535},{505,385,85,65535},{506,386,86,65535},{507,387,87,65535},{440,428,48,65535},{441,429,49,65535},{442,430,50,65535},{443,431,51,65535},{444,432,52,65535},{445,433,53,65535},{446,434,54,65535},{447,435,55,65535},{448,436,56,65535},{449,437,57,65535},{450,438,58,65535},{451,439,59,65535},{452,220,244,65535},{453,221,245,65535},{454,222,246,65535},{455,223,247,65535},{456,224,248,65535},{457,225,249,65535},{458,226,250,65535},{459,227,251,65535},{460,228,252,65535},{461,229,253,65535},{462,230,254,65535},{463,231,255,65535},{684,276,60,65535},{685,277,61,65535},{686,278,62,65535},{687,279,63,65535},{688,280,64,65535},{689,281,65,65535},{690,282,66,65535},{691,283,67,65535},{692,284,112,65535},{693,285,113,65535},{694,286,114,65535},{695,287,115,65535},{696,420,216,65535},{697,421,217,65535},{698,422,218,65535},{699,423,219,65535},{700,424,88,65535},{701,425,89,65535},{702,426,90,65535},{703,427,91,65535},{396,516,0,65535},{397,517,1,65535},{398,518,2,65535},{399,519,3,65535},{400,520,4,65535},{401,521,5,65535},{402,522,6,65535},{403,523,7,65535},{404,524,8,65535},{405,525,9,65535},{406,526,10,65535},{407,527,11,65535},{408,464,92,65535},{409,465,93,65535},{410,466,94,65535},{411,467,95,65535},{412,468,96,65535},{413,469,97,65535},{414,470,98,65535},{415,471,99,65535},{416,472,100,65535},{417,473,101,65535},{418,474,102,65535},{419,475,103,65535},{640,476,104,65535},{641,477,105,65535},{642,478,106,65535},{643,479,107,65535},{644,480,108,65535},{645,481,109,65535},{646,482,110,65535},{647,483,111,65535},{648,264,256,65535},{649,265,257,65535},{650,266,258,65535},{651,267,259,65535},{652,268,260,65535},{653,269,261,65535},{654,270,262,65535},{655,271,263,65535},{656,272,200,65535},{657,273,201,65535},{658,274,202,65535},{659,275,203,65535},{596,320,156,65535},{597,321,157,65535},{598,322,158,65535},{599,323,159,65535},{600,324,160,65535},{601,325,161,65535},{602,326,162,65535},{603,327,163,65535},{604,328,164,65535},{605,329,165,65535},{606,330,166,65535},{607,331,167,65535},{608,508,168,65535},{609,509,169,65535},{610,510,170,65535},{611,511,171,65535},{612,512,172,65535},{613,513,173,65535},{614,514,174,65535},{615,515,175,65535},{352,560,116,65535},{353,561,117,65535},{354,562,118,65535},{355,563,119,65535},{356,564,120,65535},{357,565,121,65535},{358,566,122,65535},{359,567,123,65535},{360,568,124,65535},{361,569,125,65535},{362,570,126,65535},{363,571,127,65535},{364,308,204,65535},{365,309,205,65535},{366,310,206,65535},{367,311,207,65535},{368,312,208,65535},{369,313,209,65535},{370,314,210,65535},{371,315,211,65535},{372,316,212,65535},{373,317,213,65535},{374,318,214,65535},{375,319,215,65535},{552,556,44,65535},{553,557,45,65535},{554,558,46,65535},{555,559,47,65535}};


namespace fa {
constexpr int NW = 8, QBLK = 32, KVBLK = 64, QB = NW * QBLK, D = 128;
constexpr int SHM_V = KVBLK * D * 2, SHM_K = KVBLK * D * 2;
constexpr int NSLOT = 3, SLOT = SHM_K + 2 * SHM_V;
constexpr int OFF_RING = 0, OFF_WS = OFF_RING + NSLOT * SLOT, OFF_BT = OFF_WS + NW * 64 * 4, BT_PAD = 96, BT_N = BT_PAD + 256, LDS_BYTES = OFF_BT + BT_N * 4;
constexpr float THR = 8.f;
#define KSWZ(row, colB) ((row) * 256 + ((colB) ^ (((row) & 7) << 4)))
#define SBAR() __builtin_amdgcn_sched_barrier(0)
__device__ __forceinline__ int v_st(int k, int c) { const int kk = (k & ~0xC) | ((k & 4) << 1) | ((k & 8) >> 1); return ((kk >> 3) * 4 + (c >> 5)) * 512 + ((kk & 7) * 32 + (c & 31)) * 2; }
__device__ __forceinline__ int v_rd_base(int lane) { return ((lane & 3) << 3) | (((lane >> 2) & 3) << 6) | (((lane >> 4) & 1) << 5) | (((lane >> 5) & 1) << 8); }
constexpr int v_rd_off(int d0, int ks, int half) { return d0 * 512 + ks * 4096 + half * 2048; }
__device__ __forceinline__ int crow(int r, int hi) { return (r & 3) + 8 * (r >> 2) + 4 * hi; }
__device__ __forceinline__ unsigned cvtpk(float lo, float hi) { unsigned r; asm volatile("v_cvt_pk_bf16_f32 %0, %1, %2" : "=v"(r) : "v"(lo), "v"(hi)); return r; }

__device__ __forceinline__ void bias_mask_tile(f32x16& p0, f32x16& p1, int dq, const LAS float* bt) {
    const float NEG = -__builtin_inff();
    const LAS float* b = bt + BT_PAD + dq - 59;
#pragma unroll
    for (int r = 0; r < 16; ++r) {
        const int c = (r & 3) + 8 * (r >> 2);
        const float v0 = b[59 - c], v1 = b[59 - c - 32];
        p0[r] = (dq - c) >= 0 ? p0[r] + v0 : NEG;
        p1[r] = (dq - c - 32) >= 0 ? p1[r] + v1 : NEG;
    }
}
__device__ __forceinline__ void partialSM(f32x16& p0, f32x16& p1, float& m_reg, float& alpha, float bc) {
    float pmax = p0[0];
#pragma unroll
    for (int r = 1; r < 16; ++r) pmax = fmaxf(pmax, p0[r]);
#pragma unroll
    for (int r = 0; r < 16; ++r) pmax = fmaxf(pmax, p1[r]);
    { auto rr = __builtin_amdgcn_permlane32_swap(__float_as_uint(pmax), __float_as_uint(pmax), false, false);
      pmax = fmaxf(__uint_as_float(rr[0]), __uint_as_float(rr[1])); }
    pmax += bc;
    constexpr float C2 = 1.4426950408889634f * SCALE;
    float mn;
    if (__builtin_expect(__all((pmax - m_reg) * SCALE <= THR), 1)) { mn = m_reg; alpha = 1.f; }
    else { mn = fmaxf(m_reg, pmax); alpha = __builtin_amdgcn_exp2f((m_reg - mn) * C2); m_reg = mn; }
    const float mnL = (bc - mn) * C2;
#pragma unroll
    for (int r = 0; r < 16; ++r) p0[r] = __builtin_amdgcn_exp2f(fmaf(p0[r], C2, mnL));
#pragma unroll
    for (int r = 0; r < 16; ++r) p1[r] = __builtin_amdgcn_exp2f(fmaf(p1[r], C2, mnL));
}
__device__ __forceinline__ void finishSM(f32x16& p0, f32x16& p1, float alpha, float& l_reg, bf16x8& pa0, bf16x8& pa1, bf16x8& pa2, bf16x8& pa3) {
    float ps = 0;
#pragma unroll
    for (int r = 0; r < 16; ++r) ps += p0[r];
#pragma unroll
    for (int r = 0; r < 16; ++r) ps += p1[r];
    { auto rr = __builtin_amdgcn_permlane32_swap(__float_as_uint(ps), __float_as_uint(ps), false, false);
      ps = __uint_as_float(rr[0]) + __uint_as_float(rr[1]); }
    l_reg = l_reg * alpha + ps;
#define PK4(P, B_, OUT) do { unsigned a0 = cvtpk(P[B_+0], P[B_+1]), a1 = cvtpk(P[B_+2], P[B_+3]);                          \
        unsigned b0 = cvtpk(P[B_+4], P[B_+5]), b1 = cvtpk(P[B_+6], P[B_+7]);                                             \
        auto r0 = __builtin_amdgcn_permlane32_swap(a0, b0, false, false); auto r1 = __builtin_amdgcn_permlane32_swap(a1, b1, false, false); \
        v4u w = {r0[0], r1[0], r0[1], r1[1]}; OUT = __builtin_bit_cast(bf16x8, w); } while (0)
    PK4(p0, 0, pa0); PK4(p0, 8, pa1); PK4(p1, 0, pa2); PK4(p1, 8, pa3);
#undef PK4
}
__device__ __forceinline__ void qkt(f32x16& p0, f32x16& p1, const LAS char* Kb, int r32, int hi, const bf16x8* qr) {
    p0 = f32x16{}; p1 = f32x16{};
    const LAS char* kb[4];
#pragma unroll
    for (int dd = 0; dd < 4; ++dd) kb[dd] = Kb + KSWZ(r32, (dd * 16 + hi * 8) * 2);
#pragma unroll
    for (int d0 = 0; d0 < 8; ++d0) { const LAS char* a = kb[d0 & 3] + (d0 >> 2) * 128;
        const bf16x8 b0 = *(const LAS bf16x8*)a;
        const bf16x8 b1 = *(const LAS bf16x8*)(a + 32 * 256);
        p0 = __builtin_amdgcn_mfma_f32_32x32x16_bf16(b0, qr[d0], p0, 0, 0, 0);
        p1 = __builtin_amdgcn_mfma_f32_32x32x16_bf16(b1, qr[d0], p1, 0, 0, 0); }
}
__device__ __forceinline__ void pv_tile(f32x16* o, int vb0, bf16x8 pa0, bf16x8 pa1, bf16x8 pa2, bf16x8 pa3) {
#define TRRD(dst, off) asm volatile("ds_read_b64_tr_b16 %0, %1 offset:%2" : "=&v"(dst) : "v"(vb0), "i"(off) : "memory")
#define PV_D0(d0) do { s16x4 l0, l1, l2, l3, h0, h1, h2, h3; constexpr int b_ = v_rd_off(d0, 0, 0);   \
        TRRD(l0, b_); TRRD(h0, b_ + 2048); TRRD(l1, b_ + 4096); TRRD(h1, b_ + 6144); TRRD(l2, b_ + 8192); TRRD(h2, b_ + 10240); TRRD(l3, b_ + 12288); TRRD(h3, b_ + 14336); \
        asm volatile("s_waitcnt lgkmcnt(0)" ::: "memory"); SBAR();   \
        o[d0] = __builtin_amdgcn_mfma_f32_32x32x16_bf16((bf16x8){l0[0], l0[1], l0[2], l0[3], h0[0], h0[1], h0[2], h0[3]}, pa0, o[d0], 0, 0, 0);   \
        o[d0] = __builtin_amdgcn_mfma_f32_32x32x16_bf16((bf16x8){l1[0], l1[1], l1[2], l1[3], h1[0], h1[1], h1[2], h1[3]}, pa1, o[d0], 0, 0, 0);   \
        o[d0] = __builtin_amdgcn_mfma_f32_32x32x16_bf16((bf16x8){l2[0], l2[1], l2[2], l2[3], h2[0], h2[1], h2[2], h2[3]}, pa2, o[d0], 0, 0, 0);   \
        o[d0] = __builtin_amdgcn_mfma_f32_32x32x16_bf16((bf16x8){l3[0], l3[1], l3[2], l3[3], h3[0], h3[1], h3[2], h3[3]}, pa3, o[d0], 0, 0, 0); } while (0)
    PV_D0(0); PV_D0(1); PV_D0(2); PV_D0(3);
#undef PV_D0
#undef TRRD
}

template <bool MOBA, int VW>
__device__ __forceinline__ void unit(LAS unsigned char* lds, const bf16* Q, const bf16* K, const bf16* V, bf16* O, int ldq, int ldk, int ldv, int ldo, int P0,
                                     const float* biascol, const unsigned* mmask, int mstride, int wave) {
    const int wid = wave, lane = lane_now(), tid = wid * 64 + lane, r32 = lane & 31, hi = lane >> 5;
    LAS float* wsf = (LAS float*)(lds + OFF_WS) + wid * 64; LAS float* li_l = wsf; LAS float* al_l = wsf + 32;
    LAS float* bt = (LAS float*)(lds + OFF_BT);
    const float bfar = biascol[31 * 32] * (1.f / SCALE);
    const int NT = (P0 + QB) / KVBLK;
    const int qlo = P0 + wid * QBLK, qm = qlo + r32 - 4 * hi;
    const int own = P0 >> 8;
    unsigned mw = 0u; if (MOBA) mw = mmask[(size_t)(qlo + r32) * mstride];
    float m_reg = -1e30f, l_reg = 0.f; f32x16 o[4 * VW] = {};
    const int vrb = v_rd_base(lane);
    bf16x8 qr[8];
#pragma unroll
    for (int d0 = 0; d0 < 8; ++d0) qr[d0] = *(const GAS bf16x8*)(Q + (size_t)(qlo + r32) * ldq + d0 * 16 + hi * 8);
#define FA_ISSUE(t_) do { const int sl_ = (t_) % NSLOT; const bf16* kt_ = K + (size_t)((t_) * KVBLK) * ldk; const bf16* vt_ = V + (size_t)((t_) * KVBLK) * ldv; \
        int ln_ = lane; asm volatile("" : "+v"(ln_));     \
        _Pragma("unroll") for (int jj = 0; jj < 2; ++jj) { const int j_ = 2 * wid + jj, row_ = 4 * j_ + (ln_ >> 4), ks_ = row_ * ldk + (((ln_ & 15) ^ (row_ & 7)) << 3); \
            const int s_ = 2 * j_ + (ln_ >> 5), kk_ = (s_ >> 2) * 8 + ((ln_ & 31) >> 2), c_ = (s_ & 3) * 32 + (ln_ & 3) * 8, key_ = (kk_ & ~0xC) | ((kk_ & 4) << 1) | ((kk_ & 8) >> 1), vs_ = key_ * ldv + c_; \
            __builtin_amdgcn_global_load_lds((const GAS unsigned*)(kt_ + ks_), (LAS unsigned*)(lds + OFF_RING + sl_ * SLOT + (2 * wid + jj) * 1024), 16, 0, 0); \
            _Pragma("unroll") for (int vh_ = 0; vh_ < VW; ++vh_) __builtin_amdgcn_global_load_lds((const GAS unsigned*)(vt_ + vs_ + vh_ * 128), (LAS unsigned*)(lds + OFF_RING + sl_ * SLOT + SHM_K + vh_ * SHM_V + (2 * wid + jj) * 1024), 16, 0, 0); } } while (0)
    __syncthreads();
    for (int i = tid; i < BT_N; i += NW * 64) { const int d = i - BT_PAD; bt[i] = biascol[bucket(d < 0 ? 0 : d) * 32] * (1.f / SCALE); }
    asm volatile("s_waitcnt vmcnt(0) lgkmcnt(0)" ::: "memory");
    FA_ISSUE(0); if (NT > 1) FA_ISSUE(1);
    for (int t = 0; t < NT; ++t) {
        const int kb = t * KVBLK; const LAS unsigned char* slot = lds + OFF_RING + (t % NSLOT) * SLOT;
        if (t + 1 < NT) { if (VW == 2) asm volatile("s_waitcnt vmcnt(6)" ::: "memory"); else asm volatile("s_waitcnt vmcnt(4)" ::: "memory"); } else asm volatile("s_waitcnt vmcnt(0)" ::: "memory");
        __builtin_amdgcn_s_barrier();
        asm volatile("" ::: "memory"); SBAR();
        if (t + 2 < NT) FA_ISSUE(t + 2);
        if (kb <= qlo + QBLK - 1) {
        f32x16 p0, p1; float alpha; bf16x8 pa0, pa1, pa2, pa3;
        qkt(p0, p1, (const LAS char*)slot, r32, hi, qr);
        const bool near = kb + KVBLK - 1 > qlo - 113;
        float bc = near ? 0.f : bfar;
        if (MOBA) { const int n = kb >> 8; if (n < own && !((mw >> n) & 1u)) bc = -__builtin_inff(); }
        if (near) bias_mask_tile(p0, p1, qm - kb, bt);
        partialSM(p0, p1, m_reg, alpha, bc);
        finishSM(p0, p1, alpha, l_reg, pa0, pa1, pa2, pa3);
        if (__any(alpha < 1.f)) {
#pragma unroll
            for (int d_ = 0; d_ < 4 * VW; ++d_)
#pragma unroll
                for (int r = 0; r < 16; ++r) o[d_][r] *= alpha; }
        SBAR();
        pv_tile(o, (int)(unsigned)(size_t)(slot + SHM_K) + vrb, pa0, pa1, pa2, pa3);
        if (VW == 2) pv_tile(o + 4, (int)(unsigned)(size_t)(slot + SHM_K + SHM_V) + vrb, pa0, pa1, pa2, pa3);
        }
    }
#undef FA_ISSUE
    { const float rl = __builtin_amdgcn_rcpf(l_reg);
      bf16* Ow = O + (size_t)(qlo + r32) * ldo + hi * 8;
#ifndef REP_FAEPI
#define REP_FAEPI 1
#endif
      for (int rep_ = 0; rep_ < REP_FAEPI; ++rep_)
#pragma unroll
      for (int d0 = 0; d0 < 4 * VW; ++d0)
#pragma unroll
          for (int g = 0; g < 4; g += 2) {
              unsigned ax = cvtpk(o[d0][4 * g] * rl, o[d0][4 * g + 1] * rl), ay = cvtpk(o[d0][4 * g + 2] * rl, o[d0][4 * g + 3] * rl);
              unsigned bx = cvtpk(o[d0][4 * g + 4] * rl, o[d0][4 * g + 5] * rl), by = cvtpk(o[d0][4 * g + 6] * rl, o[d0][4 * g + 7] * rl);
              asm volatile("s_nop 1" : "+v"(ax), "+v"(ay), "+v"(bx), "+v"(by));
              { auto r_ = __builtin_amdgcn_permlane32_swap(ax, bx, false, false); ax = r_[0]; bx = r_[1]; }
              { auto r_ = __builtin_amdgcn_permlane32_swap(ay, by, false, false); ay = r_[0]; by = r_[1]; }
              const v4u w = {ax, ay, bx, by};
              *(GAS v4u*)(Ow + d0 * 32 + g * 8) = w; } }
}
#undef KSWZ
#undef SBAR
}


__device__ __forceinline__ float lambda_init_of(int l) { return l == 0 ? 0.2f : 0.35550906759096925f; }

__device__ __forceinline__ void prep_phase(Frame& F, int l) {
    const int lane = lane_now();
    const int wv_ = WAVE(F), gw = VCU(F) * NWAVES + wv_, NGW = F.G * NWAVES;
    const bf16* PROJ = (const bf16*)(WSL(F) + WS_PROJ); const float* TAIL = (const float*)(WSL(F) + WS_TAIL);
    bf16* CKVN = (bf16*)(WSL(F) + WS_CKVN); bf16* KI = (bf16*)(WSL(F) + WS_KI); float* WI = (float*)(WSL(F) + WS_WI); float* KMEAN = (float*)(WSL(F) + WS_KMEAN);
    const float* kvg = karg(7) + (size_t)l * KVL;
    const f32x4 g0 = *(const GAS f32x4*)(kvg + lane * 8), g1 = *(const GAS f32x4*)(kvg + lane * 8 + 4);
    for (int m = gw; m < M; m += NGW) {
        const v4u cw = *(const GAS v4u*)(PROJ + (size_t)m * DINM + O_CKV + lane * 8);
        float c[8] = {bflo(cw.x), bfhi(cw.x), bflo(cw.y), bfhi(cw.y), bflo(cw.z), bfhi(cw.z), bflo(cw.w), bfhi(cw.w)};
        float ss = 0.f;
#pragma unroll
        for (int j = 0; j < 8; ++j) ss += c[j] * c[j];
        const float r = 1.f / sqrtf(wave_sum(ss) * (1.f / KVL) + RMS_EPS);
        v4u o; o.x = pk2(c[0] * r * g0.x, c[1] * r * g0.y); o.y = pk2(c[2] * r * g0.z, c[3] * r * g0.w); o.z = pk2(c[4] * r * g1.x, c[5] * r * g1.y); o.w = pk2(c[6] * r * g1.z, c[7] * r * g1.w);
        *(GAS v4u*)(CKVN + (size_t)m * KVL + lane * 8) = o;
        const float kv = TAIL[(size_t)m * NTAIL + lane];
        const float mean = wave_sum(kv) * (1.f / 64.f); const float d = kv - mean;
        const float var = wave_sum(d * d) * (1.f / 64.f);
        KI[(size_t)m * 64 + lane] = (bf16)f2bf(d / sqrtf(var + LN_EPS));
        if (lane < 32) WI[(size_t)m * 32 + lane] = TAIL[(size_t)m * NTAIL + 64 + lane] * (0.17677669529663687f * 0.125f);
    }
    { LAS float* red = (LAS float*)(F.lds + RING_OFF);
      for (int it = VCU(F); it < NB * MOBA_H * 16; it += F.G) {
        const int n = it & 15, bh = it >> 4, b = bh / MOBA_H, h = bh % MOBA_H;
        const bf16* kp = PROJ + (size_t)(b * T + n * 256 + wv_ * 32) * DINM + O_MK + h * HD + 2 * lane; unsigned wq[32];
#pragma unroll
        for (int j = 0; j < 32; ++j) wq[j] = *(const GAS unsigned*)(kp + (size_t)j * DINM);
        float s0 = 0.f, s1 = 0.f;
#pragma unroll
        for (int j = 0; j < 32; ++j) { s0 += bflo(wq[j]); s1 += bfhi(wq[j]); }
        __syncthreads();
        red[wv_ * 128 + 2 * lane] = s0; red[wv_ * 128 + 2 * lane + 1] = s1;
        __syncthreads();
        if (wv_ == 0) { float a0 = 0.f, a1 = 0.f;
#pragma unroll
            for (int ww = 0; ww < 8; ++ww) { a0 += red[ww * 128 + 2 * lane]; a1 += red[ww * 128 + 2 * lane + 1]; }
            KMEAN[(size_t)it * HD + 2 * lane] = a0 * (1.f / 256.f); KMEAN[(size_t)it * HD + 2 * lane + 1] = a1 * (1.f / 256.f); }
      } }
}
__device__ __forceinline__ float quad_sum(float v) {
    v += __builtin_bit_cast(float, __builtin_amdgcn_mov_dpp(__builtin_bit_cast(int, v), 0xB1, 0xF, 0xF, true));
    v += __builtin_bit_cast(float, __builtin_amdgcn_mov_dpp(__builtin_bit_cast(int, v), 0x4E, 0xF, 0xF, true));
    return v;
}
#ifdef MS_CHECK
__device__ __forceinline__ unsigned ms_ref_mask(float g, int own) {
    float v1 = 0.f, v2 = 0.f, v3 = 0.f; int i1 = -1, i2 = -1, i3 = -1;
#pragma unroll
    for (int nn = 0; nn < 15; ++nn) { const float gg = __builtin_bit_cast(float, __builtin_amdgcn_readlane(__builtin_bit_cast(int, g), 4 * nn));
        if (nn < own) {
            if (i1 < 0 || gg > v1) { v3 = v2; i3 = i2; v2 = v1; i2 = i1; v1 = gg; i1 = nn; }
            else if (i2 < 0 || gg > v2) { v3 = v2; i3 = i2; v2 = gg; i2 = nn; }
            else if (i3 < 0 || gg > v3) { v3 = gg; i3 = nn; } } }
    unsigned mask = 0u; if (i1 >= 0) mask |= 1u << i1; if (i2 >= 0) mask |= 1u << i2; if (i3 >= 0) mask |= 1u << i3;
    return mask;
}
#define MS_CHK(g_, mask_, row_) do { if (ms_ref_mask(g_, own) != ((mask_) ^ MS_CHECK_XOR) && lane == 0) ((unsigned short*)(WSL(F) + WS_XN))[(size_t)(row_) * DM] = 0x7FC0; } while (0)
#else
#define MS_CHK(g_, mask_, row_) do { } while (0)
#endif
__device__ __forceinline__ int quads_max(int v) {
    { const int o = __builtin_amdgcn_mov_dpp(v, 0x141, 0xF, 0xF, true); v = v > o ? v : o; }
    { const int o = __builtin_amdgcn_mov_dpp(v, 0x140, 0xF, 0xF, true); v = v > o ? v : o; }
    { auto r = __builtin_amdgcn_permlane16_swap((unsigned)v, (unsigned)v, false, false); const int a = (int)r[0], c = (int)r[1]; v = a > c ? a : c; }
    { auto r = __builtin_amdgcn_permlane32_swap((unsigned)v, (unsigned)v, false, false); const int a = (int)r[0], c = (int)r[1]; v = a > c ? a : c; }
    return v;
}
__device__ __forceinline__ void moba_select_phase(Frame& F) {
    const int lane = lane_now();
    const int wv_ = WAVE(F), gw = VCU(F) * NWAVES + wv_, NGW = F.G * NWAVES, n = lane >> 2, part = lane & 3;
    const bf16* PROJ = (const bf16*)(WSL(F) + WS_PROJ); const float* KMEAN = (const float*)(WSL(F) + WS_KMEAN); unsigned* MMASK = (unsigned*)(WSL(F) + WS_MMASK);
    for (int m4 = gw; m4 < M / 4; m4 += NGW) {
        const int m0 = m4 * 4, b = m0 / T, own = (m0 % T) >> 8;
        f32x4 kmA[8], kmB[8]; v4u qA[4][4], qB[4][4];
#define MS_LOAD(KM, QQ, h_) do { const float* kp_ = KMEAN + ((size_t)((b * MOBA_H + (h_)) * 16 + n)) * HD + part * 32; \
        _Pragma("unroll") for (int i = 0; i < 8; ++i) KM[i] = n < own ? *(const GAS f32x4*)(kp_ + 4 * i) : (f32x4){0.f, 0.f, 0.f, 0.f}; \
        _Pragma("unroll") for (int tk = 0; tk < 4; ++tk) { const bf16* qp_ = PROJ + (size_t)(m0 + tk) * DINM + O_MQ + (h_) * HD + part * 32; \
            _Pragma("unroll") for (int i = 0; i < 4; ++i) QQ[tk][i] = *(const GAS v4u*)(qp_ + 8 * i); } } while (0)
#define MS_HEAD(KM, QQ, h_) do { _Pragma("unroll") for (int tk = 0; tk < 4; ++tk) { float g = 0.f; \
            _Pragma("unroll") for (int i = 0; i < 4; ++i) { const v4u qw = QQ[tk][i]; \
                g += bflo(qw.x) * KM[2 * i].x + bfhi(qw.x) * KM[2 * i].y + bflo(qw.y) * KM[2 * i].z + bfhi(qw.y) * KM[2 * i].w \
                   + bflo(qw.z) * KM[2 * i + 1].x + bfhi(qw.z) * KM[2 * i + 1].y + bflo(qw.w) * KM[2 * i + 1].z + bfhi(qw.w) * KM[2 * i + 1].w; } \
            g = quad_sum(g); \
              \
            int key_ = __builtin_bit_cast(int, g); key_ ^= (key_ >> 31) & 0x7FFFFFFF; bool live_ = n < own; unsigned mask = 0u; \
            _Pragma("unroll") for (int rd_ = 0; rd_ < 3; ++rd_) { const int mx_ = quads_max(live_ ? key_ : (int)0x80000000); \
                const unsigned long long bal_ = __ballot(live_ && key_ == mx_); \
                if (bal_) { const int sel_ = (int)(__builtin_ctzll(bal_) >> 2); mask |= 1u << sel_; live_ = live_ && n != sel_; } } \
            MS_CHK(g, mask, m0 + tk); \
            if (lane == 0) MMASK[(size_t)(m0 + tk) * MOBA_H + (h_)] = mask; } } while (0)
        MS_LOAD(kmA, qA, 0);
        for (int h = 0; h < MOBA_H; h += 2) {
            MS_LOAD(kmB, qB, h + 1);
            MS_HEAD(kmA, qA, h);
            if (h + 2 < MOBA_H) MS_LOAD(kmA, qA, h + 2);
            MS_HEAD(kmB, qB, h + 1);
        }
#undef MS_LOAD
#undef MS_HEAD
#undef MS_CHK
    }
}
__device__ __forceinline__ void attn_phase(Frame& F) {
    const bf16* PROJ = (const bf16*)(WSL(F) + WS_PROJ); bf16* DIFFO = (bf16*)(WSL(F) + WS_DIFFO); bf16* Y = (bf16*)(WSL(F) + WS_Y);
    const unsigned* MMASK = (const unsigned*)(WSL(F) + WS_MMASK); const float* tab = karg(3);
    constexpr int ND = NB * DIFF_H * 2, PER_QB = ND + NB * MOBA_H, NU = 16 * PER_QB;
    const int vcu_ = VCU(F), wave_ = WAVE(F);
    for (int r = 0;; ++r) {
        int i;
        if (F.G == 256) { if (r >= 4) break; const int id = (int)c_attn_sched[vcu_][r]; if (id == 0xFFFF) break; i = (15 - id / PER_QB) * PER_QB + id % PER_QB; }
        else { i = r * F.G + ((r & 1) ? F.G - 1 - vcu_ : vcu_); if (i >= NU) break; }
        const int qb = 15 - i / PER_QB, j = i % PER_QB, P0 = qb * 256;
        if (j < ND) {
            const int b = j / (DIFF_H * 2), vh = j % (DIFF_H * 2), h = vh >> 1, mp = vh & 1;
            const bf16* base = PROJ + (size_t)(b * T) * DINM;
#ifdef DIFF_VW1_CHECK
            for (int vh_ = 0; vh_ < 2; ++vh_)
                fa::unit<false, 1>(F.lds + RING_OFF, base + O_DQ + h * 256 + mp * 128, base + O_DK + h * 256 + mp * 128, base + O_DV + h * 256 + vh_ * 128,
                                   DIFFO + (size_t)(b * T) * (DIFF_H * 512) + (h * 2 + mp) * 256 + vh_ * 128, DINM, DINM, DINM, DIFF_H * 512, P0, tab + h * 2 + mp, nullptr, 0, wave_);
#else
            fa::unit<false, 2>(F.lds + RING_OFF, base + O_DQ + h * 256 + mp * 128, base + O_DK + h * 256 + mp * 128, base + O_DV + h * 256,
                               DIFFO + (size_t)(b * T) * (DIFF_H * 512) + (h * 2 + mp) * 256, DINM, DINM, DINM, DIFF_H * 512, P0, tab + h * 2 + mp, nullptr, 0, wave_);
#endif
        } else {
            const int jj = j - ND, b = jj / MOBA_H, h = jj % MOBA_H;
            const bf16* base = PROJ + (size_t)(b * T) * DINM;
            fa::unit<true, 1>(F.lds + RING_OFF, base + O_MQ + h * HD, base + O_MK + h * HD, base + O_MV + h * HD, Y + (size_t)(b * T) * DM + 1536 + h * HD, DINM, DINM, DINM, DM, P0,
                              tab + 12 + h, MMASK + (size_t)(b * T) * MOBA_H + h, MOBA_H, wave_);
        }
    }
}
__device__ __forceinline__ void post_phase(Frame& F, int l) {
    const int lane = lane_now();
    const int wv_ = WAVE(F), gw = VCU(F) * NWAVES + wv_, NGW = F.G * NWAVES;
    const bf16* DIFFO = (const bf16*)(WSL(F) + WS_DIFFO); bf16* Y = (bf16*)(WSL(F) + WS_Y);
    const float* lv = karg(5) + (size_t)l * 512; const float* sg = karg(6) + (size_t)l * 256;
    const float e1 = wave_sum(lv[lane] * lv[128 + lane] + lv[64 + lane] * lv[192 + lane]), e2 = wave_sum(lv[256 + lane] * lv[384 + lane] + lv[320 + lane] * lv[448 + lane]);
    const float li = lambda_init_of(l), lam = expf(e1) - expf(e2) + li;
    const f32x4 g = *(const GAS f32x4*)(sg + lane * 4);
    for (int it0 = gw * 4; it0 < M * DIFF_H; it0 += NGW * 4) {
        v2u a[4], c[4];
#pragma unroll
        for (int u = 0; u < 4; ++u) { const int it = it0 + u, m = it / DIFF_H, h = it % DIFF_H; const bf16* p = DIFFO + (size_t)m * (DIFF_H * 512) + h * 512 + lane * 4;
            a[u] = *(const GAS v2u*)p; c[u] = *(const GAS v2u*)(p + 256); }
#pragma unroll
        for (int u = 0; u < 4; ++u) { const int it = it0 + u, m = it / DIFF_H, h = it % DIFF_H;
            const float o0 = bflo(a[u].x) - lam * bflo(c[u].x), o1 = bfhi(a[u].x) - lam * bfhi(c[u].x), o2 = bflo(a[u].y) - lam * bflo(c[u].y), o3 = bfhi(a[u].y) - lam * bfhi(c[u].y);
            const float r = 1.f / sqrtf(wave_sum(o0 * o0 + o1 * o1 + o2 * o2 + o3 * o3) * (1.f / 256.f) + RMS_EPS) * (1.f - li);
            v2u o; o.x = pk2(o0 * r * g.x, o1 * r * g.y); o.y = pk2(o2 * r * g.z, o3 * r * g.w);
            *(GAS v2u*)(Y + (size_t)m * DM + h * 256 + lane * 4) = o; }
    }
}


template <int KK, int NCT>
__device__ __forceinline__ void sg_unit(const bf16* A, int lda, const bf16* B, bf16* C, int ldc, int lane) {
    const int fr = lane & 15, fq = lane >> 4;
    f32x4 acc[2][NCT];
#pragma unroll
    for (int i = 0; i < 2; ++i)
#pragma unroll
        for (int j = 0; j < NCT; ++j) acc[i][j] = (f32x4){0.f, 0.f, 0.f, 0.f};
    const bf16* ap = A + (size_t)fr * lda + 8 * fq; const bf16* bp = B + (size_t)(8 * (fr >> 2) + (fr & 3)) * KK + 8 * fq;
#pragma unroll 4
    for (int ks = 0; ks < KK / 32; ++ks) {
        bf16x8 a[2], b[NCT];
#pragma unroll
        for (int i = 0; i < 2; ++i) a[i] = *(const GAS bf16x8*)(ap + (size_t)i * 16 * lda + ks * 32);
#pragma unroll
        for (int j = 0; j < NCT; ++j) b[j] = *(const GAS bf16x8*)(bp + (size_t)((j >> 1) * 32 + 4 * (j & 1)) * KK + ks * 32);
#pragma unroll
        for (int i = 0; i < 2; ++i)
#pragma unroll
            for (int j = 0; j < NCT; ++j) acc[i][j] = __builtin_amdgcn_mfma_f32_16x16x32_bf16(b[j], a[i], acc[i][j], 0, 0, 0);
    }
#pragma unroll
    for (int i = 0; i < 2; ++i)
#pragma unroll
        for (int jp = 0; jp < NCT / 2; ++jp) { v4u o; o.x = pk2(acc[i][2 * jp][0], acc[i][2 * jp][1]); o.y = pk2(acc[i][2 * jp][2], acc[i][2 * jp][3]);
            o.z = pk2(acc[i][2 * jp + 1][0], acc[i][2 * jp + 1][1]); o.w = pk2(acc[i][2 * jp + 1][2], acc[i][2 * jp + 1][3]);
            *(GAS v4u*)(C + (size_t)(i * 16 + fr) * ldc + jp * 32 + 8 * fq) = o; }
}
__device__ __forceinline__ void qlat_phase(Frame& F, int l) {
    const int lane = lane_now();
    const int gw = VCU(F) * NWAVES + WAVE(F), NGW = F.G * NWAVES;
    const bf16* PROJ = (const bf16*)(WSL(F) + WS_PROJ); const bf16* WUK = (const bf16*)(WSL(F) + WS_WUK) + (size_t)l * DSA_H * KVL * HD; bf16* QLAT = (bf16*)(WSL(F) + WS_QLAT);
    for (int wu = gw; wu < (M / 32) * DSA_H * 4; wu += NGW) { const int tt = wu / (DSA_H * 4), rem = wu % (DSA_H * 4), h = rem >> 2, cg = rem & 3;
        sg_unit<HD, 8>(PROJ + (size_t)(tt * 32) * DINM + O_CQ + h * HD, DINM, WUK + ((size_t)h * KVL + cg * 128) * HD, QLAT + (size_t)(tt * 32) * (DSA_H * KVL) + h * KVL + cg * 128, DSA_H * KVL, lane); }
}
__device__ __forceinline__ void dsa_out_phase(Frame& F, int l) {
    const int lane = lane_now();
    const int gw = VCU(F) * NWAVES + WAVE(F), NGW = F.G * NWAVES;
    const bf16* OLAT = (const bf16*)(WSL(F) + WS_OLAT); const bf16* WUVT = (const bf16*)(WSL(F) + WS_WUVT) + (size_t)l * DSA_H * HD * KVL; bf16* Y = (bf16*)(WSL(F) + WS_Y);
    for (int wu = gw; wu < (M / 32) * DSA_H * 2; wu += NGW) { const int tt = wu / (DSA_H * 2), rem = wu % (DSA_H * 2), h = rem >> 1, cg = rem & 1;
        sg_unit<KVL, 4>(OLAT + (size_t)(tt * 32) * (DSA_H * KVL) + h * KVL, DSA_H * KVL, WUVT + ((size_t)h * HD + cg * 64) * KVL, Y + (size_t)(tt * 32) * DM + 2816 + h * HD + cg * 64, DM, lane); }
}

typedef short v4i16_t __attribute__((ext_vector_type(4)));
namespace dsa {
constexpr int G = 4;
constexpr int KT = 256, KSTR = 144;
constexpr int NB1 = 1024;
constexpr int SZ_KI = KT * KSTR, OFF_KI = 0, OFF_SC = 2 * SZ_KI, OFF_HIST = OFF_SC + G * 16384, OFF_SEL = OFF_HIST + G * NB1 * 4, OFF_CNT = OFF_SEL + G * 512  , CNT_W = 64  , LDS_END = OFF_CNT + G * CNT_W * 4;
static_assert(LDS_END <= RING_BYTES, "dsa select LDS map");
__device__ __forceinline__ unsigned fkey(float f) { const unsigned u = __float_as_uint(f); return (u & 0x80000000u) ? ~u : (u | 0x80000000u); }
__device__ __forceinline__ int crow(int r, int hi) { return (r & 3) + 8 * (r >> 2) + 4 * hi; }
}
__device__ __forceinline__ void dsa_select_phase(Frame& F) {
    using namespace dsa;
    const int lane = lane_now(), w = WAVE(F), tid = w * 64 + lane, g = w >> 1, par = w & 1, r32 = lane & 31, hi = lane >> 5;
    LAS unsigned char* L = F.lds + RING_OFF;
    LAS float* sc = (LAS float*)(L + OFF_SC) + g * 4096; LAS unsigned* hist = (LAS unsigned*)(L + OFF_HIST) + g * NB1;
    LAS unsigned* bmp = (LAS unsigned*)(L + OFF_SEL) + g * 128; LAS unsigned* cnt = (LAS unsigned*)(L + OFF_CNT) + g * CNT_W;
    LAS unsigned* cnt_all = (LAS unsigned*)(L + OFF_CNT);
    const bf16* PROJ = (const bf16*)(WSL(F) + WS_PROJ); const bf16* KI = (const bf16*)(WSL(F) + WS_KI); const float* WI = (const float*)(WSL(F) + WS_WI); unsigned short* SEL = (unsigned short*)(WSL(F) + WS_SEL);
    constexpr int NGRP = M / G; const int vcu_ = VCU(F);
    for (int rr = 0;; ++rr) {
        const int i = rr * F.G + ((rr & 1) ? F.G - 1 - vcu_ : vcu_); if (i >= NGRP) break;
        const int b = i & 1, t0 = T - G - G * (i >> 1), t = t0 + g; const size_t row = (size_t)b * T + t;
        if (t0 + G - 1 < 256) {
            if (par == 0) { const unsigned e = lane * 4; v2u o; o.x = e | ((e + 1) << 16); o.y = (e + 2) | ((e + 3) << 16); *(GAS v2u*)(SEL + row * 256 + lane * 4) = o; }
            continue; }
        bf16x8 aq[4]; float wv[16];
#pragma unroll
        for (int ks = 0; ks < 4; ++ks) aq[ks] = *(const GAS bf16x8*)(PROJ + row * DINM + O_IQ + r32 * IDX_D + 16 * ks + 8 * hi);
#pragma unroll
        for (int r = 0; r < 16; ++r) wv[r] = WI[row * IDX_H + crow(r, hi)];
        const int ntile = (t0 + G - 1) / KT + 1;
        const bf16* kib = KI + (size_t)b * T * IDX_D;
        v4u sa0, sa1, sa2, sa3, sb0, sb1, sb2, sb3;
        const int p0k = tid >> 3, p0c = tid & 7;
#define DS_LOAD(R, tl) do { const bf16* s_ = kib + (size_t)((tl) * KT + p0k) * IDX_D + p0c * 8; R##0 = *(const GAS v4u*)s_; R##1 = *(const GAS v4u*)(s_ + 64 * IDX_D); R##2 = *(const GAS v4u*)(s_ + 128 * IDX_D); R##3 = *(const GAS v4u*)(s_ + 192 * IDX_D); } while (0)
#define DS_WRITE(R, bf) do { LAS unsigned char* d_ = L + OFF_KI + (bf) * SZ_KI + p0k * KSTR + p0c * 16; *(LAS v4u*)d_ = R##0; *(LAS v4u*)(d_ + 64 * KSTR) = R##1; *(LAS v4u*)(d_ + 128 * KSTR) = R##2; *(LAS v4u*)(d_ + 192 * KSTR) = R##3; } while (0)
        __syncthreads();
        if (tid < G * CNT_W) cnt_all[tid] = 0u;
        ((LAS unsigned*)(L + OFF_SEL))[tid] = 0u;
        DS_LOAD(sa, 0); if (ntile > 1) DS_LOAD(sb, 1);
        DS_WRITE(sa, 0);
        __syncthreads();
        float smin = 3.0e38f, smax = -3.0e38f;
#define DS_MF(ACC, sb_) do { ACC = (f32x16){}; _Pragma("unroll") for (int ks = 0; ks < 4; ++ks) ACC = __builtin_amdgcn_mfma_f32_32x32x16_bf16(aq[ks], kf[sb_][ks], ACC, 0, 0, 0); } while (0)
#define DS_EP(ACC, sb_, tl) do { const int key = (tl) * KT + (par + 2 * (sb_)) * 32 + r32; float s = 0.f; \
            _Pragma("unroll") for (int r = 0; r < 16; ++r) { const int ai_ = __float_as_int(ACC[r]); s += wv[r] * __int_as_float(ai_ > 0 ? ai_ : 0); }   \
            { auto rr = __builtin_amdgcn_permlane32_swap(__float_as_uint(s), __float_as_uint(s), false, false); s = __uint_as_float(rr[0]) + __uint_as_float(rr[1]); } \
            if (hi == 0 && key <= t) { sc[key] = s; smin = fminf(smin, s); smax = fmaxf(smax, s); } } while (0)
#define DS_STEP(tl, RL, RW) do { const int bufi = (tl) & 1; \
            if ((tl) + 2 < ntile) DS_LOAD(RL, (tl) + 2); \
            { const unsigned kbase = (unsigned)(size_t)(L + OFF_KI + bufi * SZ_KI + (par * 32 + r32) * KSTR + 16 * hi); \
              bf16x8 kf[4][4]; \
              _Pragma("unroll") for (int sb_ = 0; sb_ < 4; ++sb_) \
                  _Pragma("unroll") for (int ks = 0; ks < 4; ++ks) asm volatile("ds_read_b128 %0, %1 offset:%2" : "=v"(kf[sb_][ks]) : "v"(kbase), "i"(sb_ * 64 * KSTR + ks * 32) : "memory"); \
                \
              f32x16 accA, accB; \
              asm volatile("s_waitcnt lgkmcnt(12)" ::: "memory"); __builtin_amdgcn_sched_barrier(0); DS_MF(accA, 0); __builtin_amdgcn_sched_barrier(0); \
              asm volatile("s_waitcnt lgkmcnt(8)" ::: "memory"); __builtin_amdgcn_sched_barrier(0); DS_MF(accB, 1); __builtin_amdgcn_sched_barrier(0); \
              DS_EP(accA, 0, tl); __builtin_amdgcn_sched_barrier(0); \
              asm volatile("s_waitcnt lgkmcnt(4)" ::: "memory"); __builtin_amdgcn_sched_barrier(0); DS_MF(accA, 2); __builtin_amdgcn_sched_barrier(0); \
              DS_EP(accB, 1, tl); __builtin_amdgcn_sched_barrier(0); \
              asm volatile("s_waitcnt lgkmcnt(0)" ::: "memory"); __builtin_amdgcn_sched_barrier(0); DS_MF(accB, 3); __builtin_amdgcn_sched_barrier(0); \
              DS_EP(accA, 2, tl); __builtin_amdgcn_sched_barrier(0); \
              DS_EP(accB, 3, tl); } \
            if ((tl) + 1 < ntile) DS_WRITE(RW, bufi ^ 1); \
            asm volatile("s_waitcnt lgkmcnt(0)" ::: "memory"); __builtin_amdgcn_s_barrier(); asm volatile("" ::: "memory");   } while (0)
        for (int tl = 0; tl < ntile; tl += 2) { DS_STEP(tl, sa, sb); if (tl + 1 < ntile) DS_STEP(tl + 1, sb, sa); }
#undef DS_STEP
#undef DS_MF
#undef DS_EP
#undef DS_LOAD
#undef DS_WRITE
#ifndef REP_SELSTAGE
#define REP_SELSTAGE 1
#endif
        for (int rep_ = 0; rep_ < REP_SELSTAGE; ++rep_) {
        if (rep_) { __syncthreads(); if (tid < G * CNT_W) cnt_all[tid] = 0u; __syncthreads(); }
#pragma unroll
        for (int o = 1; o < 64; o <<= 1) { smin = fminf(smin, __shfl_xor(smin, o)); smax = fmaxf(smax, __shfl_xor(smax, o)); }
        if (lane == 0) { cnt[4 + 2 * par] = __float_as_uint(smin); cnt[5 + 2 * par] = __float_as_uint(smax); }
        for (int e = tid; e < G * NB1; e += NWAVES * 64) ((LAS unsigned*)(L + OFF_HIST))[e] = 0u;
        __syncthreads();
        const float lo = fminf(__uint_as_float(cnt[4]), __uint_as_float(cnt[6])), hi_ = fmaxf(__uint_as_float(cnt[5]), __uint_as_float(cnt[7]));
        const float bscale = hi_ > lo ? ((float)NB1 - 0.5f) / (hi_ - lo) : 0.f;
        const int n = t + 1;
        for (int e0 = par * 64 + lane; e0 < n; e0 += 512) {
            float sv_[4];
#pragma unroll
            for (int u = 0; u < 4; ++u) sv_[u] = sc[(e0 + 128 * u) & 4095];
#pragma unroll
            for (int u = 0; u < 4; ++u) if (e0 + 128 * u < n) { int bin = (int)((sv_[u] - lo) * bscale); bin = bin > NB1 - 1 ? NB1 - 1 : bin;
                __hip_atomic_fetch_add(&hist[bin], 1u, __ATOMIC_RELAXED, __HIP_MEMORY_SCOPE_WORKGROUP); } }
        __syncthreads();
        int B1, need; unsigned hB1;
        { unsigned hh[16]; unsigned tot = 0;
#pragma unroll
          for (int q = 0; q < 4; ++q) { const v4u v = *(const LAS v4u*)&hist[16 * lane + 4 * q]; hh[4 * q] = v.x; hh[4 * q + 1] = v.y; hh[4 * q + 2] = v.z; hh[4 * q + 3] = v.w; tot += v.x + v.y + v.z + v.w; }
          unsigned suf = tot;
#pragma unroll
          for (int o = 1; o < 64; o <<= 1) { const unsigned v = __shfl_down(suf, o); if (lane + o < 64) suf += v; }
          const unsigned long long bal = __ballot(suf >= 256u);
          const int ls = 63 - __builtin_clzll(bal | 1ull);
          unsigned cum = suf - tot; int bb = 0; unsigned cg = 0, hb = 0; bool found = false;
#pragma unroll
          for (int q = 15; q >= 0; --q) { if (!found) { if (cum + hh[q] >= 256u) { bb = q; cg = cum; hb = hh[q]; found = true; } else cum += hh[q]; } }
          B1 = 16 * ls + __shfl(bb, ls); need = 256 - (int)__shfl(cg, ls); hB1 = __shfl(hb, ls); }
        if (lane == 0 && par == 0) { unsigned z_ = 0u; asm volatile("" : "+v"(z_)); cnt[2] = ~z_; cnt[3] = z_; }
        __syncthreads();
        LAS unsigned short* cand = (LAS unsigned short*)(cnt + 8);
        { unsigned kmn = 0xFFFFFFFFu, kmx = 0u;
          for (int e0 = par * 64 + lane; e0 < n; e0 += 512) { float sv_[4];
#pragma unroll
            for (int u = 0; u < 4; ++u) sv_[u] = sc[(e0 + 128 * u) & 4095];
#pragma unroll
            for (int u = 0; u < 4; ++u) { const int e = e0 + 128 * u; if (e < n) { const float s = sv_[u]; int bin = (int)((s - lo) * bscale); bin = bin > NB1 - 1 ? NB1 - 1 : bin;
              if (bin > B1) __hip_atomic_fetch_or(&bmp[e >> 5], 1u << (e & 31), __ATOMIC_RELAXED, __HIP_MEMORY_SCOPE_WORKGROUP);
              else if (bin == B1) { const unsigned pos = __hip_atomic_fetch_add(&cnt[0], 1u, __ATOMIC_RELAXED, __HIP_MEMORY_SCOPE_WORKGROUP); if (pos < 64u) cand[pos] = (unsigned short)e;
                  const unsigned k = fkey(s); kmn = k < kmn ? k : kmn; kmx = k > kmx ? k : kmx; } } } }
          if (hB1 > 64u) {
#pragma unroll
              for (int o = 1; o < 64; o <<= 1) { const unsigned a = __shfl_xor(kmn, o), c2 = __shfl_xor(kmx, o); kmn = a < kmn ? a : kmn; kmx = c2 > kmx ? c2 : kmx; }
              if (lane == 0) { __hip_atomic_fetch_min(&cnt[2], kmn, __ATOMIC_RELAXED, __HIP_MEMORY_SCOPE_WORKGROUP); __hip_atomic_fetch_max(&cnt[3], kmx, __ATOMIC_RELAXED, __HIP_MEMORY_SCOPE_WORKGROUP); } } }
        if (lane == 0 && par == 0) cnt[1] = hB1 > 64u ? 0u : 1u;
        for (int e = tid; e < G * NB1; e += NWAVES * 64) ((LAS unsigned*)(L + OFF_HIST))[e] = 0u;
        __syncthreads();
        if (hB1 <= 64u) {
            if (par == 0) { const int nc = (int)hB1; const int me = lane < nc ? (int)cand[lane] : 0; const unsigned mk = lane < nc ? fkey(sc[me]) : 0u; int rank = 0;
                for (int jn = 0; jn < nc; ++jn) { const int oe = __builtin_amdgcn_readlane(me, jn); const unsigned ok = (unsigned)__builtin_amdgcn_readlane((int)mk, jn); rank += (ok > mk || (ok == mk && oe < me)) ? 1 : 0; }
                if (lane < nc && rank < need) __hip_atomic_fetch_or(&bmp[me >> 5], 1u << (me & 31), __ATOMIC_RELAXED, __HIP_MEMORY_SCOPE_WORKGROUP); } }
        const bool any_fb = (cnt_all[1] + cnt_all[CNT_W + 1] + cnt_all[2 * CNT_W + 1] + cnt_all[3 * CNT_W + 1]) != (unsigned)G;
        if (any_fb) {
        unsigned kmin = cnt[2], kmax = cnt[3];
        bool done = hB1 <= 64u;
        for (int lev = 0; lev < 4; ++lev) {
            const unsigned width = kmax - kmin; const int bits = 32 - __builtin_clz(width | 1u);
            int sh = bits - 8; if (sh < 0) sh = 0;
            if (!done) for (int e = par * 64 + lane; e < n; e += 128) { const unsigned k = fkey(sc[e]); if (k >= kmin && k <= kmax) __hip_atomic_fetch_add(&hist[(k - kmin) >> sh], 1u, __ATOMIC_RELAXED, __HIP_MEMORY_SCOPE_WORKGROUP); }
            __syncthreads();
            unsigned B = 0, cgt = 0, hB = 0;
            if (!done) {
                const unsigned h0 = hist[4 * lane], h1 = hist[4 * lane + 1], h2 = hist[4 * lane + 2], h3 = hist[4 * lane + 3];
                unsigned suf = h0 + h1 + h2 + h3;
#pragma unroll
                for (int o = 1; o < 64; o <<= 1) { const unsigned v = __shfl_down(suf, o); if (lane + o < 64) suf += v; }
                const unsigned long long bal = __ballot(suf >= (unsigned)need);
                const int ls = 63 - __builtin_clzll(bal | 1ull);
                unsigned cum = suf - (h0 + h1 + h2 + h3), bb = 0, cg = 0, hb = 0;
                if (cum + h3 >= (unsigned)need) { bb = 3; cg = cum; hb = h3; }
                else if (cum + h3 + h2 >= (unsigned)need) { bb = 2; cg = cum + h3; hb = h2; }
                else if (cum + h3 + h2 + h1 >= (unsigned)need) { bb = 1; cg = cum + h3 + h2; hb = h1; }
                else { bb = 0; cg = cum + h3 + h2 + h1; hb = h0; }
                B = 4 * ls + __shfl(bb, ls); cgt = __shfl(cg, ls); hB = __shfl(hb, ls);
            }
            __syncthreads();
            if (!done) {
                const bool all_b = (cgt + hB == (unsigned)need);
                const bool ties = !all_b && sh == 0;
                for (int e = par * 64 + lane; e < n; e += 128) { const unsigned k = fkey(sc[e]);
                    if (k >= kmin && k <= kmax) { const unsigned bin = (k - kmin) >> sh;
                        if (bin > B || (all_b && bin == B)) { __hip_atomic_fetch_or(&bmp[e >> 5], 1u << (e & 31), __ATOMIC_RELAXED, __HIP_MEMORY_SCOPE_WORKGROUP); } } }
                if (ties) { if (par == 0) { int left = need - (int)cgt; const unsigned kk = kmin + B;
                        for (int e0 = 0; e0 < n && left > 0; e0 += 64) { const int e = e0 + lane; const bool eq = e < n && fkey(sc[e]) == kk;
                            const unsigned long long bq = __ballot(eq); const int before = __popcll(bq & ((1ull << lane) - 1ull));
                            if (eq && before < left) { __hip_atomic_fetch_or(&bmp[e >> 5], 1u << (e & 31), __ATOMIC_RELAXED, __HIP_MEMORY_SCOPE_WORKGROUP); }
                            left -= __popcll(bq); } }
                    done = true; }
                else if (all_b) done = true;
                else { need -= (int)cgt; const unsigned long long lo2 = (unsigned long long)kmin + ((unsigned long long)B << sh), hi2 = lo2 + ((1ull << sh) - 1ull);
                    kmin = (unsigned)lo2; kmax = hi2 < (unsigned long long)kmax ? (unsigned)hi2 : kmax; }
            }
            if (lane == 0 && par == 0) cnt[1] = done ? 1u : 0u;
            for (int e = tid; e < G * NB1; e += NWAVES * 64) ((LAS unsigned*)(L + OFF_HIST))[e] = 0u;
            __syncthreads();
            if (cnt_all[1] + cnt_all[CNT_W + 1] + cnt_all[2 * CNT_W + 1] + cnt_all[3 * CNT_W + 1] == (unsigned)G) break;
        }
        }
        __syncthreads();
        if (par == 0) {
            unsigned w0 = bmp[2 * lane], w1 = bmp[2 * lane + 1]; const int c = __popc(w0) + __popc(w1); int pre = c;
#pragma unroll
            for (int o = 1; o < 64; o <<= 1) { const int v = __shfl_up(pre, o); if (lane >= o) pre += v; }
            int pos = pre - c; unsigned short* so = SEL + row * 256;
            while (w0) { const int bb = __builtin_ctz(w0); w0 &= w0 - 1u; if (pos < 256) so[pos] = (unsigned short)(lane * 64 + bb); ++pos; }
            while (w1) { const int bb = __builtin_ctz(w1); w1 &= w1 - 1u; if (pos < 256) so[pos] = (unsigned short)(lane * 64 + 32 + bb); ++pos; }
        }
        }
    }
}
#ifndef DA_GRP
#define DA_GRP 2
#endif
#ifndef REP_GATHER
#define REP_GATHER 1
#endif
constexpr int DA_XOFF = 131072, DA_SOFF = DA_XOFF + 8192;
constexpr int DA_BOFF = DA_SOFF + 2048;
static_assert(DA_BOFF + 8192 <= RING_BYTES, "dsa attention LDS map");
__device__ __forceinline__ void dsa_attn_phase(Frame& F, int hot = 0) {
    const int lane = lane_now(), w = WAVE(F), tid = w * 64 + lane, g = w >> 1, half = w & 1, fr = lane & 15, fq = lane >> 4;
    LAS unsigned char* cbuf = F.lds + RING_OFF + g * 32768; LAS unsigned char* xb = F.lds + RING_OFF + DA_XOFF + g * 2048;
    const bf16* CKVN = (const bf16*)(WSL(F) + WS_CKVN); const bf16* QLAT = (const bf16*)(WSL(F) + WS_QLAT); const unsigned short* SEL = (const unsigned short*)(WSL(F) + WS_SEL);
    bf16* OLAT = (bf16*)(WSL(F) + WS_OLAT); const float* tab = karg(3);
    const int hh = fr < DSA_H ? fr : DSA_H - 1;
    constexpr float LOG2E = 1.4426950408889634f;
    const int q4 = (lane >> 2) & 3, p4 = lane & 3, keyl = 4 * fq + q4;
    LAS float* btab = (LAS float*)(F.lds + RING_OFF + DA_BOFF);
    for (int e = tid; e < 128 * 16; e += NWAVES * 64) { const int d = e >> 4, h_ = e & 15; btab[e] = tab[bucket(d) * 32 + 22 + (h_ < DSA_H ? h_ : DSA_H - 1)] * LOG2E; }
    const int vcu_ = VCU(F), per_x = F.G >= 8 ? F.G / 8 : 1, xcd = vcu_ / per_x, jx = vcu_ % per_x, nxb = F.G >= 8 ? 4 : F.G;
    for (int r8 = 0;; ++r8) {
        int b, t0;
        if (F.G >= 8 && F.G % 8 == 0) { const int gi = r8 * (nxb * per_x) + (xcd >> 1) * per_x + jx; if (gi >= T / 4) break; b = xcd & 1; t0 = T - 4 - 4 * gi; }
        else { const int gi = r8 * F.G + vcu_; if (gi >= M / 4) break; b = gi & 1; t0 = T - 4 - 4 * (gi >> 1); }
        const int t = t0 + g, q = b * T + t, nsel = t + 1 < 256 ? t + 1 : 256;
        const int nmax = ((t0 + 4 < 256 ? t0 + 4 : 256) + 15) >> 4;
        bf16x8 ql[8];
#pragma unroll
        for (int ks = 0; ks < 8; ++ks) ql[ks] = __builtin_nontemporal_load((const GAS bf16x8*)(QLAT + (size_t)q * (DSA_H * KVL) + hh * KVL + half * 256 + 32 * ks + 8 * fq));
        f32x4 O[16];
#pragma unroll
        for (int ct = 0; ct < 16; ++ct) O[ct] = (f32x4){0.f, 0.f, 0.f, 0.f};
        float m_run = -1e30f, l_run = 0.f;
        const bf16* cb = CKVN + (size_t)b * T * KVL;
        const LAS unsigned short* srow = (const LAS unsigned short*)(F.lds + RING_OFF + DA_SOFF + g * 512);
        v2u selw; if (half == 0) selw = *(const GAS v2u*)(SEL + (size_t)q * 256 + lane * 4);
#define DA_RD128(dst, addr, off) asm volatile("ds_read_b128 %0, %1 offset:%2" : "=v"(dst) : "v"(addr), "i"(off) : "memory")
#define DA_RDTR(dst, addr, off) asm volatile("ds_read_b64_tr_b16 %0, %1 offset:%2" : "=v"(dst) : "v"(addr), "i"(off) : "memory")
#define DA_ISSUE_K(sv_, bf_, k0_, k1_) do { _Pragma("unroll") for (int k = (k0_); k < (k1_); ++k) { const int slot_ = half * 8 + k; const int idx_ = __builtin_amdgcn_readlane(sv_, slot_); \
        _Pragma("unroll") for (int rg_ = 0; rg_ < REP_GATHER; ++rg_) __builtin_amdgcn_global_load_lds((const GAS unsigned*)(cb + (size_t)idx_ * KVL + ((lane ^ slot_) & 63) * 8), (LAS unsigned*)(cbuf + (bf_) * 16384 + slot_ * 1024), 16, 0, 0); } } while (0)
#define DA_ISSUE(sv_, bf_) DA_ISSUE_K(sv_, bf_, 0, 8)
#define DA_NEXT(k0_) do { __builtin_amdgcn_sched_barrier(0); if (more) DA_ISSUE_K(selv, cur ^ 1, k0_, (k0_) + DA_GRP); __builtin_amdgcn_sched_barrier(0); } while (0)
        __syncthreads();
        if (half == 0) *(LAS v2u*)(F.lds + RING_OFF + DA_SOFF + g * 512 + lane * 8) = selw;
        __syncthreads();
        int selv = fr < nsel ? (int)srow[fr] : 0; if (hot) selv &= 255;
        DA_ISSUE(selv, 0);
        for (int c = 0; c < nmax; ++c) {
            const int cur = c & 1;
            asm volatile("s_waitcnt vmcnt(0)" ::: "memory");
            __builtin_amdgcn_s_barrier();
            asm volatile("" ::: "memory"); __builtin_amdgcn_sched_barrier(0);
            const bool more = c + 1 < nmax;
            if (more) { const int slot = (c + 1) * 16 + fr; selv = slot < nsel ? (int)srow[slot] : 0; if (hot) selv &= 255; }
            DA_NEXT(0);
            const LAS unsigned char* buf = cbuf + cur * 16384;
            f32x4 s4 = (f32x4){0.f, 0.f, 0.f, 0.f};
            { bf16x8 af[8];
#pragma unroll
              for (int i4 = 0; i4 < 4; ++i4) { const unsigned sa = (unsigned)(size_t)(buf + fr * 1024 + half * 512 + (((4 * i4 + fq) ^ fr) << 4));
                  DA_RD128(af[i4], sa, 0); DA_RD128(af[4 + i4], sa, 256); }
              asm volatile("s_waitcnt lgkmcnt(0)" ::: "memory"); __builtin_amdgcn_sched_barrier(0);
#pragma unroll
              for (int ks = 0; ks < 8; ++ks) s4 = __builtin_amdgcn_mfma_f32_16x16x32_bf16(af[ks], ql[ks], s4, 0, 0, 0); }
            DA_NEXT(DA_GRP);
            *(LAS f32x4*)(xb + half * 1024 + lane * 16) = s4;
            asm volatile("s_waitcnt lgkmcnt(0)" ::: "memory");
            __builtin_amdgcn_s_barrier();
            asm volatile("" ::: "memory"); __builtin_amdgcn_sched_barrier(0);
            DA_NEXT(2 * DA_GRP);
            s4 = s4 + *(const LAS f32x4*)(xb + (half ^ 1) * 1024 + lane * 16);
            float sv[4]; float cmax = -__builtin_inff();
#pragma unroll
            for (int r = 0; r < 4; ++r) { const int ks_ = 4 * fq + r; const bool valid = c * 16 + ks_ < nsel; const int idx = valid ? (int)srow[c * 16 + ks_] : 0;
                int dist = t - idx; dist = dist > 127 ? 127 : dist; const float bias = btab[dist * 16 + fr];
                sv[r] = valid ? s4[r] * (SCALE * LOG2E) + bias : -__builtin_inff(); cmax = fmaxf(cmax, sv[r]); }
            { auto r1 = __builtin_amdgcn_permlane16_swap(__float_as_uint(cmax), __float_as_uint(cmax), false, false); cmax = fmaxf(__uint_as_float(r1[0]), __uint_as_float(r1[1]));
              auto r2 = __builtin_amdgcn_permlane32_swap(__float_as_uint(cmax), __float_as_uint(cmax), false, false); cmax = fmaxf(__uint_as_float(r2[0]), __uint_as_float(r2[1])); }
            const bool grow = __any(cmax - m_run > 10.f);
            const float m_new = grow ? fmaxf(m_run, cmax) : m_run, alpha = grow ? __builtin_amdgcn_exp2f(m_run - m_new) : 1.f;
            float p[4], ps = 0.f;
#pragma unroll
            for (int r = 0; r < 4; ++r) { p[r] = __builtin_amdgcn_exp2f(sv[r] - m_new); ps += p[r]; }
            { auto r1 = __builtin_amdgcn_permlane16_swap(__float_as_uint(ps), __float_as_uint(ps), false, false); ps = __uint_as_float(r1[0]) + __uint_as_float(r1[1]);
              auto r2 = __builtin_amdgcn_permlane32_swap(__float_as_uint(ps), __float_as_uint(ps), false, false); ps = __uint_as_float(r2[0]) + __uint_as_float(r2[1]); }
            l_run = l_run * alpha + ps; m_run = m_new;
            if (grow) { float ar[4];
#pragma unroll
                for (int r = 0; r < 4; ++r) ar[r] = __shfl(alpha, 4 * fq + r);
#pragma unroll
                for (int ct = 0; ct < 16; ++ct)
#pragma unroll
                    for (int r = 0; r < 4; ++r) O[ct][r] *= ar[r]; }
            DA_NEXT(3 * DA_GRP);
            v2u pw; pw.x = pk2(p[0], p[1]); pw.y = pk2(p[2], p[3]);
            const s16x4 pa = __builtin_bit_cast(s16x4, pw);
            { const unsigned rb = (unsigned)(size_t)(buf + keyl * 1024 + half * 512 + (p4 & 1) * 8); s16x4 bvv[16];
#pragma unroll
              for (int i8 = 0; i8 < 8; ++i8) { const unsigned ad = rb + (((2 * i8 + (p4 >> 1)) ^ keyl) << 4);
                  DA_RDTR(bvv[i8], ad, 0); DA_RDTR(bvv[8 + i8], ad, 256); }
              asm volatile("s_waitcnt lgkmcnt(0)" ::: "memory"); __builtin_amdgcn_sched_barrier(0);
#pragma unroll
              for (int ct = 0; ct < 16; ++ct) O[ct] = __builtin_amdgcn_mfma_f32_16x16x16bf16_1k(pa, bvv[ct], O[ct], 0, 0, 0); }
        }
#undef DA_ISSUE
#undef DA_ISSUE_K
#undef DA_NEXT
#undef DA_RD128
#undef DA_RDTR
        float rl[4];
#pragma unroll
        for (int r = 0; r < 4; ++r) rl[r] = 1.f / __shfl(l_run, 4 * fq + r);
        { LAS unsigned char* stg = cbuf + (nmax & 1) * 16384 + half * 8192;
          LAS unsigned char* wb = stg + (4 * fq * 256 + fr) * 2;
#pragma unroll
          for (int r = 0; r < 4; ++r) if (4 * fq + r < DSA_H) {
#pragma unroll
              for (int ct = 0; ct < 16; ++ct) *(LAS unsigned short*)(wb + r * 512 + ct * 32) = (unsigned short)f2bf(O[ct][r] * rl[r]); }
          asm volatile("s_waitcnt lgkmcnt(0)" ::: "memory");
#pragma unroll
          for (int i5 = 0; i5 < 5; ++i5) { const int e = i5 * 512 + lane * 8, hd = e >> 8, col = e & 255;
              __builtin_nontemporal_store(*(const LAS v4u*)(stg + i5 * 1024 + lane * 16), (GAS v4u*)(OLAT + (size_t)q * (DSA_H * KVL) + hd * KVL + half * 256 + col)); } }
    }
}


template <class P> __device__ __forceinline__ P* lnd(P* p) { asm volatile("" : "+s"(p)); return p; }
#ifndef DA_HOT
#define DA_HOT 0
#endif
#ifndef QLAT_GEMM
#define QLAT_GEMM 1
#endif
struct QlatOrder : pg8::StaticOrder { __device__ __forceinline__ int acol(const pg8::Unit& u) const { return (u.pn >> 1) * HD; } };
#ifndef REP_DSAOUT
#define REP_DSAOUT 1
#endif
#ifndef REP_POSTP
#define REP_POSTP 1
#endif
#ifndef DSAOUT_GEMM
#define DSAOUT_GEMM 1
#endif
struct DsaOutOrder : pg8::StaticOrder { __device__ __forceinline__ int acol(const pg8::Unit& u) const { return u.pn * 2 * KVL; } };
#ifndef REP_QLAT
#define REP_QLAT 1
#endif
#ifndef REP_FA
#define REP_FA 1
#endif
#ifndef REP_DA
#define REP_DA 1
#endif
#ifndef REP_MS
#define REP_MS 1
#endif
#ifndef REP_TAIL
#define REP_TAIL 1
#endif
#ifndef REP_P0
#define REP_P0 1
#endif
#ifndef REP_PROJ
#define REP_PROJ 1
#endif
#ifndef REP_PREP
#define REP_PREP 1
#endif
#ifndef REP_SEL
#define REP_SEL 1
#endif
#ifndef REP_ATTN
#define REP_ATTN 1
#endif
#ifndef REP_POST
#define REP_POST 1
#endif
#ifndef REP_WO
#define REP_WO 1
#endif
#ifndef REP_LN
#define REP_LN 1
#endif
#ifndef REP_UP
#define REP_UP 1
#endif
#ifndef REP_DN
#define REP_DN 1
#endif
constexpr int PH_PER_LAYER = 10, N_PHASES = 1 + DEPTH * PH_PER_LAYER;
struct Args { const float* in[17]; float* out; unsigned char* ws; int ph_lo, ph_hi, li, pad; };
__global__ void __launch_bounds__(NWAVES * 64, 2) mk_fwd(Args args) {
    extern __shared__ __attribute__((aligned(16))) unsigned char lds[];
    Frame F;
    F.lds = (LAS unsigned char*)lds;
    F.MISC = (volatile LAS unsigned*)(F.lds + MISC_OFF);
    F.wave = __builtin_amdgcn_readfirstlane((int)threadIdx.x >> 6);
    F.G = gridDim.x; { const int bx = blockIdx.x; F.vcu = (F.G % 8 == 0) ? (bx % 8) * (F.G / 8) + bx / 8 : bx; }
    F.ws = args.ws; F.ctl = (gu32*)(args.ws + WS_CTL);
    { for (int u = F.wave * 64 + lane_now(); u < (LDS_BYTES - LDSCTL_OFF) / 4; u += NWAVES * 64) ((LAS unsigned*)(F.lds + LDSCTL_OFF))[u] = 0u; }
    __syncthreads();
    XcdBarrier bar = xcd_barrier_post((unsigned*)(F.ctl + CW_BAR) + args.li * XCD_BAR_WORDS, F.MISC + 8, F.wave);
    const int lo = args.ph_lo, hi = args.ph_hi;
#define IN(k) (lo <= (k) && (k) < hi)
#ifndef REP_BAR
#define REP_BAR 1
#endif
#define SEAM(k) do { if (IN(k) && IN((k) + 1)) { for (int rb_ = 0; rb_ < REP_BAR; ++rb_) xcd_barrier(bar); } } while (0)

#define XN ((bf16*)(WSL(F) + WS_XN))
#define PROJ ((bf16*)(WSL(F) + WS_PROJ))
#define TAIL ((float*)(WSL(F) + WS_TAIL))
#define Y ((bf16*)(WSL(F) + WS_Y))
#define Z ((bf16*)(WSL(F) + WS_Z))
#define HID ((bf16*)(WSL(F) + WS_HID))

    for (int rep_ = 0; rep_ < REP_P0; ++rep_) { if (IN(0)) { p0_prologue(F); }
    SEAM(0); }
    for (int l = 0; l < DEPTH; ++l) {
        const int pb = 1 + l * PH_PER_LAYER;
        for (int rep_ = 0; rep_ < REP_PROJ; ++rep_) { if (IN(pb + 0)) {
            pg8::Gemm g{lnd(XN), lnd(w_layer(F, l, 0)), M, DINM, DM}; pg8::StaticOrder S; S.init(M, DINM, F.G, (int)blockIdx.x);
            pg8::EpiBf16<0> E{lnd(PROJ), DINM};
            pg8::gemm_phase<pg8::EpiBf16<0>, pg8::StaticOrder, PG8_ALIGN, PG8_SP2>(F.lds + RING_OFF, g, S, E, WAVE(F));
            for (int rt_ = 0; rt_ < REP_TAIL; ++rt_) tail_phase(F, lnd(XN), lnd(w_layer(F, l, 0) + (size_t)DINM * DM), lnd(TAIL));
        }
        SEAM(pb + 0); }
        for (int rep_ = 0; rep_ < REP_PREP; ++rep_) { if (IN(pb + 1)) { prep_phase(F, l);
            for (int r2_ = 0; r2_ < REP_QLAT; ++r2_) {
#if QLAT_GEMM
                __syncthreads();
                pg8::Gemm g{lnd((const bf16*)(WSL(F) + WS_PROJ) + O_CQ), lnd((const bf16*)(WSL(F) + WS_WUK) + (size_t)l * DSA_H * KVL * HD), M, DSA_H * KVL, HD, DINM};
                QlatOrder S; S.init(M, DSA_H * KVL, F.G, (int)blockIdx.x);
                pg8::EpiBf16Late E{lnd((bf16*)(WSL(F) + WS_QLAT)), DSA_H * KVL};
                pg8::gemm_phase<pg8::EpiBf16Late, QlatOrder, PG8_ALIGN, PG8_SP2, true>(F.lds + RING_OFF, g, S, E, WAVE(F));
#else
                qlat_phase(F, l);
#endif
            } }
        SEAM(pb + 1); }
        for (int rep_ = 0; rep_ < REP_SEL; ++rep_) { if (IN(pb + 2)) { for (int r2_ = 0; r2_ < REP_MS; ++r2_) moba_select_phase(F); dsa_select_phase(F); }
        SEAM(pb + 2); }
        for (int rep_ = 0; rep_ < REP_ATTN; ++rep_) { if (IN(pb + 3)) { for (int r2_ = 0; r2_ < REP_FA; ++r2_) { attn_phase(F); __syncthreads(); } for (int r2_ = 0; r2_ < REP_DA; ++r2_) { dsa_attn_phase(F, DA_HOT && (r2_ + 1 < REP_DA)); __syncthreads(); } }
        SEAM(pb + 3); }
        for (int rep_ = 0; rep_ < REP_POST; ++rep_) { if (IN(pb + 4)) { for (int r2_ = 0; r2_ < REP_POSTP; ++r2_) post_phase(F, l); for (int r2_ = 0; r2_ < REP_DSAOUT; ++r2_) {
#if DSAOUT_GEMM
                pg8::Gemm g{lnd((const bf16*)(WSL(F) + WS_OLAT)), lnd((const bf16*)(WSL(F) + WS_WUVB) + (size_t)l * 5 * 256 * 1024), M, DSA_H * HD, 2 * KVL, DSA_H * KVL};
                DsaOutOrder S; S.init(M, DSA_H * HD, F.G, (int)blockIdx.x);
                pg8::EpiBf16Late E{lnd((bf16*)(WSL(F) + WS_Y) + 2816), DM};
                pg8::gemm_phase<pg8::EpiBf16Late, DsaOutOrder, PG8_ALIGN, PG8_SP2, true>(F.lds + RING_OFF, g, S, E, WAVE(F));
#else
#error "the prologue only builds the pair-matrix layout"
#endif
            } }
        SEAM(pb + 4); }
        for (int rep_ = 0; rep_ < REP_WO; ++rep_) { if (IN(pb + 5)) {
            pg8::Gemm g{lnd(Y), lnd(w_layer(F, l, 1)), M, DM, DM}; pg8::StaticOrder S; S.init(M, DM, F.G, (int)blockIdx.x);
            pg8::EpiResBf16 E{lnd(Z), lnd(XN), DM, ALPHA};
            pg8::gemm_phase<pg8::EpiResBf16, pg8::StaticOrder, PG8_ALIGN, PG8_SP2>(F.lds + RING_OFF, g, S, E, WAVE(F));
        }
        SEAM(pb + 5); }
        for (int rep_ = 0; rep_ < REP_LN; ++rep_) { if (IN(pb + 6)) ln_phase(F, lnd(Z), lnd(karg(11) + (size_t)l * DM), lnd(karg(12) + (size_t)l * DM), nullptr, lnd(XN));
        SEAM(pb + 6); }
        for (int rep_ = 0; rep_ < REP_UP; ++rep_) { if (IN(pb + 7)) {
            pg8::Gemm g{lnd(XN), lnd(w_layer(F, l, 2)), M, DFF, DM}; pg8::StaticOrder S; S.init(M, DFF, F.G, (int)blockIdx.x);
            pg8::EpiBf16<1> E{lnd(HID), DFF};
            pg8::gemm_phase<pg8::EpiBf16<1>, pg8::StaticOrder, PG8_ALIGN, PG8_SP2>(F.lds + RING_OFF, g, S, E, WAVE(F));
        }
        SEAM(pb + 7); }
        for (int rep_ = 0; rep_ < REP_DN; ++rep_) { if (IN(pb + 8)) {
            pg8::Gemm g{lnd(HID), lnd(w_layer(F, l, 3)), M, DM, DFF}; pg8::StaticOrder S; S.init(M, DM, F.G, (int)blockIdx.x);
            pg8::EpiResBf16 E{lnd(Z), lnd(XN), DM, ALPHA};
            pg8::gemm_phase<pg8::EpiResBf16, pg8::StaticOrder, PG8_ALIGN, PG8_SP2>(F.lds + RING_OFF, g, S, E, WAVE(F));
        }
        SEAM(pb + 8); }
        for (int rep_ = 0; rep_ < REP_LN; ++rep_) { if (IN(pb + 9)) { const bool fin = (l == DEPTH - 1); ln_phase(F, lnd(Z), lnd(karg(15) + (size_t)l * DM), lnd(karg(16) + (size_t)l * DM), fin ? lnd((float*)karg(17)) : nullptr, fin ? nullptr : lnd(XN)); }
        SEAM(pb + 9); }
    }
#undef IN
#undef SEAM
#undef XN
#undef PROJ
#undef TAIL
#undef Y
#undef Z
#undef HID
}


extern "C" void kernel_launch(void* const* d_in, const int* in_sizes, int n_in, void* d_out, int out_size, void* d_ws, size_t ws_size, hipStream_t stream) {
    static int grid = 0;
    if (grid == 0) {
        if (n_in != 17 || in_sizes[0] != M * DM || out_size != M * DM || ws_size < WS_END) { fprintf(stderr, "kernel_launch: unexpected shapes / workspace (n_in %d, ws %zu need %zu); nothing launched\n", n_in, ws_size, (size_t)WS_END); grid = -1; return; }
        int dev = 0, cus = 0, per_cu = 0;
        if (hipGetDevice(&dev) != hipSuccess || hipDeviceGetAttribute(&cus, hipDeviceAttributeMultiprocessorCount, dev) != hipSuccess) { grid = -1; return; }
        if (hipFuncSetAttribute((const void*)mk_fwd, hipFuncAttributeMaxDynamicSharedMemorySize, LDS_BYTES) != hipSuccess) { fprintf(stderr, "kernel_launch: hipFuncSetAttribute failed\n"); grid = -1; return; }
        if (hipOccupancyMaxActiveBlocksPerMultiprocessor(&per_cu, (const void*)mk_fwd, NWAVES * 64, LDS_BYTES) != hipSuccess || per_cu < 1)
            fprintf(stderr, "kernel_launch: note: occupancy query reports %d workgroups per CU\n", per_cu);
        (void)hipGetLastError();
        grid = cus;
    }
    if (grid < 0) return;
    (void)hipMemsetAsync((char*)d_ws + WS_CTL, 0, CTL_ZERO_BYTES, stream);
    Args a{};
    for (int i = 0; i < 17; ++i) a.in[i] = (const float*)d_in[i];
    a.out = (float*)d_out; a.ws = (unsigned char*)d_ws; a.ph_lo = 0; a.ph_hi = N_PHASES; a.li = 0; a.pad = 0;
    hipLaunchKernelGGL(mk_fwd, dim3(grid), dim3(NWAVES * 64), LDS_BYTES, stream, a);
    const hipError_t le = hipPeekAtLastError();
    if (le != hipSuccess) fprintf(stderr, "kernel_launch: launch failed: %s\n", hipGetErrorName(le));
}
```
